# Optimizing an MI355X kernel written in HIP

```python
import math
import jax
import jax.numpy as jnp
from jax import lax
import numpy as np

D_MODEL = 1024
BATCH = 2
SEQ = 8192
DEPTH = 4
DEC_BATCH = 8
DEC_SEQ = 16
PAST_LEN = 2048

CHUNK = 64
HGRN_BLOCK = 16
N_AB = (DEPTH + 1) // 2
N_C = DEPTH // 2
H_A = 8
HD_A = 64
W_A = H_A * HD_A
LORA_W = 64
LORA_A = 64
LORA_G = 128
A_COLS = 3 * W_A + LORA_W + LORA_A + LORA_G
A_SPLITS = (W_A, 2 * W_A, 3 * W_A, 3 * W_A + LORA_W, 3 * W_A + LORA_W + LORA_A)
LNX_EPS = 64e-5
H_B = 16
HD_B = 64
W_B = H_B * HD_B
G_B = 2
N_B = 128
CONV_W = 4
XBC = W_B + 2 * G_B * N_B
B_COLS = W_B + XBC + H_B
IN_AB = A_COLS + B_COLS
MIX_AB = W_A + W_B
H_C = 8
DK_C = 128
DV_C = 128
W_C = H_C * DK_C
IN_C = 4 * W_C
D_FF = -(-8 * D_MODEL // (3 * 256)) * 256

kernel_name = 'rwkv7_mamba2_hgrn2_streaming_encoder_step'


def rms_norm(x, w, eps=1e-6):
    x32 = x.astype(jnp.float32)
    y = x32 * lax.rsqrt(jnp.mean(x32 * x32, axis=-1, keepdims=True) + eps)
    return (y * w.astype(jnp.float32)).astype(x.dtype)


def group_rms_norm(x, w, groups, eps=1e-5):
    shp = x.shape
    x32 = x.astype(jnp.float32).reshape(*shp[:-1], groups, shp[-1] // groups)
    y = x32 * lax.rsqrt(jnp.mean(x32 * x32, axis=-1, keepdims=True) + eps)
    return y.reshape(shp) * w.astype(jnp.float32)


def split_heads(u, n_heads):
    return u.astype(jnp.float32).reshape(*u.shape[:-1], n_heads, u.shape[-1] // n_heads)


def causal_dwconv(u, prev, w, b):
    up = jnp.concatenate([prev.astype(u.dtype), u], axis=1)
    y = lax.conv_general_dilated(up, w[:, None, :].astype(u.dtype), (1,), 'VALID',
                                 dimension_numbers=('NWC', 'WIO', 'NWC'),
                                 feature_group_count=u.shape[-1])
    return y + b, up[:, up.shape[1] - (CONV_W - 1):]


def rwkv7_scan(r, decay, k, v, kk, a, s0):
    def step(s, inp):
        r_t, d_t, k_t, v_t, kk_t, a_t = inp
        sa = jnp.einsum('bhvk,bhk->bhv', s, -kk_t)
        s = (s * d_t[:, :, None, :] + sa[..., None] * (kk_t * a_t)[:, :, None, :]
             + v_t[..., None] * k_t[:, :, None, :])
        return s, jnp.einsum('bhvk,bhk->bhv', s, r_t)
    xs = tuple(jnp.moveaxis(u, 1, 0) for u in (r, decay, k, v, kk, a))
    s_last, o = lax.scan(step, s0.astype(jnp.float32), xs)
    return jnp.moveaxis(o, 0, 1), s_last


def rwkv7_mixer(p, shift_prev, s0, mu, w0, w2, a0, a2, g2, k_k, k_a, r_k, lnx_w, lnx_b):
    bsz, t, _ = p.shape
    p_prev = jnp.concatenate([shift_prev[:, None, :].astype(p.dtype), p[:, :-1]], axis=1)
    pm = p + (p_prev - p) * mu
    r, k, v, xw, xa, xg = jnp.split(pm, A_SPLITS, axis=-1)
    w = -jax.nn.softplus(-(w0 + jnp.tanh(xw) @ w2)) - 0.5
    decay = jnp.exp(-jnp.exp(w.astype(jnp.float32)))
    a = jax.nn.sigmoid(a0 + xa @ a2)
    g = jax.nn.sigmoid(xg) @ g2
    kk = split_heads(k * k_k, H_A)
    kk = kk / jnp.maximum(jnp.sqrt(jnp.sum(kk * kk, axis=-1, keepdims=True)), 1e-12)
    k = k * (1.0 + (a - 1.0) * k_a)
    rh, kh, vh, ah, dh = (split_heads(u, H_A) for u in (r, k, v, a, decay))
    o, s_new = rwkv7_scan(rh, dh, kh, vh, kk, ah, s0)
    mean = jnp.mean(o, axis=-1, keepdims=True)
    var = jnp.mean(jnp.square(o - mean), axis=-1, keepdims=True)
    o = ((o - mean) * lax.rsqrt(var + LNX_EPS)).reshape(bsz, t, W_A) * lnx_w + lnx_b
    bonus = jnp.sum(rh * kh * r_k, axis=-1, keepdims=True) * vh
    out = (o + bonus.reshape(bsz, t, W_A)) * g
    return out, p[:, -1], s_new


def ssd_chunked(x, dt, a_neg, bm, cm, s0, chunk):
    bsz, t = x.shape[:2]
    nc = t // chunk
    hg = H_B // G_B
    xd = (x * dt[..., None]).reshape(bsz, nc, chunk, G_B, hg, HD_B)
    la = (dt * a_neg).reshape(bsz, nc, chunk, G_B, hg)
    bc = bm.reshape(bsz, nc, chunk, G_B, N_B)
    cc = cm.reshape(bsz, nc, chunk, G_B, N_B)
    acum = jnp.cumsum(la, axis=2)
    causal = jnp.tril(jnp.ones((chunk, chunk), bool))[None, None, :, :, None, None]
    seg = acum[:, :, :, None] - acum[:, :, None, :]
    decay_ls = jnp.where(causal, jnp.exp(jnp.where(causal, seg, 0.0)), 0.0)
    cb = jnp.einsum('bclgn,bcsgn->bclsg', cc, bc)
    y_intra = jnp.einsum('bclsg,bclsgh,bcsghp->bclghp', cb, decay_ls, xd)
    to_end = jnp.exp(acum[:, :, -1:] - acum)
    chunk_states = jnp.einsum('bclgn,bclgh,bclghp->bcghpn', bc, to_end, xd)
    chunk_decay = jnp.exp(acum[:, :, -1])

    def step(s, inp):
        st, dec = inp
        return s * dec[..., None, None] + st, s
    s_last, s_in = lax.scan(step, s0.astype(jnp.float32).reshape(bsz, G_B, hg, HD_B, N_B),
                            (jnp.moveaxis(chunk_states, 1, 0), jnp.moveaxis(chunk_decay, 1, 0)))
    s_in = jnp.moveaxis(s_in, 0, 1)
    y_inter = jnp.einsum('bclgn,bcghpn,bclgh->bclghp', cc, s_in, jnp.exp(acum))
    y = (y_intra + y_inter).reshape(bsz, t, H_B, HD_B)
    return y, s_last.reshape(bsz, H_B, HD_B, N_B)


def mamba2_mixer(p, conv_prev, s0, conv_w, conv_b, dt_bias, a_log, d_skip, norm_w, chunk):
    z, xbc, dt = jnp.split(p, (W_B, W_B + XBC), axis=-1)
    xbc_c, conv_new = causal_dwconv(xbc, conv_prev, conv_w, conv_b)
    xbc_c = jax.nn.silu(xbc_c)
    xs, bm, cm = jnp.split(xbc_c, (W_B, W_B + G_B * N_B), axis=-1)
    xs = split_heads(xs, H_B)
    dt = jax.nn.softplus(dt.astype(jnp.float32) + dt_bias.astype(jnp.float32))
    y, s_new = ssd_chunked(xs, dt, -jnp.exp(a_log.astype(jnp.float32)),
                           split_heads(bm, G_B), split_heads(cm, G_B), s0, chunk)
    y = y + d_skip[:, None] * xs
    y = y.reshape(*y.shape[:2], W_B) * jax.nn.silu(z.astype(jnp.float32))
    return group_rms_norm(y, norm_w, G_B), conv_new, s_new


def gla_chunked(q, k, v, log_f, s0, chunk):
    bsz, t = q.shape[:2]
    nc = t // chunk
    q, k, v, log_f = (u.reshape(bsz, nc, chunk, H_C, u.shape[-1]) for u in (q, k, v, log_f))
    bcum = jnp.cumsum(log_f, axis=2)
    causal = jnp.tril(jnp.ones((chunk, chunk), bool))[:, :, None, None]
    seg = bcum[:, :, :, None] - bcum[:, :, None, :]
    decay_ls = jnp.where(causal, jnp.exp(jnp.where(causal, seg, 0.0)), 0.0)
    att = jnp.einsum('bclhk,bcshk,bclshk->bchls', q, k, decay_ls)
    o_intra = jnp.einsum('bchls,bcshv->bclhv', att, v)
    chunk_states = jnp.einsum('bclhk,bclhv->bchkv', k * jnp.exp(bcum[:, :, -1:] - bcum), v)
    chunk_decay = jnp.exp(bcum[:, :, -1])

    def step(s, inp):
        st, dec = inp
        return s * dec[..., None] + st, s
    s_last, s_in = lax.scan(step, s0.astype(jnp.float32),
                            (jnp.moveaxis(chunk_states, 1, 0), jnp.moveaxis(chunk_decay, 1, 0)))
    s_in = jnp.moveaxis(s_in, 0, 1)
    o_inter = jnp.einsum('bclhk,bchkv->bclhv', q * jnp.exp(bcum), s_in)
    return (o_intra + o_inter).reshape(bsz, t, H_C, DV_C), s_last


def hgrn2_mixer(p, s0, lb, norm_w, chunk):
    q, f, i, g = jnp.split(p, 4, axis=-1)
    f = f.astype(jnp.float32)
    lb = lb.astype(jnp.float32)
    log_f = jnp.log(lb + (1.0 - lb) * jax.nn.sigmoid(f))
    k = (1.0 - lb) * jax.nn.sigmoid(-f)
    o, s_new = gla_chunked(split_heads(jax.nn.silu(q), H_C), split_heads(k, H_C),
                           split_heads(i, H_C), split_heads(log_f, H_C), s0, chunk)
    o = group_rms_norm(o.reshape(*o.shape[:2], W_C), norm_w, H_C) * jax.nn.silu(g.astype(jnp.float32))
    return o, s_new


def trunk(x, c, st_rwkv, st_shift, st_ssm, st_conv, st_hgrn,
          norm_mix_w, norm_ffn_w, norm_out_w, ada_w, ada_b,
          w_in_ab, w_out_ab, mu_a, w0, w2, a0, a2, g2, k_k, k_a, r_k, lnx_w, lnx_b,
          conv_w, conv_b, dt_bias, a_log, d_skip, norm_b_w,
          w_in_c, w_out_c, lb_param, norm_c_w,
          w_gate, w_up, w_down):
    chunk = math.gcd(CHUNK, x.shape[1])
    chunk_c = math.gcd(HGRN_BLOCK, x.shape[1])
    lb_soft = jax.nn.softmax(lb_param.astype(jnp.float32), axis=0)
    lb_all = jnp.cumsum(lb_soft, axis=0) - lb_soft[0]
    new_rwkv, new_shift, new_ssm, new_conv, new_hgrn = [], [], [], [], []
    for layer in range(DEPTH):
        j = layer // 2
        mod = jax.nn.silu(c) @ ada_w[layer] + ada_b[layer]
        sh_m, sc_m, g_m, sh_f, sc_f, g_f = jnp.split(mod[:, None, :], 6, axis=-1)
        h = rms_norm(x, norm_mix_w[layer]) * (1.0 + sc_m) + sh_m
        if layer % 2 == 0:
            proj = h @ w_in_ab[j]
            oa, shift_new, rwkv_new = rwkv7_mixer(proj[..., :A_COLS], st_shift[:, j], st_rwkv[:, j],
                                                  mu_a[j], w0[j], w2[j], a0[j], a2[j], g2[j],
                                                  k_k[j], k_a[j], r_k[j], lnx_w[j], lnx_b[j])
            ob, conv_new, ssm_new = mamba2_mixer(proj[..., A_COLS:], st_conv[:, j], st_ssm[:, j],
                                                 conv_w[j], conv_b[j], dt_bias[j], a_log[j],
                                                 d_skip[j], norm_b_w[j], chunk)
            mix = jnp.concatenate([oa.astype(x.dtype), ob.astype(x.dtype)], axis=-1) @ w_out_ab[j]
            new_rwkv.append(rwkv_new)
            new_shift.append(shift_new)
            new_ssm.append(ssm_new)
            new_conv.append(conv_new)
        else:
            oc, hgrn_new = hgrn2_mixer(h @ w_in_c[j], st_hgrn[:, j], lb_all[j], norm_c_w[j], chunk_c)
            mix = oc.astype(x.dtype) @ w_out_c[j]
            new_hgrn.append(hgrn_new)
        x = x + g_m * mix
        h = rms_norm(x, norm_ffn_w[layer]) * (1.0 + sc_f) + sh_f
        x = x + g_f * ((jax.nn.silu(h @ w_gate[layer]) * (h @ w_up[layer])) @ w_down[layer])
    y = rms_norm(x, norm_out_w)
    return (y, jnp.stack(new_rwkv, axis=1), jnp.stack(new_shift, axis=1), jnp.stack(new_ssm, axis=1),
            jnp.stack(new_conv, axis=1), jnp.stack(new_hgrn, axis=1))


def setup_inputs(seed: int = 0) -> dict:
    key = jax.random.key(seed)
    ks = iter(jax.random.split(key, 64))

    def nrm(shape, scale):
        return jax.random.normal(next(ks), shape, jnp.float32) * scale

    def unif(shape, lo, hi):
        return jax.random.uniform(next(ks), shape, jnp.float32, lo, hi)

    d = D_MODEL
    inputs = {}
    inputs['x_prompt'] = nrm((BATCH, SEQ, d), 1.0)
    inputs['x_sample'] = nrm((DEC_BATCH, DEC_SEQ, d), 1.0)
    inputs['state_rwkv'] = nrm((DEC_BATCH, N_AB, H_A, HD_A, HD_A), 0.3)
    inputs['state_rwkv_shift'] = nrm((DEC_BATCH, N_AB, A_COLS), 1.0)
    inputs['state_ssm'] = nrm((DEC_BATCH, N_AB, H_B, HD_B, N_B), 0.1)
    inputs['state_conv'] = nrm((DEC_BATCH, N_AB, CONV_W - 1, XBC), 1.0)
    inputs['state_hgrn'] = nrm((DEC_BATCH, N_C, H_C, DK_C, DV_C), 0.3)
    inputs['c_prompt'] = nrm((BATCH, d), 1.0)
    inputs['c_sample'] = nrm((DEC_BATCH, d), 1.0)
    inputs['norm_mix_w'] = 1.0 + nrm((DEPTH, d), 0.02)
    inputs['norm_ffn_w'] = 1.0 + nrm((DEPTH, d), 0.02)
    inputs['norm_out_w'] = 1.0 + nrm((d,), 0.02)
    inputs['ada_w'] = nrm((DEPTH, d, 6 * d), 0.5 * d ** -0.5)
    inputs['ada_b'] = nrm((DEPTH, 6 * d), 0.02)
    inputs['w_in_ab'] = nrm((N_AB, d, IN_AB), d ** -0.5)
    inputs['w_out_ab'] = nrm((N_AB, MIX_AB, d), MIX_AB ** -0.5)
    inputs['mu_a'] = unif((N_AB, A_COLS), 0.0, 1.0)
    inputs['w0'] = unif((N_AB, W_A), -5.0, 0.0)
    inputs['w2'] = nrm((N_AB, LORA_W, W_A), 0.1)
    inputs['a0'] = nrm((N_AB, W_A), 0.5)
    inputs['a2'] = nrm((N_AB, LORA_A, W_A), 0.1)
    inputs['g2'] = nrm((N_AB, LORA_G, W_A), LORA_G ** -0.5)
    inputs['k_k'] = 0.85 + nrm((N_AB, W_A), 0.02)
    inputs['k_a'] = 1.0 + nrm((N_AB, W_A), 0.02)
    inputs['r_k'] = nrm((N_AB, H_A, HD_A), 0.1)
    inputs['lnx_w'] = 1.0 + nrm((N_AB, W_A), 0.02)
    inputs['lnx_b'] = nrm((N_AB, W_A), 0.02)
    inputs['conv_w'] = nrm((N_AB, CONV_W, XBC), CONV_W ** -0.5)
    inputs['conv_b'] = nrm((N_AB, XBC), 0.02)
    dt0 = jnp.exp(unif((N_AB, H_B), math.log(1e-3), math.log(1e-1)))
    inputs['dt_bias'] = dt0 + jnp.log(-jnp.expm1(-dt0))
    inputs['a_log'] = jnp.log(unif((N_AB, H_B), 1.0, 16.0))
    inputs['d_skip'] = 1.0 + nrm((N_AB, H_B), 0.1)
    inputs['norm_b_w'] = 1.0 + nrm((N_AB, W_B), 0.02)
    inputs['w_in_c'] = nrm((N_C, d, IN_C), d ** -0.5)
    inputs['w_out_c'] = nrm((N_C, W_C, d), W_C ** -0.5)
    inputs['lb_param'] = nrm((N_C, W_C), 0.1)
    inputs['norm_c_w'] = 1.0 + nrm((N_C, W_C), 0.02)
    inputs['w_gate'] = nrm((DEPTH, d, D_FF), d ** -0.5)
    inputs['w_up'] = nrm((DEPTH, d, D_FF), d ** -0.5)
    inputs['w_down'] = nrm((DEPTH, D_FF, d), D_FF ** -0.5)
    return inputs


def reference(x_prompt, x_sample, state_rwkv, state_rwkv_shift, state_ssm, state_conv, state_hgrn,
              c_prompt, c_sample, norm_mix_w, norm_ffn_w, norm_out_w, ada_w, ada_b,
              w_in_ab, w_out_ab, mu_a, w0, w2, a0, a2, g2, k_k, k_a, r_k, lnx_w, lnx_b,
              conv_w, conv_b, dt_bias, a_log, d_skip, norm_b_w,
              w_in_c, w_out_c, lb_param, norm_c_w, w_gate, w_up, w_down):
    weights = (norm_mix_w, norm_ffn_w, norm_out_w, ada_w, ada_b,
               w_in_ab, w_out_ab, mu_a, w0, w2, a0, a2, g2, k_k, k_a, r_k, lnx_w, lnx_b,
               conv_w, conv_b, dt_bias, a_log, d_skip, norm_b_w,
               w_in_c, w_out_c, lb_param, norm_c_w, w_gate, w_up, w_down)
    bp = x_prompt.shape[0]
    z_rwkv = jnp.zeros((bp, N_AB, H_A, HD_A, HD_A), jnp.float32)
    z_shift = jnp.zeros((bp, N_AB, A_COLS), x_prompt.dtype)
    z_ssm = jnp.zeros((bp, N_AB, H_B, HD_B, N_B), jnp.float32)
    z_conv = jnp.zeros((bp, N_AB, CONV_W - 1, XBC), x_prompt.dtype)
    z_hgrn = jnp.zeros((bp, N_C, H_C, DK_C, DV_C), jnp.float32)
    y_prompt, p_rwkv, p_shift, p_ssm, p_conv, p_hgrn = trunk(
        x_prompt, c_prompt, z_rwkv, z_shift, z_ssm, z_conv, z_hgrn, *weights)
    y_sample, s_rwkv, s_shift, s_ssm, s_conv, s_hgrn = trunk(
        x_sample, c_sample, state_rwkv, state_rwkv_shift, state_ssm, state_conv, state_hgrn, *weights)
    return (y_prompt, y_sample, p_rwkv, p_shift, p_ssm, p_conv, p_hgrn,
            s_rwkv, s_shift, s_ssm, s_conv, s_hgrn)
```

```cpp
#include <hip/hip_runtime.h>
#include <hip/hip_cooperative_groups.h>
#include <cstdio>
namespace cg = cooperative_groups;

typedef unsigned short u16;
typedef __attribute__((ext_vector_type(8))) short bf16x8;
typedef __attribute__((ext_vector_type(4))) float f32x4;

#define NT 16512
#define PSTR 4480

#define O_RWKV_P 16908288ull
#define O_SHIFT_P 17039360ull
#define O_SSM_P 17046528ull
#define O_CONV_P 17570816ull
#define O_HGRN_P 17589248ull
#define O_RWKV_S 18113536ull
#define O_SHIFT_S 18637824ull
#define O_SSM_S 18666496ull
#define O_CONV_S 20763648ull
#define O_HGRN_S 20837376ull

struct Params {
  const float *x_prompt, *x_sample, *st_rwkv, *st_shift, *st_ssm, *st_conv, *st_hgrn, *c_prompt, *c_sample;
  const float *norm_mix_w, *norm_ffn_w, *norm_out_w, *ada_w, *ada_b, *w_in_ab, *w_out_ab, *mu_a, *w0, *w2, *a0, *a2,
      *g2, *k_k, *k_a, *r_k, *lnx_w, *lnx_b, *conv_w, *conv_b, *dt_bias, *a_log, *d_skip, *norm_b_w, *w_in_c,
      *w_out_c, *lb_param, *norm_c_w, *w_gate, *w_up, *w_down;
  float* out;
  float *mod, *bonus, *dtb;
  u16 *wb_in, *wb_out, *wb_gu, *wb_dn, *hm, *pbuf, *rw, *cv;
  float* scr;
  u16* ub;
  u16 *w2t, *a2t, *g2t;
  unsigned* bar;
  int p0, p1;
};

typedef const __attribute__((address_space(4))) Params& CP;
typedef const __attribute__((address_space(4))) Params* CPP;
__device__ __forceinline__ CPP getp() {
  CPP pp = (CPP)__builtin_amdgcn_kernarg_segment_ptr();
  asm volatile("" : "+s"(pp) : : "memory");
  return pp;
}
__device__ __forceinline__ int otid() {
  int t = threadIdx.x;
  asm volatile("" : "+v"(t));
  return t;
}
__device__ __forceinline__ float bf2f(u16 u) { return __uint_as_float(((unsigned)u) << 16); }
typedef float f32x2_t __attribute__((ext_vector_type(2)));
typedef __bf16 bf16x2_t __attribute__((ext_vector_type(2)));
__device__ __forceinline__ unsigned pack2(float a, float b) {
  f32x2_t v = {a, b};
  bf16x2_t r = __builtin_convertvector(v, bf16x2_t);
  return __builtin_bit_cast(unsigned, r);
}
__device__ __forceinline__ u16 f2bf(float f) { return (u16)(pack2(f, f) & 0xffffu); }
__device__ __forceinline__ float lo16(unsigned v) { return __uint_as_float(v << 16); }
__device__ __forceinline__ float hi16(unsigned v) { return __uint_as_float(v & 0xffff0000u); }
__device__ __forceinline__ float sigm(float x) { return __builtin_amdgcn_rcpf(1.f + __expf(-x)); }
__device__ __forceinline__ float silu_(float x) { return x * __builtin_amdgcn_rcpf(1.f + __expf(-x)); }
__device__ __forceinline__ float softplus_(float x) {
  const float e = __expf(x);
  return x > 20.f ? x : (e < 1e-4f ? e * (1.f - 0.5f * e) : __logf(1.f + e));
}
__device__ __forceinline__ float tanh_(float x) { return 1.f - 2.f * __builtin_amdgcn_rcpf(1.f + __expf(2.f * x)); }

__device__ __forceinline__ int row_seq(int m) { return m < 16384 ? (m >> 13) : 2 + ((m - 16384) >> 4); }
__device__ __forceinline__ int seq_row0(int s) { return s < 2 ? s * 8192 : 16384 + (s - 2) * 16; }
__device__ __forceinline__ int seq_len(int s) { return s < 2 ? 8192 : 16; }
__device__ __forceinline__ float* out_state(float* out, int s, int j, size_t baseP, size_t baseS, size_t sz) {
  return s < 2 ? out + baseP + (size_t)(s * 2 + j) * sz : out + baseS + (size_t)((s - 2) * 2 + j) * sz;
}

template <int CTRL>
__device__ __forceinline__ float dpp_f(float x) {
  return __int_as_float(__builtin_amdgcn_update_dpp(0, __float_as_int(x), CTRL, 0xf, 0xf, false));
}
__device__ __forceinline__ float red16(float x) {
  x += dpp_f<0xB1>(x);
  x += dpp_f<0x4E>(x);
  x += dpp_f<0x124>(x);
  x += dpp_f<0x128>(x);
  return x;
}
__device__ __forceinline__ float red32_hi(float x) {
  x = red16(x);
  float y = __int_as_float(__builtin_amdgcn_update_dpp(0, __float_as_int(x), 0x142, 0xA, 0xf, false));
  return x + y;
}
__device__ __forceinline__ float wave_sum(float x) {
  x = red16(x);
  x += __int_as_float(__builtin_amdgcn_update_dpp(0, __float_as_int(x), 0x142, 0xA, 0xf, false));
  x += __int_as_float(__builtin_amdgcn_update_dpp(0, __float_as_int(x), 0x143, 0xC, 0xf, false));
  return __int_as_float(__builtin_amdgcn_readlane(__float_as_int(x), 63));
}

__device__ void phase_mod(CP p, char* smem, int bid, int nb) {
  if (bid >= 384) return;
  float* sc = (float*)smem;
  float* red = sc + 10 * 1024;
  const int tid = otid(), lane = tid & 63, wv = tid >> 6;
  for (int i = tid; i < 10 * 1024; i += 256) {
    int s = i >> 10, k = i & 1023;
    float c = s < 2 ? p.c_prompt[s * 1024 + k] : p.c_sample[(s - 2) * 1024 + k];
    sc[i] = silu_(c);
  }
  __syncthreads();
  for (int u = bid; u < 384; u += nb) {
    int L = u / 96, cgp = u % 96;
    int col = cgp * 64 + lane;
    const float* W = p.ada_w + (size_t)L * 1024 * 6144 + col;
    float acc[10];
#pragma unroll
    for (int s = 0; s < 10; s++) acc[s] = 0.f;
    int k0 = wv * 256;
#pragma unroll 4
    for (int k = k0; k < k0 + 256; k += 4) {
      float w0 = W[(size_t)k * 6144], w1 = W[(size_t)(k + 1) * 6144], w2 = W[(size_t)(k + 2) * 6144],
            w3 = W[(size_t)(k + 3) * 6144];
#pragma unroll
      for (int s = 0; s < 10; s++) {
        float4 c4 = *(const float4*)&sc[s * 1024 + k];
        acc[s] += c4.x * w0 + c4.y * w1 + c4.z * w2 + c4.w * w3;
      }
    }
#pragma unroll
    for (int s = 0; s < 10; s++) red[(wv * 10 + s) * 64 + lane] = acc[s];
    __syncthreads();
    for (int i = tid; i < 640; i += 256) {
      int s = i >> 6, l = i & 63;
      float v = red[(0 * 10 + s) * 64 + l] + red[(1 * 10 + s) * 64 + l] + red[(2 * 10 + s) * 64 + l] +
                red[(3 * 10 + s) * 64 + l];
      int c = cgp * 64 + l;
      p.mod[((size_t)L * 10 + s) * 6144 + c] = v + p.ada_b[L * 6144 + c];
    }
    __syncthreads();
  }
}

__device__ __forceinline__ void wconv_tile(const float* __restrict__ src, int K, int N, u16* __restrict__ dst, int k0,
                                           int n0, int mode, float* tile) {
  const int tid = otid();
#pragma unroll
  for (int i = 0; i < 4; i++) {
    int r = i * 16 + (tid >> 4), c = (tid & 15) * 4;
    int n = n0 + c;
    float4 v4 = n < N ? *(const float4*)(src + (size_t)(k0 + r) * N + n) : make_float4(0.f, 0.f, 0.f, 0.f);
    tile[r * 65 + c] = v4.x; tile[r * 65 + c + 1] = v4.y; tile[r * 65 + c + 2] = v4.z; tile[r * 65 + c + 3] = v4.w;
  }
  __syncthreads();
  int n = tid >> 2, kc = (tid & 3) * 16;
  unsigned pk[8];
#pragma unroll
  for (int i = 0; i < 8; i++) pk[i] = pack2(tile[(kc + 2 * i) * 65 + n], tile[(kc + 2 * i + 1) * 65 + n]);
  int gn = n0 + n;
  int row = mode == 0 ? gn : ((gn >> 4) * 32 + (gn & 15) + (mode == 2 ? 16 : 0));
  uint4* d = (uint4*)(dst + (size_t)row * K + k0 + kc);
  d[0] = make_uint4(pk[0], pk[1], pk[2], pk[3]);
  d[1] = make_uint4(pk[4], pk[5], pk[6], pk[7]);
  __syncthreads();
}

__device__ void phase_wconv(CP p, int L, char* smem, int bid, int nb) {
  float* tile = (float*)smem;
  const int j = L >> 1;
  const bool even = (L & 1) == 0;
  const int ntn_in = even ? 70 : 64;
  const int n_in = 16 * ntn_in;
  const int n_out = even ? 24 * 16 : 16 * 16;
  const int n_g = 16 * 44;
  const int n_lora = even ? 32 : 0;
  const int total = n_in + n_out + 3 * n_g + n_lora;
  for (int u = bid; u < total; u += nb) {
    int li = u;
    if (li < n_in) {
      int kt = li / ntn_in, nt = li % ntn_in;
      if (even)
        wconv_tile(p.w_in_ab + (size_t)j * 1024 * 4368, 1024, 4368, p.wb_in, kt * 64, nt * 64, 0, tile);
      else
        wconv_tile(p.w_in_c + (size_t)j * 1024 * 4096, 1024, 4096, p.wb_in, kt * 64, nt * 64, 0, tile);
      continue;
    }
    li -= n_in;
    if (li < n_out) {
      int kt = li / 16, nt = li % 16;
      if (even)
        wconv_tile(p.w_out_ab + (size_t)j * 1536 * 1024, 1536, 1024, p.wb_out, kt * 64, nt * 64, 0, tile);
      else
        wconv_tile(p.w_out_c + (size_t)j * 1024 * 1024, 1024, 1024, p.wb_out, kt * 64, nt * 64, 0, tile);
      continue;
    }
    li -= n_out;
    if (li < n_g) {
      int kt = li / 44, nt = li % 44;
      wconv_tile(p.w_gate + (size_t)L * 1024 * 2816, 1024, 2816, p.wb_gu, kt * 64, nt * 64, 1, tile);
      continue;
    }
    li -= n_g;
    if (li < n_g) {
      int kt = li / 44, nt = li % 44;
      wconv_tile(p.w_up + (size_t)L * 1024 * 2816, 1024, 2816, p.wb_gu, kt * 64, nt * 64, 2, tile);
      continue;
    }
    li -= n_g;
    if (li < n_g) {
      int kt = li / 16, nt = li % 16;
      wconv_tile(p.w_down + (size_t)L * 2816 * 1024, 2816, 1024, p.wb_dn, kt * 64, nt * 64, 0, tile);
      continue;
    }
    li -= n_g;
    if (li < 8) wconv_tile(p.w2 + (size_t)j * 64 * 512, 64, 512, p.w2t, 0, li * 64, 0, tile);
    else if (li < 16) wconv_tile(p.a2 + (size_t)j * 64 * 512, 64, 512, p.a2t, 0, (li - 8) * 64, 0, tile);
    else wconv_tile(p.g2 + (size_t)j * 128 * 512, 128, 512, p.g2t, ((li - 16) >> 3) * 64, ((li - 16) & 7) * 64, 0, tile);
  }
}

__device__ void phase_norm(CP p, int L, int which, int bid, int nb) {
  const int tid = otid(), lane = tid & 63, wv = tid >> 6;
  const bool first = (L == 0 && which == 0);
  const float* nw = (which ? p.norm_ffn_w : p.norm_mix_w) + L * 1024;
  float* X = p.out;
  for (int row = bid * 4 + wv; row < NT; row += nb * 4) {
    const float* x = first ? (row < 16384 ? p.x_prompt + (size_t)row * 1024 : p.x_sample + (size_t)(row - 16384) * 1024)
                           : X + (size_t)row * 1024;
    float4 v[4];
    float ss = 0.f;
#pragma unroll
    for (int i = 0; i < 4; i++) {
      v[i] = *(const float4*)(x + i * 256 + lane * 4);
      ss += v[i].x * v[i].x + v[i].y * v[i].y + v[i].z * v[i].z + v[i].w * v[i].w;
    }
    ss = wave_sum(ss);
    float rstd = rsqrtf(ss * (1.f / 1024.f) + 1e-6f);
    int s = row_seq(row);
    const float* md = p.mod + ((size_t)L * 10 + s) * 6144 + (which ? 3072 : 0);
#pragma unroll
    for (int i = 0; i < 4; i++) {
      int c = i * 256 + lane * 4;
      float4 w4 = *(const float4*)(nw + c);
      float4 sh = *(const float4*)(md + c);
      float4 sc = *(const float4*)(md + 1024 + c);
      float h0 = v[i].x * rstd * w4.x * (1.f + sc.x) + sh.x;
      float h1 = v[i].y * rstd * w4.y * (1.f + sc.y) + sh.y;
      float h2 = v[i].z * rstd * w4.z * (1.f + sc.z) + sh.z;
      float h3 = v[i].w * rstd * w4.w * (1.f + sc.w) + sh.w;
      *(uint2*)(p.hm + (size_t)row * 1024 + c) = make_uint2(pack2(h0, h1), pack2(h2, h3));
      if (first) *(float4*)(X + (size_t)row * 1024 + c) = v[i];
    }
  }
}

__device__ void phase_final(CP p, int bid, int nb) {
  const int tid = otid(), lane = tid & 63, wv = tid >> 6;
  float* X = p.out;
  for (int row = bid * 4 + wv; row < NT; row += nb * 4) {
    float* x = X + (size_t)row * 1024;
    float4 v[4];
    float ss = 0.f;
#pragma unroll
    for (int i = 0; i < 4; i++) {
      v[i] = *(const float4*)(x + i * 256 + lane * 4);
      ss += v[i].x * v[i].x + v[i].y * v[i].y + v[i].z * v[i].z + v[i].w * v[i].w;
    }
    ss = wave_sum(ss);
    float rstd = rsqrtf(ss * (1.f / 1024.f) + 1e-6f);
#pragma unroll
    for (int i = 0; i < 4; i++) {
      int c = i * 256 + lane * 4;
      float4 w4 = *(const float4*)(p.norm_out_w + c);
      float4 o;
      o.x = v[i].x * rstd * w4.x;
      o.y = v[i].y * rstd * w4.y;
      o.z = v[i].z * rstd * w4.z;
      o.w = v[i].w * rstd * w4.w;
      *(float4*)(x + c) = o;
    }
  }
}

__device__ void gemm_phase(CP p, const u16* __restrict__ A, int lda, const u16* __restrict__ Bt, int K,
                           int ntn, int epi, u16* __restrict__ outb, int ldo, int ncols, const float* __restrict__ gate,
                           char* smem, int bid, int nb) {
  u16* As = (u16*)smem;
  u16* Bs = As + 128 * 64;
  const int tid = otid(), lane = tid & 63, wv = tid >> 6;
  const int wm = wv >> 1, wn = wv & 1;
  const int lr = tid >> 3, lc = tid & 7;
  const int l15 = lane & 15, lq = lane >> 4;
  const int nk = K >> 6;
  const int nitems = (epi == 2) ? 128 * ntn + 8 * ntn : 129 * ntn;
#define G_DECODE(tile_, mt_, nt_, kt0_, kt1_, split_) { \
    kt0_ = 0; kt1_ = nk; split_ = false; \
    if (epi == 2 && (tile_) >= 128 * ntn) { \
      const int r_ = (tile_) - 128 * ntn; \
      mt_ = 128; nt_ = r_ >> 3; split_ = true; \
      kt0_ = ((r_ & 7) * nk) >> 3; kt1_ = (((r_ & 7) + 1) * nk) >> 3; \
    } else if (epi == 2 && nb == 512 && ntn == 4) { \
        \
      const int slot_ = (tile_) >> 3; \
      mt_ = ((tile_) & 7) * 16 + (slot_ >> 2); nt_ = slot_ & 3; \
    } else { mt_ = (tile_) / ntn; nt_ = (tile_) % ntn; } }
  uint4 ra0, ra1, ra2, ra3, rb0, rb1, rb2, rb3, rb4, rb5, rb6, rb7;
  const int voA = lr * lda + lc * 8, voB = lr * K + lc * 8;
  const int sA = 32 * lda, sB = 32 * K;
#define G_LOADP(ab_, bb_, kt_) { const u16* ag_ = (ab_) + (kt_) * 64; const u16* bg_ = (bb_) + (kt_) * 64; \
    ra0 = *(const uint4*)(ag_ + voA); ra1 = *(const uint4*)((ag_ + sA) + voA); ra2 = *(const uint4*)((ag_ + 2 * sA) + voA); ra3 = *(const uint4*)((ag_ + 3 * sA) + voA); \
    rb0 = *(const uint4*)(bg_ + voB); rb1 = *(const uint4*)((bg_ + sB) + voB); rb2 = *(const uint4*)((bg_ + 2 * sB) + voB); rb3 = *(const uint4*)((bg_ + 3 * sB) + voB); \
    rb4 = *(const uint4*)((bg_ + 4 * sB) + voB); rb5 = *(const uint4*)((bg_ + 5 * sB) + voB); rb6 = *(const uint4*)((bg_ + 6 * sB) + voB); rb7 = *(const uint4*)((bg_ + 7 * sB) + voB); }
  bool have = false;
  if (bid >= (nb >> 1)) __builtin_amdgcn_s_sleep(10);
  for (int tile = bid; tile < nitems; tile += nb) {
    int mt, nt, kt0, kt1;
    bool split;
    G_DECODE(tile, mt, nt, kt0, kt1, split)
    const int m0 = mt * 128, n0 = nt * 256;
    f32x4 acc0[4][4], acc1[4][4];
#pragma unroll
    for (int a = 0; a < 4; a++)
#pragma unroll
      for (int b = 0; b < 4; b++) { acc0[a][b] = (f32x4){0.f, 0.f, 0.f, 0.f}; acc1[a][b] = (f32x4){0.f, 0.f, 0.f, 0.f}; }
    const u16* Ab = A + (size_t)m0 * lda;
    const u16* Bb = Bt + (size_t)n0 * K;
    u16* Aw = As + lr * 64 + ((lc ^ (lr & 7)) * 8);
    u16* Bw = Bs + lr * 64 + ((lc ^ (lr & 7)) * 8);
    if (!have) G_LOADP(Ab, Bb, kt0)
    for (int kt = kt0; kt < kt1; kt++) {
      __syncthreads();
      *(uint4*)(Aw) = ra0; *(uint4*)(Aw + 32 * 64) = ra1; *(uint4*)(Aw + 64 * 64) = ra2; *(uint4*)(Aw + 96 * 64) = ra3;
      *(uint4*)(Bw) = rb0; *(uint4*)(Bw + 32 * 64) = rb1; *(uint4*)(Bw + 64 * 64) = rb2; *(uint4*)(Bw + 96 * 64) = rb3;
      *(uint4*)(Bw + 128 * 64) = rb4; *(uint4*)(Bw + 160 * 64) = rb5; *(uint4*)(Bw + 192 * 64) = rb6; *(uint4*)(Bw + 224 * 64) = rb7;
      __syncthreads();
      if (kt + 1 < kt1) G_LOADP(Ab, Bb, kt + 1)
      {
        const int sw0 = (lq ^ (l15 & 7)) * 8, sw1 = ((lq + 4) ^ (l15 & 7)) * 8;
        __builtin_amdgcn_s_setprio(1);
        const u16* Ar = As + (wm * 64 + l15) * 64;
        const u16* Br = Bs + (wn * 128 + l15) * 64;
        bf16x8 af0[4];
#pragma unroll
        for (int mi = 0; mi < 4; mi++) af0[mi] = *(const bf16x8*)(Ar + mi * 16 * 64 + sw0);
        bf16x8 bq0 = *(const bf16x8*)(Br + sw0);
        bf16x8 bq1 = *(const bf16x8*)(Br + 16 * 64 + sw0);
        __builtin_amdgcn_sched_barrier(0);
#define G_STEP(ACC, nidx, bcur, nextni, nextsw, donext) { \
          bf16x8 bn_ = bcur; \
          if (donext) bcur = *(const bf16x8*)(Br + (nextni) * 16 * 64 + (nextsw)); \
          _Pragma("unroll") for (int mi = 0; mi < 4; mi++) \
            ACC[mi][nidx] = __builtin_amdgcn_mfma_f32_16x16x32_bf16(af0[mi], bn_, ACC[mi][nidx], 0, 0, 0); \
          __builtin_amdgcn_sched_barrier(0); }
        G_STEP(acc0, 0, bq0, 2, sw0, true)
        G_STEP(acc0, 1, bq1, 3, sw0, true)
        G_STEP(acc0, 2, bq0, 4, sw0, true)
        G_STEP(acc0, 3, bq1, 5, sw0, true)
        G_STEP(acc1, 0, bq0, 6, sw0, true)
        G_STEP(acc1, 1, bq1, 7, sw0, true)
        G_STEP(acc1, 2, bq0, 0, sw1, true)
        G_STEP(acc1, 3, bq1, 1, sw1, true)
#pragma unroll
        for (int mi = 0; mi < 4; mi++) af0[mi] = *(const bf16x8*)(Ar + mi * 16 * 64 + sw1);
        __builtin_amdgcn_sched_barrier(0);
        G_STEP(acc0, 0, bq0, 2, sw1, true)
        G_STEP(acc0, 1, bq1, 3, sw1, true)
        G_STEP(acc0, 2, bq0, 4, sw1, true)
        G_STEP(acc0, 3, bq1, 5, sw1, true)
        G_STEP(acc1, 0, bq0, 6, sw1, true)
        G_STEP(acc1, 1, bq1, 7, sw1, true)
        G_STEP(acc1, 2, bq0, 0, 0, false)
        G_STEP(acc1, 3, bq1, 0, 0, false)
        __builtin_amdgcn_s_setprio(0);
      }
    }
    {
      const int ntile = tile + nb;
      have = ntile < nitems;
      if (have) {
        int mt2, nt2, k0n, k1n; bool sp2;
        G_DECODE(ntile, mt2, nt2, k0n, k1n, sp2)
        (void)k1n; (void)sp2;
        G_LOADP(A + (size_t)(mt2 * 128) * lda, Bt + (size_t)(nt2 * 256) * K, k0n)
      }
    }
    if (epi == 2) {
#pragma unroll
      for (int mi = 0; mi < 4; mi++)
#pragma unroll
        for (int jj = 0; jj < 4; jj++) {
          int row = m0 + wm * 64 + mi * 16 + lq * 4 + jj;
          int s = row_seq(row);
          const float* g = gate + (size_t)s * 6144;
          float* xr = p.out + (size_t)row * 1024;
#pragma unroll
          for (int ni = 0; ni < 4; ni++) {
            int col = n0 + wn * 128 + ni * 16 + l15;
            if (split) { atomicAdd(&xr[col], g[col] * acc0[mi][ni][jj]); atomicAdd(&xr[col + 64], g[col + 64] * acc1[mi][ni][jj]); }
            else { xr[col] += g[col] * acc0[mi][ni][jj]; xr[col + 64] += g[col + 64] * acc1[mi][ni][jj]; }
          }
        }
    } else if (epi == 0) {
      u16* Cs = (u16*)smem;
#define EPI0_HALF(hp, ACC) { \
        __syncthreads(); \
        _Pragma("unroll") for (int mi = 0; mi < 4; mi++) \
          _Pragma("unroll") for (int n4 = 0; n4 < 4; n4++) \
            _Pragma("unroll") for (int jj = 0; jj < 4; jj++) { \
              int r = wm * 64 + mi * 16 + lq * 4 + jj, c = wn * 64 + n4 * 16 + l15; \
              Cs[r * 136 + c] = f2bf(ACC[mi][n4][jj]); } \
        __syncthreads(); \
        _Pragma("unroll") for (int i = 0; i < 8; i++) { \
          int q = tid + 256 * i; \
          int r = q >> 4, ch = q & 15; \
          int gcol = n0 + (ch >> 3) * 128 + (hp) * 64 + (ch & 7) * 8; \
          if (gcol < ncols) *(uint4*)(outb + (size_t)(m0 + r) * ldo + gcol) = *(const uint4*)(Cs + r * 136 + ch * 8); } }
      EPI0_HALF(0, acc0)
      EPI0_HALF(1, acc1)
    } else {
      __syncthreads();
      u16* Cs = (u16*)smem;
#pragma unroll
      for (int mi = 0; mi < 4; mi++)
#pragma unroll
        for (int i2 = 0; i2 < 2; i2++)
#pragma unroll
          for (int jj = 0; jj < 4; jj++) {
            int r = wm * 64 + mi * 16 + lq * 4 + jj, c = wn * 64 + i2 * 16 + l15;
            float g0 = acc0[mi][2 * i2][jj], u0 = acc0[mi][2 * i2 + 1][jj];
            float g1 = acc1[mi][2 * i2][jj], u1 = acc1[mi][2 * i2 + 1][jj];
            Cs[r * 136 + c] = f2bf(silu_(g0) * u0);
            Cs[r * 136 + c + 32] = f2bf(silu_(g1) * u1);
          }
      __syncthreads();
#pragma unroll
      for (int i = 0; i < 8; i++) {
        int q = tid + 256 * i;
        int r = q >> 4, ch = q & 15;
        *(uint4*)(outb + (size_t)(m0 + r) * ldo + nt * 128 + ch * 8) = *(const uint4*)(Cs + r * 136 + ch * 8);
      }
    }
  }
}

__device__ void phase_prep_even(CP p, int j, char* smem, int bid, int nb) {
  const int tid = otid();
  const u16* P = p.pbuf;
  {
    u16* txb = (u16*)smem;
    u16* xab = txb + 16 * 72;
    float* resw = (float*)(xab + 16 * 72);
    float* resa = resw + 8 * 512;
    for (int i = tid; i < 2 * 16 * 72; i += 256) txb[i] = 0;
    const int half = tid >> 7, hk = tid & 127, h = hk >> 4, kq = hk & 15;
    const int c4 = h * 64 + kq * 4;
    const float* mu = p.mu_a + j * 1792;
    for (int u = bid; u < NT / 8; u += nb) {
      const int m0 = u * 8;
      const int s = row_seq(m0);
      const int r0 = seq_row0(s);
      __syncthreads();
#pragma unroll
      for (int i = 0; i < 4; i++) {
        int idx = tid + 256 * i;
        int tok = idx >> 7, cc = idx & 127;
        int m = m0 + tok;
        int col = 1536 + cc;
        float pc = bf2f(P[(size_t)m * PSTR + col]);
        float pp = (m > r0) ? bf2f(P[(size_t)(m - 1) * PSTR + col])
                            : (s >= 2 ? p.st_shift[((size_t)(s - 2) * 2 + j) * 1792 + col] : 0.f);
        float pm = pc + (pp - pc) * mu[col];
        if (cc < 64)
          txb[tok * 72 + cc] = f2bf(tanh_(pm));
        else
          xab[tok * 72 + cc - 64] = f2bf(pm);
      }
      __syncthreads();
      {
        const int lane = tid & 63, wv = tid >> 6, l15 = lane & 15, lq = lane >> 4;
        bf16x8 aw[2], aa[2];
#pragma unroll
        for (int ks = 0; ks < 2; ks++) {
          aw[ks] = *(const bf16x8*)(txb + l15 * 72 + ks * 32 + lq * 8);
          aa[ks] = *(const bf16x8*)(xab + l15 * 72 + ks * 32 + lq * 8);
        }
#pragma unroll
        for (int nt = 0; nt < 8; nt++) {
          const int n = wv * 128 + nt * 16 + l15;
          f32x4 cw = (f32x4){0.f, 0.f, 0.f, 0.f}, ca = (f32x4){0.f, 0.f, 0.f, 0.f};
#pragma unroll
          for (int ks = 0; ks < 2; ks++) {
            bf16x8 bw = *(const bf16x8*)(p.w2t + (size_t)n * 64 + ks * 32 + lq * 8);
            bf16x8 ba = *(const bf16x8*)(p.a2t + (size_t)n * 64 + ks * 32 + lq * 8);
            cw = __builtin_amdgcn_mfma_f32_16x16x32_bf16(aw[ks], bw, cw, 0, 0, 0);
            ca = __builtin_amdgcn_mfma_f32_16x16x32_bf16(aa[ks], ba, ca, 0, 0, 0);
          }
          if (lq < 2) {
#pragma unroll
            for (int jj = 0; jj < 4; jj++) {
              resw[(lq * 4 + jj) * 512 + n] = cw[jj];
              resa[(lq * 4 + jj) * 512 + n] = ca[jj];
            }
          }
        }
      }
      __syncthreads();
      float accw[4][4], acca[4][4];
#pragma unroll
      for (int tk = 0; tk < 4; tk++) {
        float4 rw4 = *(const float4*)(resw + (half * 4 + tk) * 512 + c4);
        float4 ra4 = *(const float4*)(resa + (half * 4 + tk) * 512 + c4);
        accw[tk][0] = rw4.x; accw[tk][1] = rw4.y; accw[tk][2] = rw4.z; accw[tk][3] = rw4.w;
        acca[tk][0] = ra4.x; acca[tk][1] = ra4.y; acca[tk][2] = ra4.z; acca[tk][3] = ra4.w;
      }
      float4 w0v = *(const float4*)(p.w0 + j * 512 + c4);
      float4 a0v = *(const float4*)(p.a0 + j * 512 + c4);
      float4 kkv = *(const float4*)(p.k_k + j * 512 + c4);
      float4 kav = *(const float4*)(p.k_a + j * 512 + c4);
      float4 rkv = *(const float4*)(p.r_k + j * 512 + c4);
      float4 mur = *(const float4*)(mu + c4);
      float4 muk = *(const float4*)(mu + 512 + c4);
      float4 muv = *(const float4*)(mu + 1024 + c4);
      const float w0a[4] = {w0v.x, w0v.y, w0v.z, w0v.w};
      const float a0a[4] = {a0v.x, a0v.y, a0v.z, a0v.w};
      const float kka[4] = {kkv.x, kkv.y, kkv.z, kkv.w};
      const float kaa[4] = {kav.x, kav.y, kav.z, kav.w};
      const float rka[4] = {rkv.x, rkv.y, rkv.z, rkv.w};
      const float mura[4] = {mur.x, mur.y, mur.z, mur.w};
      const float muka[4] = {muk.x, muk.y, muk.z, muk.w};
      const float muva[4] = {muv.x, muv.y, muv.z, muv.w};
#pragma unroll
      for (int tk = 0; tk < 4; tk++) {
        const int m = m0 + half * 4 + tk;
        uint2 pr = *(const uint2*)(P + (size_t)m * PSTR + c4);
        uint2 pk = *(const uint2*)(P + (size_t)m * PSTR + 512 + c4);
        uint2 pv = *(const uint2*)(P + (size_t)m * PSTR + 1024 + c4);
        float rc[4] = {lo16(pr.x), hi16(pr.x), lo16(pr.y), hi16(pr.y)};
        float kc[4] = {lo16(pk.x), hi16(pk.x), lo16(pk.y), hi16(pk.y)};
        float vc[4] = {lo16(pv.x), hi16(pv.x), lo16(pv.y), hi16(pv.y)};
        float rp[4], kp[4], vp[4];
        if (m > r0) {
          uint2 qr = *(const uint2*)(P + (size_t)(m - 1) * PSTR + c4);
          uint2 qk = *(const uint2*)(P + (size_t)(m - 1) * PSTR + 512 + c4);
          uint2 qv = *(const uint2*)(P + (size_t)(m - 1) * PSTR + 1024 + c4);
          rp[0] = lo16(qr.x); rp[1] = hi16(qr.x); rp[2] = lo16(qr.y); rp[3] = hi16(qr.y);
          kp[0] = lo16(qk.x); kp[1] = hi16(qk.x); kp[2] = lo16(qk.y); kp[3] = hi16(qk.y);
          vp[0] = lo16(qv.x); vp[1] = hi16(qv.x); vp[2] = lo16(qv.y); vp[3] = hi16(qv.y);
        } else if (s >= 2) {
          const float* sp = p.st_shift + ((size_t)(s - 2) * 2 + j) * 1792;
#pragma unroll
          for (int e = 0; e < 4; e++) { rp[e] = sp[c4 + e]; kp[e] = sp[512 + c4 + e]; vp[e] = sp[1024 + c4 + e]; }
        } else {
#pragma unroll
          for (int e = 0; e < 4; e++) { rp[e] = 0.f; kp[e] = 0.f; vp[e] = 0.f; }
        }
        float r[4], k[4], v[4], kk[4], kn[4], bb[4], ee[4];
        float ssq = 0.f, bsum = 0.f;
#pragma unroll
        for (int e = 0; e < 4; e++) {
          r[e] = rc[e] + (rp[e] - rc[e]) * mura[e];
          k[e] = kc[e] + (kp[e] - kc[e]) * muka[e];
          v[e] = vc[e] + (vp[e] - vc[e]) * muva[e];
          float wpre = w0a[e] + accw[tk][e];
          float w = -softplus_(-wpre) - 0.5f;
          { const float ew = __expf(w); ee[e] = ew < 1e-3f ? ew * (1.f - 0.5f * ew) : 1.f - __expf(-ew); }
          float a = sigm(a0a[e] + acca[tk][e]);
          kk[e] = k[e] * kka[e];
          ssq += kk[e] * kk[e];
          kn[e] = k[e] * (1.f + (a - 1.f) * kaa[e]);
          bb[e] = a;
          bsum += r[e] * kn[e] * rka[e];
        }
        ssq = red16(ssq);
        bsum = red16(bsum);
        float inv = rsqrtf(fmaxf(ssq, 1e-24f));
#pragma unroll
        for (int e = 0; e < 4; e++) { kk[e] *= inv; bb[e] = kk[e] * bb[e]; }
        if (kq == 0) p.bonus[(size_t)m * 8 + h] = bsum;
        uint4* dst = (uint4*)(p.rw + (((size_t)m * 8 + h) * 16 + kq) * 24);
        dst[0] = make_uint4(pack2(r[0], r[1]), pack2(r[2], r[3]), pack2(kn[0], kn[1]), pack2(kn[2], kn[3]));
        dst[1] = make_uint4(pack2(kk[0], kk[1]), pack2(kk[2], kk[3]), pack2(bb[0], bb[1]), pack2(bb[2], bb[3]));
        dst[2] = make_uint4(pack2(ee[0], ee[1]), pack2(ee[2], ee[3]), pack2(v[0], v[1]), pack2(v[2], v[3]));
      }
    }
  }
  for (int idx = bid * 256 + tid; idx < 10 * 1792; idx += nb * 256) {
    int s = idx / 1792, c = idx % 1792;
    int m = seq_row0(s) + seq_len(s) - 1;
    float* o = out_state(p.out, s, j, O_SHIFT_P, O_SHIFT_S, 1792);
    o[c] = bf2f(P[(size_t)m * PSTR + c]);
  }
  for (int u = bid; u < NT / 16; u += nb) {
    const int mb = u * 16;
    const int s = row_seq(mb);
    const int r0 = seq_row0(s);
    if (tid < 192) {
      const int c0 = tid * 8;
      const int t0 = mb - r0;
      float wgt[4][8], bia[8];
      {
        float4 b0 = *(const float4*)(p.conv_b + j * 1536 + c0), b1 = *(const float4*)(p.conv_b + j * 1536 + c0 + 4);
        bia[0] = b0.x; bia[1] = b0.y; bia[2] = b0.z; bia[3] = b0.w; bia[4] = b1.x; bia[5] = b1.y; bia[6] = b1.z; bia[7] = b1.w;
#pragma unroll
        for (int tap = 0; tap < 4; tap++) {
          const float* cw = p.conv_w + ((size_t)j * 4 + tap) * 1536 + c0;
          float4 w0 = *(const float4*)cw, w1 = *(const float4*)(cw + 4);
          wgt[tap][0] = w0.x; wgt[tap][1] = w0.y; wgt[tap][2] = w0.z; wgt[tap][3] = w0.w;
          wgt[tap][4] = w1.x; wgt[tap][5] = w1.y; wgt[tap][6] = w1.z; wgt[tap][7] = w1.w;
        }
      }
#pragma unroll 1
      for (int hf = 0; hf < 2; hf++) {
      uint4 rows[11];
#pragma unroll
      for (int i = 0; i < 11; i++) {
        const int tt = t0 + hf * 8 - 3 + i;
        if (tt >= 0) {
          rows[i] = *(const uint4*)(P + (size_t)(r0 + tt) * PSTR + 2816 + c0);
        } else if (s >= 2) {
          const float* cs = p.st_conv + (((size_t)(s - 2) * 2 + j) * 3 + (tt + 3)) * 1536 + c0;
          float4 q0 = *(const float4*)cs, q1 = *(const float4*)(cs + 4);
          rows[i] = make_uint4(pack2(q0.x, q0.y), pack2(q0.z, q0.w), pack2(q1.x, q1.y), pack2(q1.z, q1.w));
        } else {
          rows[i] = make_uint4(0, 0, 0, 0);
        }
      }
#pragma unroll
      for (int t = 0; t < 8; t++) {
        float acc[8];
#pragma unroll
        for (int e = 0; e < 8; e++) acc[e] = bia[e];
#pragma unroll
        for (int tap = 0; tap < 4; tap++) {
          const uint4 q = rows[t + tap];
          acc[0] += wgt[tap][0] * lo16(q.x); acc[1] += wgt[tap][1] * hi16(q.x);
          acc[2] += wgt[tap][2] * lo16(q.y); acc[3] += wgt[tap][3] * hi16(q.y);
          acc[4] += wgt[tap][4] * lo16(q.z); acc[5] += wgt[tap][5] * hi16(q.z);
          acc[6] += wgt[tap][6] * lo16(q.w); acc[7] += wgt[tap][7] * hi16(q.w);
        }
        *(uint4*)(p.cv + (size_t)(mb + hf * 8 + t) * 1536 + c0) =
            make_uint4(pack2(silu_(acc[0]), silu_(acc[1])), pack2(silu_(acc[2]), silu_(acc[3])),
                       pack2(silu_(acc[4]), silu_(acc[5])), pack2(silu_(acc[6]), silu_(acc[7])));
      }
      }
    }
    {
      int tok = tid >> 4, hh = tid & 15;
      int m = mb + tok;
      float dtv = softplus_(bf2f(P[(size_t)m * PSTR + 4352 + hh]) + p.dt_bias[j * 16 + hh]);
      float* cs = (float*)smem;
      __syncthreads();
      cs[tid] = -dtv * __expf(p.a_log[j * 16 + hh]);
      __syncthreads();
      float G = 0.f;
      for (int i = 0; i <= tok; i++) G += cs[i * 16 + hh];
      p.dtb[(size_t)m * 32 + hh] = dtv;
      p.dtb[(size_t)m * 32 + 16 + hh] = G;
    }
  }
  for (int idx = bid * 256 + tid; idx < 10 * 3 * 1536; idx += nb * 256) {
    int s = idx / 4608, rem = idx % 4608;
    int r = rem / 1536, c = rem % 1536;
    int m = seq_row0(s) + seq_len(s) - 3 + r;
    float* o = out_state(p.out, s, j, O_CONV_P, O_CONV_S, 4608);
    o[rem] = bf2f(P[(size_t)m * PSTR + 2816 + c]);
  }
}

__device__ __forceinline__ void cvt8_store(float* d, uint4 v) {
  *(float4*)d = make_float4(lo16(v.x), hi16(v.x), lo16(v.y), hi16(v.y));
  *(float4*)(d + 4) = make_float4(lo16(v.z), hi16(v.z), lo16(v.w), hi16(v.w));
}

#define RK_NOC 4
#define RK_BASE(p) ((p).scr + 2100000)
#define RK_LS(p) (RK_BASE(p))
#define RK_PS(p) (RK_BASE(p) + 262144)
#define RK_SI(p) (RK_BASE(p) + 524288)
template <int PART>
__device__ __forceinline__ void rwkv_scan_item(CP p, int j, int s, int h, int rg, int oc, int noc, char* smem) {
  float* Lb = (float*)smem;
  float* ob = Lb + 2 * 16 * 16 * 28;
  const int tid = otid(), lane = tid & 63, wv = tid >> 6;
  const int rl = lane >> 4, kq = lane & 15;
  const int R = rg * 16 + wv * 4 + rl;
  const int T = seq_len(s) / noc, m0 = seq_row0(s) + oc * T;
  float S[4];
  if (PART == 1) {
#pragma unroll
    for (int e = 0; e < 4; e++) S[e] = (R == kq * 4 + e) ? 1.f : 0.f;
  } else if (s >= 2) {
    float4 q = *(const float4*)(p.st_rwkv + ((((size_t)(s - 2) * 2 + j) * 8 + h) * 64 + R) * 64 + kq * 4);
    S[0] = q.x; S[1] = q.y; S[2] = q.z; S[3] = q.w;
  } else {
    S[0] = S[1] = S[2] = S[3] = 0.f;
  }
  const u16* src = p.rw + ((size_t)m0 * 8 + h) * 16 * 24;
  const int q0 = tid, q1 = tid + 256, q2 = tid + 512;
  const int so0 = (q0 / 48) * 3072 + (q0 % 48) * 8, so1 = (q1 / 48) * 3072 + (q1 % 48) * 8,
            so2 = (q2 / 48) * 3072 + (q2 % 48) * 8;
  const int do0 = ((q0 / 48) * 16 + (q0 % 48) / 3) * 28 + ((q0 % 48) % 3) * 8,
            do1 = ((q1 / 48) * 16 + (q1 % 48) / 3) * 28 + ((q1 % 48) % 3) * 8,
            do2 = ((q2 / 48) * 16 + (q2 % 48) / 3) * 28 + ((q2 % 48) % 3) * 8;
  u16* outp = PART ? p.ub + (size_t)(m0 + (tid >> 4)) * 512 + h * 64 + rg * 16 + (tid & 15)
                   : p.hm + (size_t)(m0 + (tid >> 4)) * 1536 + h * 64 + rg * 16 + (tid & 15);
  const int ostr = PART ? 16 * 512 : 16 * 1536;
  const int nbat = T >> 4;
  uint4 a0, a1, a2, c0, c1, c2;
#define RW_ISSUE(r0, r1, r2, bt) { const u16* sp_ = src + (size_t)(bt) * 16 * 3072; \
    r0 = *(const uint4*)(sp_ + so0); r1 = *(const uint4*)(sp_ + so1); r2 = *(const uint4*)(sp_ + so2); }
#define RW_STASH(r0, r1, r2, bi) { float* d_ = Lb + (bi) * (16 * 16 * 28); \
    cvt8_store(d_ + do0, r0); cvt8_store(d_ + do1, r1); cvt8_store(d_ + do2, r2); }
#define RW_COMPUTE(bt) { \
    const float* cur = Lb + ((bt) & 1) * (16 * 16 * 28); \
    float* obc = ob + ((bt) & 1) * 256; \
    float op[16]; \
    _Pragma("unroll") for (int st = 0; st < 16; st++) { \
      const float* sl = cur + (st * 16 + kq) * 28; \
      float4 r4 = *(const float4*)(sl), k4 = *(const float4*)(sl + 4), kk4 = *(const float4*)(sl + 8), \
             b4 = *(const float4*)(sl + 12), e4 = *(const float4*)(sl + 16); \
      float v = PART ? 0.f : cur[(st * 16 + (R >> 2)) * 28 + 20 + (R & 3)]; \
      float sa = (S[0] * kk4.x + S[1] * kk4.y) + (S[2] * kk4.z + S[3] * kk4.w); \
      sa = -red16(sa); \
      S[0] = fmaf(S[0], -e4.x, S[0]); S[1] = fmaf(S[1], -e4.y, S[1]); \
      S[2] = fmaf(S[2], -e4.z, S[2]); S[3] = fmaf(S[3], -e4.w, S[3]); \
      S[0] = fmaf(v, k4.x, S[0]); S[1] = fmaf(v, k4.y, S[1]); \
      S[2] = fmaf(v, k4.z, S[2]); S[3] = fmaf(v, k4.w, S[3]); \
      S[0] = fmaf(sa, b4.x, S[0]); S[1] = fmaf(sa, b4.y, S[1]); \
      S[2] = fmaf(sa, b4.z, S[2]); S[3] = fmaf(sa, b4.w, S[3]); \
      op[st] = (S[0] * r4.x + S[1] * r4.y) + (S[2] * r4.z + S[3] * r4.w); \
      if ((st & 3) == 3) __builtin_amdgcn_sched_barrier(0); \
    } \
    _Pragma("unroll") for (int st = 0; st < 16; st++) op[st] = red16(op[st]); \
    if (kq == 0) { _Pragma("unroll") for (int st = 0; st < 16; st++) obc[st * 16 + wv * 4 + rl] = op[st]; } }
#define RW_OUT(bt) { outp[(size_t)(bt) * ostr] = f2bf(ob[((bt) & 1) * 256 + tid]); }
  __syncthreads();
  RW_ISSUE(a0, a1, a2, 0)
  RW_STASH(a0, a1, a2, 0)
  if (1 < nbat) RW_ISSUE(a0, a1, a2, 1)
  if (2 < nbat) RW_ISSUE(c0, c1, c2, 2)
  __syncthreads();
  for (int b = 0; b < nbat; b += 2) {
    RW_COMPUTE(b)
    if (b + 1 < nbat) RW_STASH(a0, a1, a2, 1)
    __syncthreads();
    RW_OUT(b)
    if (b + 1 >= nbat) break;
    if (b + 3 < nbat) RW_ISSUE(a0, a1, a2, b + 3)
    RW_COMPUTE(b + 1)
    if (b + 2 < nbat) RW_STASH(c0, c1, c2, 0)
    __syncthreads();
    RW_OUT(b + 1)
    if (b + 4 < nbat) RW_ISSUE(c0, c1, c2, b + 4)
  }
  if (noc == 1) {
    float* o = out_state(p.out, s, j, O_RWKV_P, O_RWKV_S, 32768);
    *(float4*)(o + ((size_t)h * 64 + R) * 64 + kq * 4) = make_float4(S[0], S[1], S[2], S[3]);
  } else {
    float* o = (PART ? RK_PS(p) : RK_LS(p)) + (size_t)((s * 8 + h) * 4 + oc) * 4096;
    *(float4*)(o + (size_t)R * 64 + kq * 4) = make_float4(S[0], S[1], S[2], S[3]);
  }
  __syncthreads();
}

__device__ __forceinline__ void rwkv_combine_item(CP p, int j, int s, int h, char* smem) {
  float* Sl = (float*)smem;
  const int tid = otid();
  const int r = tid >> 2, jq = tid & 3;
  const size_t idx0 = (size_t)(s * 8 + h) * 4;
  float cur[16];
  {
    const float* l0 = RK_LS(p) + idx0 * 4096 + r * 64 + jq * 16;
#pragma unroll
    for (int c = 0; c < 16; c++) cur[c] = l0[c];
  }
  for (int oc = 1; oc < RK_NOC; oc++) {
    float* si = RK_SI(p) + (idx0 + oc) * 4096 + r * 64 + jq * 16;
    __syncthreads();
#pragma unroll
    for (int c = 0; c < 16; c++) { si[c] = cur[c]; Sl[r * 65 + jq * 16 + c] = cur[c]; }
    __syncthreads();
    float nx[16];
    {
      const float* lo = RK_LS(p) + (idx0 + oc) * 4096 + r * 64 + jq * 16;
#pragma unroll
      for (int c = 0; c < 16; c++) nx[c] = lo[c];
    }
    const float* pm = RK_PS(p) + (idx0 + oc) * 4096 + jq * 16;
    for (int i = 0; i < 64; i++) {
      const float sv = Sl[r * 65 + i];
      const float4 p0 = *(const float4*)(pm + i * 64), p1 = *(const float4*)(pm + i * 64 + 4),
                   p2 = *(const float4*)(pm + i * 64 + 8), p3 = *(const float4*)(pm + i * 64 + 12);
      nx[0] += sv * p0.x; nx[1] += sv * p0.y; nx[2] += sv * p0.z; nx[3] += sv * p0.w;
      nx[4] += sv * p1.x; nx[5] += sv * p1.y; nx[6] += sv * p1.z; nx[7] += sv * p1.w;
      nx[8] += sv * p2.x; nx[9] += sv * p2.y; nx[10] += sv * p2.z; nx[11] += sv * p2.w;
      nx[12] += sv * p3.x; nx[13] += sv * p3.y; nx[14] += sv * p3.z; nx[15] += sv * p3.w;
    }
#pragma unroll
    for (int c = 0; c < 16; c++) cur[c] = nx[c];
  }
  float* o = out_state(p.out, s, j, O_RWKV_P, O_RWKV_S, 32768) + ((size_t)h * 64 + r) * 64 + jq * 16;
#pragma unroll
  for (int c = 0; c < 16; c++) o[c] = cur[c];
  __syncthreads();
}

typedef __attribute__((ext_vector_type(4))) short bf16x4;
#define MB_SL(p) ((p).scr)
#define MB_DD(p) ((p).scr + 256 * 8192)
#define MB_NOC 8
template <int MODE>
__device__ __forceinline__ void mamba_scan_item(CP p, int j, int s, int h, int oc, int noc, char* smem) {
  u16* Bs = (u16*)smem;
  u16* Cs = Bs + 2 * 16 * 136;
  u16* BTs = Cs + 2 * 16 * 136;
  u16* XTs = BTs + 2 * 128 * 24;
  u16* XBs = XTs + 2 * 64 * 24;
  u16* SsT = XBs + 2 * 64 * 24;
  float* Gs = (float*)(SsT + 64 * 136);
  const int tid = otid(), lane = tid & 63, wv = tid >> 6;
  const int l15 = lane & 15, lq = lane >> 4;
  const int g = h >> 3;
  const int T = seq_len(s);
  const int nch = (T >> 4) / noc;
  const int m0 = seq_row0(s) + oc * nch * 16;
  f32x4 acc[8];
#pragma unroll
  for (int nt = 0; nt < 8; nt++) acc[nt] = (f32x4){0.f, 0.f, 0.f, 0.f};
  float prodD = 1.f;
  if (MODE == 1) {
    if (s >= 2) {
      const float* sp = p.st_ssm + (((size_t)(s - 2) * 2 + j) * 16 + h) * 8192 + (size_t)(wv * 16 + lq * 4) * 128 + l15;
#pragma unroll
      for (int nt = 0; nt < 8; nt++)
        acc[nt] = (f32x4){sp[nt * 16], sp[128 + nt * 16], sp[256 + nt * 16], sp[384 + nt * 16]};
    } else {
      for (int cp = 0; cp < oc; cp++) {
        const size_t idx = (size_t)((s * 16 + h) * 8 + cp);
        const float dd = MB_DD(p)[idx];
        const float* sp = MB_SL(p) + idx * 8192 + (size_t)(wv * 16 + lq * 4) * 128 + l15;
#pragma unroll
        for (int nt = 0; nt < 8; nt++)
          acc[nt] = (f32x4){acc[nt][0] * dd + sp[nt * 16], acc[nt][1] * dd + sp[128 + nt * 16],
                            acc[nt][2] * dd + sp[256 + nt * 16], acc[nt][3] * dd + sp[384 + nt * 16]};
      }
    }
  }
  const u16* Pb = p.cv + (size_t)(m0 + (tid >> 4)) * 1536 + 1024 + g * 128 + (tid & 15) * 8;
  const u16* Px = p.cv + (size_t)(m0 + ((tid >> 3) & 15)) * 1536 + h * 64 + (tid & 7) * 8;
  const float* Pdt = p.dtb + (size_t)(m0 + ((tid >> 3) & 15)) * 32 + h;
  const float* PgL = p.dtb + (size_t)(m0 + 15) * 32 + 16 + h;
  const float* PG = p.dtb + (size_t)(m0 + (tid & 15)) * 32 + 16 + h;
  uint4 ab, ac, ax, cb, cc, cx;
  float adt = 0.f, ag = 0.f, agl = 0.f, aG = 0.f, cdt = 0.f, cg = 0.f, cgl = 0.f, cG = 0.f;
  ab = make_uint4(0, 0, 0, 0); ac = ab; ax = ab; cb = ab; cc = ab; cx = ab;
#define MM_ISSUE(rb, rc, rx, rdt, rg, rgl, rG, c) { \
    rb = *(const uint4*)(Pb + (size_t)(c) * 16 * 1536); \
    if (MODE == 1) rc = *(const uint4*)(Pb + (size_t)(c) * 16 * 1536 + 256); \
    if (tid < 128) { rx = *(const uint4*)(Px + (size_t)(c) * 16 * 1536); rdt = Pdt[(size_t)(c) * 16 * 32]; \
      rg = Pdt[(size_t)(c) * 16 * 32 + 16]; rgl = PgL[(size_t)(c) * 16 * 32]; } \
    if (tid < 16) rG = PG[(size_t)(c) * 16 * 32]; }
#define MM_T8(dst, rv, sc) { \
      dst[0 * 24] = f2bf(lo16(rv.x) * (sc)); dst[1 * 24] = f2bf(hi16(rv.x) * (sc)); dst[2 * 24] = f2bf(lo16(rv.y) * (sc)); dst[3 * 24] = f2bf(hi16(rv.y) * (sc)); \
      dst[4 * 24] = f2bf(lo16(rv.z) * (sc)); dst[5 * 24] = f2bf(hi16(rv.z) * (sc)); dst[6 * 24] = f2bf(lo16(rv.w) * (sc)); dst[7 * 24] = f2bf(hi16(rv.w) * (sc)); }
#define MM_STASH(rb, rc, rx, rdt, rg, rgl, rG, bi) { \
    if (MODE == 1) { *(uint4*)(Bs + (bi) * (16 * 136) + (tid >> 4) * 136 + (tid & 15) * 8) = rb; \
                     *(uint4*)(Cs + (bi) * (16 * 136) + (tid >> 4) * 136 + (tid & 15) * 8) = rc; } \
    { u16* bd_ = BTs + (bi) * (128 * 24) + ((tid & 15) * 8) * 24 + (tid >> 4); \
      bd_[0 * 24] = (u16)(rb.x & 0xffff); bd_[1 * 24] = (u16)(rb.x >> 16); bd_[2 * 24] = (u16)(rb.y & 0xffff); bd_[3 * 24] = (u16)(rb.y >> 16); \
      bd_[4 * 24] = (u16)(rb.z & 0xffff); bd_[5 * 24] = (u16)(rb.z >> 16); bd_[6 * 24] = (u16)(rb.w & 0xffff); bd_[7 * 24] = (u16)(rb.w >> 16); } \
    if (tid < 128) { const float sb_ = rdt * __expf(rgl - rg); \
      u16* xb_ = XBs + (bi) * (64 * 24) + ((tid & 7) * 8) * 24 + (tid >> 3); MM_T8(xb_, rx, sb_) \
      if (MODE == 1) { u16* xt_ = XTs + (bi) * (64 * 24) + ((tid & 7) * 8) * 24 + (tid >> 3); MM_T8(xt_, rx, rdt) } } \
    if (tid < 16) { Gs[(bi) * 32 + tid] = rG; if (tid == 15) Gs[(bi) * 32 + 16] = __expf(rG); } }
  __syncthreads();
  MM_ISSUE(ab, ac, ax, adt, ag, agl, aG, 0)
  MM_STASH(ab, ac, ax, adt, ag, agl, aG, 0)
  if (1 < nch) MM_ISSUE(ab, ac, ax, adt, ag, agl, aG, 1)
  if (2 < nch) MM_ISSUE(cb, cc, cx, cdt, cg, cgl, cG, 2)
  for (int c = 0; c < nch; c++) {
    const int bi = c & 1;
    if (MODE == 1) {
#pragma unroll
      for (int nt = 0; nt < 8; nt++)
#pragma unroll
        for (int jj = 0; jj < 4; jj++)
          SsT[(wv * 16 + lq * 4 + jj) * 136 + nt * 16 + l15] = f2bf(acc[nt][jj]);
    }
    __syncthreads();
    if (c + 1 < nch) {
      if (bi == 0) { MM_STASH(ab, ac, ax, adt, ag, agl, aG, 1) if (c + 3 < nch) MM_ISSUE(ab, ac, ax, adt, ag, agl, aG, c + 3) }
      else { MM_STASH(cb, cc, cx, cdt, cg, cgl, cG, 0) if (c + 3 < nch) MM_ISSUE(cb, cc, cx, cdt, cg, cgl, cG, c + 3) }
    }
    const u16* Bc = Bs + bi * (16 * 136);
    const u16* Cc = Cs + bi * (16 * 136);
    const u16* BTc = BTs + bi * (128 * 24);
    const u16* XTc = XTs + bi * (64 * 24);
    const u16* XBc = XBs + bi * (64 * 24);
    const float* Gc = Gs + bi * 32;
    if (MODE == 1) {
      f32x4 at = (f32x4){0.f, 0.f, 0.f, 0.f};
      bf16x8 cf[4];
#pragma unroll
      for (int ks = 0; ks < 4; ks++) {
        bf16x8 bfv = *(const bf16x8*)(Bc + l15 * 136 + ks * 32 + lq * 8);
        cf[ks] = *(const bf16x8*)(Cc + l15 * 136 + ks * 32 + lq * 8);
        at = __builtin_amdgcn_mfma_f32_16x16x32_bf16(bfv, cf[ks], at, 0, 0, 0);
      }
      const float Gt = Gc[l15];
      bf16x4 bat;
#pragma unroll
      for (int jj = 0; jj < 4; jj++) {
        const int sidx = lq * 4 + jj;
        bat[jj] = (short)f2bf(sidx <= l15 ? at[jj] * __expf(Gt - Gc[sidx]) : 0.f);
      }
      bf16x4 xt = *(const bf16x4*)(XTc + (wv * 16 + l15) * 24 + lq * 4);
      f32x4 ao1 = (f32x4){0.f, 0.f, 0.f, 0.f};
      ao1 = __builtin_amdgcn_mfma_f32_16x16x16bf16_1k(xt, bat, ao1, 0, 0, 0);
      f32x4 ao2 = (f32x4){0.f, 0.f, 0.f, 0.f};
#pragma unroll
      for (int ks = 0; ks < 4; ks++) {
        bf16x8 sf = *(const bf16x8*)(SsT + (wv * 16 + l15) * 136 + ks * 32 + lq * 8);
        ao2 = __builtin_amdgcn_mfma_f32_16x16x32_bf16(sf, cf[ks], ao2, 0, 0, 0);
      }
      const float eg = __expf(Gt);
      *(uint2*)(p.hm + (size_t)(m0 + c * 16 + l15) * 1536 + 512 + h * 64 + wv * 16 + lq * 4) =
          make_uint2(pack2(ao1[0] + ao2[0] * eg, ao1[1] + ao2[1] * eg), pack2(ao1[2] + ao2[2] * eg, ao1[3] + ao2[3] * eg));
    }
    {
      const float eGL = Gc[16];
      if (MODE == 0) prodD *= eGL;
      bf16x4 xb = *(const bf16x4*)(XBc + (wv * 16 + l15) * 24 + lq * 4);
#pragma unroll
      for (int nt = 0; nt < 8; nt++) {
        bf16x4 bt = *(const bf16x4*)(BTc + (nt * 16 + l15) * 24 + lq * 4);
        f32x4 cin = (f32x4){acc[nt][0] * eGL, acc[nt][1] * eGL, acc[nt][2] * eGL, acc[nt][3] * eGL};
        acc[nt] = __builtin_amdgcn_mfma_f32_16x16x16bf16_1k(xb, bt, cin, 0, 0, 0);
      }
    }
  }
  if (MODE == 0) {
    const size_t idx = (size_t)((s * 16 + h) * 8 + oc);
    float* sp = MB_SL(p) + idx * 8192 + (size_t)(wv * 16 + lq * 4) * 128 + l15;
#pragma unroll
    for (int nt = 0; nt < 8; nt++) {
      sp[nt * 16] = acc[nt][0]; sp[128 + nt * 16] = acc[nt][1]; sp[256 + nt * 16] = acc[nt][2]; sp[384 + nt * 16] = acc[nt][3];
    }
    if (tid == 0) MB_DD(p)[idx] = prodD;
  } else if (oc == noc - 1) {
    float* sp = out_state(p.out, s, j, O_SSM_P, O_SSM_S, 131072) + (size_t)h * 8192 + (size_t)(wv * 16 + lq * 4) * 128 + l15;
#pragma unroll
    for (int nt = 0; nt < 8; nt++) {
      sp[nt * 16] = acc[nt][0]; sp[128 + nt * 16] = acc[nt][1]; sp[256 + nt * 16] = acc[nt][2]; sp[384 + nt * 16] = acc[nt][3];
    }
  }
  __syncthreads();
}

__device__ void phase_scan_even_a(CP p, int j, char* smem, int bid, int nb) {
  const int nA = 32 * (MB_NOC - 1);
  for (int it = bid; it < 448 + nA + 256; it += nb) {
    int kind, q, oc = 0, noc = RK_NOC;
    if (it < 256) { kind = 0; q = it >> 2; oc = it & 3; }
    else if (it < 448) { kind = 1; q = (it - 256) / 3; oc = 1 + (it - 256) % 3; }
    else if (it < 448 + nA) { kind = 2; q = (it - 448) / (MB_NOC - 1); oc = (it - 448) % (MB_NOC - 1); }
    else { kind = 0; q = 64 + (it - 448 - nA); noc = 1; }
    if (kind == 2) mamba_scan_item<0>(p, j, q >> 4, q & 15, oc, MB_NOC, smem);
    else {
      const int s = q < 64 ? (q >> 5) : 2 + ((q - 64) >> 5);
      if (kind == 0) rwkv_scan_item<0>(p, j, s, (q >> 2) & 7, q & 3, oc, noc, smem);
      else rwkv_scan_item<1>(p, j, s, (q >> 2) & 7, q & 3, oc, noc, smem);
    }
  }
}
__device__ void phase_scan_even(CP p, int j, char* smem, int bid, int nb) {
  for (int it = bid; it < 16 + 32 * MB_NOC + 128; it += nb) {
    if (it < 16) { rwkv_combine_item(p, j, it >> 3, it & 7, smem); continue; }
    const int i2 = it - 16;
    int q, s, oc, noc;
    if (i2 < 32 * MB_NOC) { q = i2 / MB_NOC; oc = i2 % MB_NOC; noc = MB_NOC; s = q >> 4; }
    else { q = i2 - 32 * MB_NOC; oc = 0; noc = 1; s = 2 + (q >> 4); }
    mamba_scan_item<1>(p, j, s, q & 15, oc, noc, smem);
  }
}

__device__ void phase_post_even(CP p, int j, char* smem, int bid, int nb) {
  const int tid = otid(), lane = tid & 63, wv = tid >> 6;
  const u16* P = p.pbuf;
  {
    u16* sgb = (u16*)smem;
    float* ul = (float*)(sgb + 16 * 136) ;
    float* resg = ul + 8 * 512;
    for (int i = tid; i < 16 * 136; i += 256) sgb[i] = 0;
    const int half = tid >> 7, hk = tid & 127, h = hk >> 4, kq = hk & 15;
    const int c4 = h * 64 + kq * 4;
    const float* mu = p.mu_a + j * 1792;
    for (int u = bid; u < NT / 8; u += nb) {
      const int m0 = u * 8;
      const int s = row_seq(m0);
      const int r0 = seq_row0(s);
      __syncthreads();
#pragma unroll
      for (int i = 0; i < 4; i++) {
        int idx = tid + 256 * i;
        int tok = idx >> 7, cc = idx & 127;
        int m = m0 + tok;
        int col = 1664 + cc;
        float pc = bf2f(P[(size_t)m * PSTR + col]);
        float pp = (m > r0) ? bf2f(P[(size_t)(m - 1) * PSTR + col])
                            : (s >= 2 ? p.st_shift[((size_t)(s - 2) * 2 + j) * 1792 + col] : 0.f);
        float pm = pc + (pp - pc) * mu[col];
        sgb[tok * 136 + cc] = f2bf(sigm(pm));
      }
      const int ocu = (s < 2) ? ((m0 - r0) >> 11) : 0;
      if (ocu > 0) {
#pragma unroll
        for (int i = 0; i < 2; i++) {
          int idx = tid + 256 * i;
          uint4 uv = *(const uint4*)(p.ub + (size_t)m0 * 512 + idx * 8);
          cvt8_store(ul + idx * 8, uv);
        }
      }
      __syncthreads();
      float corr[4][4];
#pragma unroll
      for (int a = 0; a < 4; a++)
#pragma unroll
        for (int b = 0; b < 4; b++) corr[a][b] = 0.f;
      if (ocu > 0) {
        const float* sip = RK_SI(p) + (size_t)((s * 8 + h) * 4 + ocu) * 4096 + (size_t)(kq * 4) * 64;
#pragma unroll 2
        for (int i = 0; i < 64; i += 4) {
          float4 u4[4];
#pragma unroll
          for (int tk = 0; tk < 4; tk++) u4[tk] = *(const float4*)(ul + (half * 4 + tk) * 512 + h * 64 + i);
#pragma unroll
          for (int rr = 0; rr < 4; rr++) {
            float4 s4 = *(const float4*)(sip + rr * 64 + i);
#pragma unroll
            for (int tk = 0; tk < 4; tk++)
              corr[tk][rr] += s4.x * u4[tk].x + s4.y * u4[tk].y + s4.z * u4[tk].z + s4.w * u4[tk].w;
          }
        }
      }
      {
        const int lane = tid & 63, wv = tid >> 6, l15 = lane & 15, lq = lane >> 4;
        bf16x8 ag[4];
#pragma unroll
        for (int ks = 0; ks < 4; ks++) ag[ks] = *(const bf16x8*)(sgb + l15 * 136 + ks * 32 + lq * 8);
#pragma unroll
        for (int nt = 0; nt < 8; nt++) {
          const int n = wv * 128 + nt * 16 + l15;
          f32x4 cgv = (f32x4){0.f, 0.f, 0.f, 0.f};
#pragma unroll
          for (int ks = 0; ks < 4; ks++) {
            bf16x8 bg = *(const bf16x8*)(p.g2t + (size_t)n * 128 + ks * 32 + lq * 8);
            cgv = __builtin_amdgcn_mfma_f32_16x16x32_bf16(ag[ks], bg, cgv, 0, 0, 0);
          }
          if (lq < 2) {
#pragma unroll
            for (int jj = 0; jj < 4; jj++) resg[(lq * 4 + jj) * 512 + n] = cgv[jj];
          }
        }
      }
      __syncthreads();
      float accg[4][4];
#pragma unroll
      for (int tk = 0; tk < 4; tk++) {
        float4 rg4 = *(const float4*)(resg + (half * 4 + tk) * 512 + c4);
        accg[tk][0] = rg4.x; accg[tk][1] = rg4.y; accg[tk][2] = rg4.z; accg[tk][3] = rg4.w;
      }
      float4 lw = *(const float4*)(p.lnx_w + j * 512 + c4);
      float4 lb = *(const float4*)(p.lnx_b + j * 512 + c4);
      const float lwa[4] = {lw.x, lw.y, lw.z, lw.w};
      const float lba[4] = {lb.x, lb.y, lb.z, lb.w};
#pragma unroll
      for (int tk = 0; tk < 4; tk++) {
        const int m = m0 + half * 4 + tk;
        u16* op = p.hm + (size_t)m * 1536 + c4;
        uint2 oraw = *(const uint2*)op;
        float o[4] = {lo16(oraw.x) + corr[tk][0], hi16(oraw.x) + corr[tk][1], lo16(oraw.y) + corr[tk][2], hi16(oraw.y) + corr[tk][3]};
        float sm = red16(o[0] + o[1] + o[2] + o[3]);
        float mean = sm * (1.f / 64.f);
        float d0 = o[0] - mean, d1 = o[1] - mean, d2 = o[2] - mean, d3 = o[3] - mean;
        float var = red16(d0 * d0 + d1 * d1 + d2 * d2 + d3 * d3) * (1.f / 64.f);
        float rs = rsqrtf(var + 64e-5f);
        float bon = p.bonus[(size_t)m * 8 + h];
        uint4 sl2 = *(const uint4*)(p.rw + (((size_t)m * 8 + h) * 16 + kq) * 24 + 16);
        float v[4] = {lo16(sl2.z), hi16(sl2.z), lo16(sl2.w), hi16(sl2.w)};
        float dd[4] = {d0, d1, d2, d3};
        float res[4];
#pragma unroll
        for (int e = 0; e < 4; e++) res[e] = (dd[e] * rs * lwa[e] + lba[e] + bon * v[e]) * accg[tk][e];
        *(uint2*)op = make_uint2(pack2(res[0], res[1]), pack2(res[2], res[3]));
      }
    }
  }
  for (int w = bid * 4 + wv; w < NT * 2; w += nb * 4) {
    int m = w >> 1, g = w & 1;
    u16* yp = p.hm + (size_t)m * 1536 + 512 + g * 512 + lane * 8;
    uint4 yr = *(const uint4*)yp;
    uint4 zr = *(const uint4*)(P + (size_t)m * PSTR + 1792 + g * 512 + lane * 8);
    float y[8] = {lo16(yr.x), hi16(yr.x), lo16(yr.y), hi16(yr.y), lo16(yr.z), hi16(yr.z), lo16(yr.w), hi16(yr.w)};
    float z[8] = {lo16(zr.x), hi16(zr.x), lo16(zr.y), hi16(zr.y), lo16(zr.z), hi16(zr.z), lo16(zr.w), hi16(zr.w)};
    uint4 xr = *(const uint4*)(p.cv + (size_t)m * 1536 + g * 512 + lane * 8);
    float x[8] = {lo16(xr.x), hi16(xr.x), lo16(xr.y), hi16(xr.y), lo16(xr.z), hi16(xr.z), lo16(xr.w), hi16(xr.w)};
    const float dsk = p.d_skip[j * 16 + g * 8 + (lane >> 3)];
    float ss = 0.f;
#pragma unroll
    for (int e = 0; e < 8; e++) { y[e] = (y[e] + dsk * x[e]) * silu_(z[e]); ss += y[e] * y[e]; }
    ss = wave_sum(ss);
    float rs = rsqrtf(ss * (1.f / 512.f) + 1e-5f);
    const float* nw = p.norm_b_w + j * 1024 + g * 512 + lane * 8;
    float4 n0 = *(const float4*)nw, n1 = *(const float4*)(nw + 4);
    *(uint4*)yp = make_uint4(pack2(y[0] * rs * n0.x, y[1] * rs * n0.y), pack2(y[2] * rs * n0.z, y[3] * rs * n0.w),
                             pack2(y[4] * rs * n1.x, y[5] * rs * n1.y), pack2(y[6] * rs * n1.z, y[7] * rs * n1.w));
  }
}

#define QK_OFF ((size_t)1032 * 1024 * 16)
__device__ void phase_prep_odd(CP p, int j, int bid, int nb) {
  const int tid = otid();
  const u16* P = p.pbuf;
  u16* KT = p.rw;
  u16* QK = p.rw + QK_OFF;
  float* DL = (float*)p.cv;
  for (int u = bid; u < (NT / 16) * 2; u += nb) {
    const int ci = u >> 1, k = ((u & 1) * 256 + tid) * 2;
    float lb0 = 0.f, lb1 = 0.f;
    if (j == 1) { lb0 = sigm(p.lb_param[1024 + k] - p.lb_param[k]); lb1 = sigm(p.lb_param[1025 + k] - p.lb_param[k + 1]); }
    const u16* base = P + (size_t)ci * 16 * PSTR + k;
    unsigned qr[16], fr[16];
#pragma unroll
    for (int t = 0; t < 16; t++) { qr[t] = *(const unsigned*)(base + (size_t)t * PSTR); fr[t] = *(const unsigned*)(base + (size_t)t * PSTR + 1024); }
    float G0 = 0.f, G1 = 0.f;
    unsigned kt0[8], kt1[8];
#pragma unroll
    for (int t = 0; t < 16; t++) {
      float q0 = lo16(qr[t]), q1 = hi16(qr[t]), f0 = lo16(fr[t]), f1 = hi16(fr[t]);
      float s0 = sigm(f0), s1 = sigm(f1);
      float ff0 = lb0 + (1.f - lb0) * s0, ff1 = lb1 + (1.f - lb1) * s1;
      float kk0 = (1.f - lb0) * (1.f - s0), kk1 = (1.f - lb1) * (1.f - s1);
      G0 += __logf(fmaxf(ff0, 1e-30f)); G1 += __logf(fmaxf(ff1, 1e-30f));
      float Q0 = silu_(q0) * __expf(G0), Q1 = silu_(q1) * __expf(G1);
      float K0 = kk0 * __expf(fminf(-G0, 80.f)), K1 = kk1 * __expf(fminf(-G1, 80.f));
      unsigned kb0 = f2bf(K0), kb1 = f2bf(K1);
      u16* qd = QK + (size_t)(ci * 16 + t) * 2048 + k;
      *(unsigned*)qd = pack2(Q0, Q1);
      *(unsigned*)(qd + 1024) = kb0 | (kb1 << 16);
      if (t & 1) { kt0[t >> 1] |= kb0 << 16; kt1[t >> 1] |= kb1 << 16; } else { kt0[t >> 1] = kb0; kt1[t >> 1] = kb1; }
    }
    *(float2*)(DL + (size_t)ci * 1024 + k) = make_float2(__expf(G0), __expf(G1));
    uint4* kd = (uint4*)(KT + ((size_t)ci * 1024 + k) * 16);
    kd[0] = make_uint4(kt0[0], kt0[1], kt0[2], kt0[3]);
    kd[1] = make_uint4(kt0[4], kt0[5], kt0[6], kt0[7]);
    kd[2] = make_uint4(kt1[0], kt1[1], kt1[2], kt1[3]);
    kd[3] = make_uint4(kt1[4], kt1[5], kt1[6], kt1[7]);
  }
}

#define HG_SL(p) ((float*)(p).cv + 2 * 1024 * 1024)
#define HG_DD(p) (HG_SL(p) + 2 * 8 * 8 * 16384)
template <int MODE>
__device__ __forceinline__ void hgrn_scan_item(CP p, int j, int s, int h, int vq, int oc, int noc, char* smem) {
  u16* Qs = (u16*)smem;
  u16* Ks = Qs + 2 * 16 * 136;
  u16* KTs = Ks + 2 * 16 * 136;
  u16* VTs = KTs + 2 * 128 * 24;
  u16* SsT = VTs + 2 * 32 * 24;
  float* dLs = (float*)(SsT + 2 * 32 * 136);
  const int tid = otid(), lane = tid & 63, wv = tid >> 6;
  const int l15 = lane & 15, lq = lane >> 4;
  const int T = seq_len(s);
  const int nch = (T >> 4) / noc;
  const int m0 = seq_row0(s) + oc * nch * 16;
  const int ci0 = m0 >> 4;
  f32x4 acc[2][2];
#pragma unroll
  for (int vt = 0; vt < 2; vt++)
#pragma unroll
    for (int kl = 0; kl < 2; kl++) acc[vt][kl] = (f32x4){0.f, 0.f, 0.f, 0.f};
  float prodD[2] = {1.f, 1.f};
  if (MODE == 1) {
    if (s >= 2) {
      const float* sp = p.st_hgrn + (((size_t)(s - 2) * 2 + j) * 8 + h) * 16384;
#pragma unroll
      for (int vt = 0; vt < 2; vt++)
#pragma unroll
        for (int kl = 0; kl < 2; kl++) {
          float4 q = *(const float4*)(sp + (size_t)((2 * wv + kl) * 16 + l15) * 128 + vq * 32 + vt * 16 + lq * 4);
          acc[vt][kl] = (f32x4){q.x, q.y, q.z, q.w};
        }
    } else {
      for (int cp = 0; cp < oc; cp++) {
        const size_t idx = (size_t)((s * 8 + h) * 8 + cp);
#pragma unroll
        for (int kl = 0; kl < 2; kl++) {
          const int k = (2 * wv + kl) * 16 + l15;
          const float dd = HG_DD(p)[idx * 128 + k];
#pragma unroll
          for (int vt = 0; vt < 2; vt++) {
            float4 L4 = *(const float4*)(HG_SL(p) + idx * 16384 + (size_t)k * 128 + vq * 32 + vt * 16 + lq * 4);
            acc[vt][kl] = (f32x4){acc[vt][kl][0] * dd + L4.x, acc[vt][kl][1] * dd + L4.y, acc[vt][kl][2] * dd + L4.z,
                                  acc[vt][kl][3] * dd + L4.w};
          }
        }
      }
    }
  }
  const u16* Pq = p.rw + QK_OFF + (size_t)(m0 + (tid >> 4)) * 2048 + h * 128 + (tid & 15) * 8;
  const u16* Pv = p.pbuf + (size_t)(m0 + ((tid >> 2) & 15)) * PSTR + 2048 + h * 128 + vq * 32 + (tid & 3) * 8;
  const u16* Pkt = p.rw + ((size_t)ci0 * 1024 + h * 128 + (tid >> 1)) * 16 + (tid & 1) * 8;
  const float* Pdl = (const float*)p.cv + (size_t)ci0 * 1024 + h * 128 + (tid & 31) * 4;
  uint4 aq, ak, akt, av, cq, ck, ckt, cvv;
  float4 ad, cd;
  aq = make_uint4(0, 0, 0, 0); ak = aq; cq = aq; ck = aq;
  av = make_uint4(0, 0, 0, 0); cvv = av; ad = make_float4(0, 0, 0, 0); cd = ad;
#define HM_ISSUE(rq, rk, rkt, rv, rd, c) { \
    if (MODE == 1) { rq = *(const uint4*)(Pq + (size_t)(c) * 16 * 2048); rk = *(const uint4*)(Pq + (size_t)(c) * 16 * 2048 + 1024); } \
    rkt = *(const uint4*)(Pkt + (size_t)(c) * 1024 * 16); \
    if (tid < 64) rv = *(const uint4*)(Pv + (size_t)(c) * 16 * PSTR); \
    if (tid < 32) rd = *(const float4*)(Pdl + (size_t)(c) * 1024); }
#define HM_STASH(rq, rk, rkt, rv, rd, bi) { \
    if (MODE == 1) { *(uint4*)(Qs + (bi) * (16 * 136) + (tid >> 4) * 136 + (tid & 15) * 8) = rq; \
    *(uint4*)(Ks + (bi) * (16 * 136) + (tid >> 4) * 136 + (tid & 15) * 8) = rk; } \
    *(uint4*)(KTs + (bi) * (128 * 24) + (tid >> 1) * 24 + (tid & 1) * 8) = rkt; \
    if (tid < 64) { u16* vd_ = VTs + (bi) * (32 * 24) + ((tid & 3) * 8) * 24 + (tid >> 2); \
      vd_[0 * 24] = (u16)(rv.x & 0xffff); vd_[1 * 24] = (u16)(rv.x >> 16); vd_[2 * 24] = (u16)(rv.y & 0xffff); vd_[3 * 24] = (u16)(rv.y >> 16); \
      vd_[4 * 24] = (u16)(rv.z & 0xffff); vd_[5 * 24] = (u16)(rv.z >> 16); vd_[6 * 24] = (u16)(rv.w & 0xffff); vd_[7 * 24] = (u16)(rv.w >> 16); } \
    if (tid < 32) *(float4*)(dLs + (bi) * 128 + tid * 4) = rd; }
  __syncthreads();
  HM_ISSUE(aq, ak, akt, av, ad, 0)
  HM_STASH(aq, ak, akt, av, ad, 0)
  if (1 < nch) HM_ISSUE(aq, ak, akt, av, ad, 1)
  if (2 < nch) HM_ISSUE(cq, ck, ckt, cvv, cd, 2)
  for (int c = 0; c < nch; c++) {
    const int bi = c & 1;
    if (MODE == 1) {
      u16* sd = SsT + bi * (32 * 136);
#pragma unroll
      for (int vt = 0; vt < 2; vt++)
#pragma unroll
        for (int kl = 0; kl < 2; kl++)
#pragma unroll
          for (int jj = 0; jj < 4; jj++)
            sd[(vt * 16 + lq * 4 + jj) * 136 + (2 * wv + kl) * 16 + l15] = f2bf(acc[vt][kl][jj]);
    }
    __syncthreads();
    if (c + 1 < nch) {
      if (bi == 0) { HM_STASH(aq, ak, akt, av, ad, 1) if (c + 3 < nch) HM_ISSUE(aq, ak, akt, av, ad, c + 3) }
      else { HM_STASH(cq, ck, ckt, cvv, cd, 0) if (c + 3 < nch) HM_ISSUE(cq, ck, ckt, cvv, cd, c + 3) }
    }
    const u16* Qc = Qs + bi * (16 * 136);
    const u16* Kc = Ks + bi * (16 * 136);
    const u16* KTc = KTs + bi * (128 * 24);
    const u16* VTc = VTs + bi * (32 * 24);
    const u16* Sc = SsT + bi * (32 * 136);
    if (MODE == 1 && wv < 2) {
      const int vt = wv;
      f32x4 at = (f32x4){0.f, 0.f, 0.f, 0.f};
      bf16x8 qf[4];
#pragma unroll
      for (int ks = 0; ks < 4; ks++) {
        bf16x8 kf = *(const bf16x8*)(Kc + l15 * 136 + ks * 32 + lq * 8);
        qf[ks] = *(const bf16x8*)(Qc + l15 * 136 + ks * 32 + lq * 8);
        at = __builtin_amdgcn_mfma_f32_16x16x32_bf16(kf, qf[ks], at, 0, 0, 0);
      }
      bf16x4 bat;
#pragma unroll
      for (int jj = 0; jj < 4; jj++) bat[jj] = (short)f2bf((lq * 4 + jj) <= l15 ? at[jj] : 0.f);
      bf16x4 vf = *(const bf16x4*)(VTc + (vt * 16 + l15) * 24 + lq * 4);
      f32x4 ao1 = (f32x4){0.f, 0.f, 0.f, 0.f};
      ao1 = __builtin_amdgcn_mfma_f32_16x16x16bf16_1k(vf, bat, ao1, 0, 0, 0);
      f32x4 ao2 = (f32x4){0.f, 0.f, 0.f, 0.f};
#pragma unroll
      for (int ks = 0; ks < 4; ks++) {
        bf16x8 sf = *(const bf16x8*)(Sc + (vt * 16 + l15) * 136 + ks * 32 + lq * 8);
        ao2 = __builtin_amdgcn_mfma_f32_16x16x32_bf16(sf, qf[ks], ao2, 0, 0, 0);
      }
      f32x4 ao = (f32x4){ao1[0] + ao2[0], ao1[1] + ao2[1], ao1[2] + ao2[2], ao1[3] + ao2[3]};
      *(uint2*)(p.hm + (size_t)(m0 + c * 16 + l15) * 1024 + h * 128 + vq * 32 + vt * 16 + lq * 4) =
          make_uint2(pack2(ao[0], ao[1]), pack2(ao[2], ao[3]));
    }
#pragma unroll
    for (int kl = 0; kl < 2; kl++) {
      const int kt = 2 * wv + kl;
      bf16x4 kb = *(const bf16x4*)(KTc + (kt * 16 + l15) * 24 + lq * 4);
      float dl = dLs[bi * 128 + kt * 16 + l15];
      if (MODE == 0) prodD[kl] *= dl;
#pragma unroll
      for (int vt = 0; vt < 2; vt++) {
        bf16x4 vf = *(const bf16x4*)(VTc + (vt * 16 + l15) * 24 + lq * 4);
        f32x4 a = __builtin_amdgcn_mfma_f32_16x16x16bf16_1k(vf, kb, acc[vt][kl], 0, 0, 0);
        acc[vt][kl] = (f32x4){a[0] * dl, a[1] * dl, a[2] * dl, a[3] * dl};
      }
    }
  }
  if (MODE == 0) {
    const size_t idx = (size_t)((s * 8 + h) * 8 + oc);
#pragma unroll
    for (int kl = 0; kl < 2; kl++) {
      const int k = (2 * wv + kl) * 16 + l15;
      if (vq == 0 && lq == 0) HG_DD(p)[idx * 128 + k] = prodD[kl];
#pragma unroll
      for (int vt = 0; vt < 2; vt++)
        *(float4*)(HG_SL(p) + idx * 16384 + (size_t)k * 128 + vq * 32 + vt * 16 + lq * 4) =
            make_float4(acc[vt][kl][0], acc[vt][kl][1], acc[vt][kl][2], acc[vt][kl][3]);
    }
  } else if (oc == noc - 1) {
    float* o = out_state(p.out, s, j, O_HGRN_P, O_HGRN_S, 131072) + (size_t)h * 16384;
#pragma unroll
    for (int vt = 0; vt < 2; vt++)
#pragma unroll
      for (int kl = 0; kl < 2; kl++)
        *(float4*)(o + (size_t)((2 * wv + kl) * 16 + l15) * 128 + vq * 32 + vt * 16 + lq * 4) =
            make_float4(acc[vt][kl][0], acc[vt][kl][1], acc[vt][kl][2], acc[vt][kl][3]);
  }
  __syncthreads();
}

#define HG_NOC 8
__device__ void phase_scan_odd_a(CP p, int j, char* smem, int bid, int nb) {
  for (int it = bid; it < 64 * (HG_NOC - 1); it += nb) {
    int q = it / (HG_NOC - 1), oc = it % (HG_NOC - 1);
    hgrn_scan_item<0>(p, j, q >> 5, (q >> 2) & 7, q & 3, oc, HG_NOC, smem);
  }
}
__device__ void phase_scan_odd(CP p, int j, char* smem, int bid, int nb) {
  for (int it = bid; it < 64 * HG_NOC + 256; it += nb) {
    int q, s, oc, noc;
    if (it < 64 * HG_NOC) { q = it / HG_NOC; oc = it % HG_NOC; noc = HG_NOC; s = q >> 5; }
    else { q = it - 64 * HG_NOC; oc = 0; noc = 1; s = 2 + (q >> 5); }
    hgrn_scan_item<1>(p, j, s, (q >> 2) & 7, q & 3, oc, noc, smem);
  }
}

__device__ void phase_post_odd(CP p, int j, int bid, int nb) {
  const int tid = otid(), lane = tid & 63, wv = tid >> 6;
  const u16* P = p.pbuf;
  for (int m = bid * 4 + wv; m < NT; m += nb * 4) {
    u16* op = p.hm + (size_t)m * 1024 + lane * 16;
    uint4 a = *(const uint4*)op, b = *(const uint4*)(op + 8);
    const u16* gp = P + (size_t)m * PSTR + 3072 + lane * 16;
    uint4 ga = *(const uint4*)gp, gb = *(const uint4*)(gp + 8);
    float o[16] = {lo16(a.x), hi16(a.x), lo16(a.y), hi16(a.y), lo16(a.z), hi16(a.z), lo16(a.w), hi16(a.w),
                   lo16(b.x), hi16(b.x), lo16(b.y), hi16(b.y), lo16(b.z), hi16(b.z), lo16(b.w), hi16(b.w)};
    float g[16] = {lo16(ga.x), hi16(ga.x), lo16(ga.y), hi16(ga.y), lo16(ga.z), hi16(ga.z), lo16(ga.w), hi16(ga.w),
                   lo16(gb.x), hi16(gb.x), lo16(gb.y), hi16(gb.y), lo16(gb.z), hi16(gb.z), lo16(gb.w), hi16(gb.w)};
    float ss = 0.f;
#pragma unroll
    for (int e = 0; e < 16; e++) ss += o[e] * o[e];
    ss += dpp_f<0xB1>(ss);
    ss += dpp_f<0x4E>(ss);
    ss += dpp_f<0x141>(ss);
    float rs = rsqrtf(ss * (1.f / 128.f) + 1e-5f);
    const float* nw = p.norm_c_w + j * 1024 + lane * 16;
    float r[16];
#pragma unroll
    for (int e = 0; e < 16; e++) r[e] = o[e] * rs * nw[e] * silu_(g[e]);
    *(uint4*)op = make_uint4(pack2(r[0], r[1]), pack2(r[2], r[3]), pack2(r[4], r[5]), pack2(r[6], r[7]));
    *(uint4*)(op + 8) = make_uint4(pack2(r[8], r[9]), pack2(r[10], r[11]), pack2(r[12], r[13]), pack2(r[14], r[15]));
  }
}


#define XB_TMO      128
#define XB_XCNT(j)  (256  + 64 * (j))
#define XB_XSUB(j)  (1280 + 64 * (j))
#define XB_XGEN(j)  (2304 + 64 * (j))
#define XB_TOP      3328
#define XB_TOPGEN   3392
#define XCD_BAR_WORDS 3456
#define XB_SPIN_CAP (1u << 22)
#define LAS __attribute__((address_space(3)))
__device__ __forceinline__ unsigned xb_ld(unsigned* p) { return __hip_atomic_load(p, __ATOMIC_RELAXED, __HIP_MEMORY_SCOPE_AGENT); }
__device__ __forceinline__ unsigned xb_add(unsigned* p, unsigned v) { return __hip_atomic_fetch_add(p, v, __ATOMIC_RELAXED, __HIP_MEMORY_SCOPE_AGENT); }
__device__ __forceinline__ unsigned xb_xcc_id() { return (unsigned)__builtin_amdgcn_s_getreg((3 << 11) | 20) & 0xFu; }
#define XB_SPIN(cond, bar) do { unsigned _sp = 0; while (cond) { __builtin_amdgcn_s_sleep(1); \
    if ((++_sp & 255u) == 0u) { if (xb_ld(&(bar)[XB_TMO])) break; if (_sp > XB_SPIN_CAP) { atomicAdd(&(bar)[XB_TMO], 1u); break; } } } } while (0)
struct XcdBarrier { unsigned* bar; unsigned x; volatile LAS unsigned* st; };
__device__ __forceinline__ XcdBarrier xcd_barrier_post(unsigned* bar, volatile LAS unsigned* st) {
  XcdBarrier b; b.bar = bar; b.x = xb_xcc_id(); b.st = st;
  if (threadIdx.x == 0) (void)xb_add(&bar[XB_XCNT(b.x)], 1u);
  return b;
}
__device__ __forceinline__ void xcd_barrier_complete(unsigned* bar, unsigned x, unsigned& nloc, unsigned& nx) {
  const unsigned G = gridDim.x * gridDim.y * gridDim.z;
  unsigned sum, cnt, mine, sp = 0u;
  for (;;) {
    sum = 0u; cnt = 0u; mine = 0u;
#pragma unroll
    for (unsigned j = 0; j < 16; ++j) { const unsigned c = xb_ld(&bar[XB_XCNT(j)]); sum += c; cnt += (c > 0u) ? 1u : 0u; mine = (j == x) ? c : mine; }
    if (sum == G) break;
    __builtin_amdgcn_s_sleep(1);
    if ((++sp & 255u) == 0u) { if (xb_ld(&bar[XB_TMO])) break; if (sp > XB_SPIN_CAP) { atomicAdd(&bar[XB_TMO], 1u); break; } }
  }
  nloc = mine > 0u ? mine : 1u; nx = cnt > 0u ? cnt : 1u;
}
__device__ __forceinline__ void xcd_barrier(const XcdBarrier& b) {
  asm volatile("s_waitcnt vmcnt(0)" ::: "memory");
  __syncthreads();
  if (threadIdx.x == 0) {
    unsigned* bar = b.bar;
    __builtin_amdgcn_s_waitcnt(0);
    unsigned nloc = b.st[0], nx = b.st[1];
    if (nloc == 0u) { xcd_barrier_complete(bar, b.x, nloc, nx); b.st[0] = nloc; b.st[1] = nx; }
    const unsigned old = xb_add(&bar[XB_XSUB(b.x)], 1u);
    const unsigned gen = old / nloc;
    if (old + 1u == (gen + 1u) * nloc) {
      __builtin_amdgcn_fence(__ATOMIC_RELEASE, "agent");
      asm volatile("s_waitcnt vmcnt(0)" ::: "memory");
      const unsigned og = xb_add(&bar[XB_TOP], 1u);
      const unsigned tg = og / nx;
      if (og + 1u == (tg + 1u) * nx) xb_add(&bar[XB_TOPGEN], 1u);
      else XB_SPIN(xb_ld(&bar[XB_TOPGEN]) == tg, bar);
      __builtin_amdgcn_fence(__ATOMIC_ACQUIRE, "agent");
      xb_add(&bar[XB_XGEN(b.x)], 1u);
      asm volatile("s_waitcnt vmcnt(0)" ::: "memory");
    } else {
      XB_SPIN(xb_ld(&bar[XB_XGEN(b.x)]) == gen, bar);
      __builtin_amdgcn_fence(__ATOMIC_ACQUIRE, "agent");
      asm volatile("s_waitcnt vmcnt(0)" ::: "memory");
    }
  }
  __syncthreads();
}

#define NPHASE 42
__global__ void __launch_bounds__(256, 2) mega(Params kp) {
  __shared__ __attribute__((aligned(16))) char smem[65536];
  cg::grid_group grid = cg::this_grid();
  const int ph0 = kp.p0, ph1 = kp.p1;
  volatile LAS unsigned* xst = (volatile LAS unsigned*)(smem + 65520);
  if (threadIdx.x == 0) { xst[0] = 0u; xst[1] = 0u; }
  __syncthreads();
  XcdBarrier xb = xcd_barrier_post(kp.bar, xst);
  if (ph1 > 1000) grid.sync();
  const bool multi = (ph1 - ph0) > 1;
  for (int ph = ph0; ph < ph1; ph++) {
    CP p = *getp();
    int bid = blockIdx.x, nb = gridDim.x;
    asm volatile("" : "+s"(bid), "+s"(nb));
    if (ph == 0) {
      phase_mod(p, smem, bid, nb);
    } else if (ph == NPHASE - 1) {
      phase_final(p, bid, nb);
    } else {
      const int L = (ph - 1) / 10, sp = (ph - 1) % 10;
      const int j = L >> 1;
      const bool even = (L & 1) == 0;
      int reps = 1;
#ifdef PROBE_SCAN
      if (sp == 4 && !even) reps = 2;
#endif
#ifdef PROBE_GEMM
      if (sp == 1 || sp == 8) reps = 2;
#endif
#ifdef PROBE_MISC
      if (sp == 0 || sp == 7 || sp == 2) reps = 2;
#endif
      for (int rep = 0; rep < reps; rep++) {
      bool do_gemm = false;
      const u16 *A = nullptr, *Bt = nullptr;
      u16* outb = nullptr;
      const float* gate = nullptr;
      int lda = 0, K = 0, ntn = 0, epi = 0, ldo = 0, ncols = 0;
      switch (sp) {
        case 0:
          phase_wconv(p, L, smem, bid, nb);
          phase_norm(p, L, 0, bid, nb);
          break;
        case 1:
          do_gemm = true; A = p.hm; lda = 1024; Bt = p.wb_in; K = 1024; ntn = even ? 18 : 16; epi = 0;
          outb = p.pbuf; ldo = PSTR; ncols = even ? PSTR : 4096;
          break;
        case 2:
          if (even) phase_prep_even(p, j, smem, bid, nb); else phase_prep_odd(p, j, bid, nb);
          break;
        case 3:
          if (even) phase_scan_even_a(p, j, smem, bid, nb); else phase_scan_odd_a(p, j, smem, bid, nb);
          break;
        case 4:
          if (even) phase_scan_even(p, j, smem, bid, nb); else phase_scan_odd(p, j, smem, bid, nb);
          break;
        case 5:
          if (even) phase_post_even(p, j, smem, bid, nb); else phase_post_odd(p, j, bid, nb);
          break;
        case 6:
          do_gemm = true; A = p.hm; lda = even ? 1536 : 1024; Bt = p.wb_out; K = lda; ntn = 4; epi = 2;
          gate = p.mod + (size_t)L * 10 * 6144 + 2048;
          break;
        case 7:
          phase_norm(p, L, 1, bid, nb);
          break;
        case 8:
          do_gemm = true; A = p.hm; lda = 1024; Bt = p.wb_gu; K = 1024; ntn = 22; epi = 1;
          outb = p.pbuf; ldo = 2816; ncols = 2816;
          break;
        default:
          do_gemm = true; A = p.pbuf; lda = 2816; Bt = p.wb_dn; K = 2816; ntn = 4; epi = 2;
          gate = p.mod + (size_t)L * 10 * 6144 + 5120;
          break;
      }
      if (do_gemm) gemm_phase(p, A, lda, Bt, K, ntn, epi, outb, ldo, ncols, gate, smem, bid, nb);
      }
    }
    if (multi && ph + 1 < ph1) xcd_barrier(xb);
  }
}

extern "C" void kernel_launch(void* const* d_in, const int* in_sizes, int n_in, void* d_out, int out_size, void* d_ws,
                              size_t ws_size, hipStream_t stream) {
  static int grid_blocks = 0;
  if (!grid_blocks) {
    int dev = 0, cus = 0, per_cu = 0;
    hipGetDevice(&dev);
    hipDeviceGetAttribute(&cus, hipDeviceAttributeMultiprocessorCount, dev);
    hipOccupancyMaxActiveBlocksPerMultiprocessor(&per_cu, mega, 256, 0);
    if (per_cu > 2) per_cu = 2;
    if (per_cu < 1) per_cu = 1;
    grid_blocks = cus * per_cu;
  }
  Params p{};
  const float* const* in = (const float* const*)d_in;
  p.x_prompt = in[0]; p.x_sample = in[1]; p.st_rwkv = in[2]; p.st_shift = in[3]; p.st_ssm = in[4]; p.st_conv = in[5];
  p.st_hgrn = in[6]; p.c_prompt = in[7]; p.c_sample = in[8]; p.norm_mix_w = in[9]; p.norm_ffn_w = in[10];
  p.norm_out_w = in[11]; p.ada_w = in[12]; p.ada_b = in[13]; p.w_in_ab = in[14]; p.w_out_ab = in[15]; p.mu_a = in[16];
  p.w0 = in[17]; p.w2 = in[18]; p.a0 = in[19]; p.a2 = in[20]; p.g2 = in[21]; p.k_k = in[22]; p.k_a = in[23];
  p.r_k = in[24]; p.lnx_w = in[25]; p.lnx_b = in[26]; p.conv_w = in[27]; p.conv_b = in[28]; p.dt_bias = in[29];
  p.a_log = in[30]; p.d_skip = in[31]; p.norm_b_w = in[32]; p.w_in_c = in[33]; p.w_out_c = in[34]; p.lb_param = in[35];
  p.norm_c_w = in[36]; p.w_gate = in[37]; p.w_up = in[38]; p.w_down = in[39];
  p.out = (float*)d_out;
  char* ws = (char*)d_ws;
  size_t off = 0;
  auto take = [&](size_t bytes) { char* r = ws + off; off += (bytes + 255) & ~(size_t)255; return r; };
  p.bar = (unsigned*)take(16384);
  p.mod = (float*)take((size_t)4 * 10 * 6144 * 4);
  p.bonus = (float*)take((size_t)NT * 8 * 4);
  p.dtb = (float*)take((size_t)NT * 32 * 4);
  p.wb_in = (u16*)take((size_t)4480 * 1024 * 2);
  p.wb_out = (u16*)take((size_t)1024 * 1536 * 2);
  p.wb_gu = (u16*)take((size_t)5632 * 1024 * 2);
  p.wb_dn = (u16*)take((size_t)1024 * 2816 * 2);
  p.hm = (u16*)take((size_t)NT * 1536 * 2);
  p.pbuf = (u16*)take((size_t)NT * PSTR * 2);
  p.rw = (u16*)take((size_t)NT * 8 * 16 * 24 * 2);
  p.cv = (u16*)take((size_t)NT * 1536 * 2);
  p.scr = (float*)take((size_t)12 * 1024 * 1024);
  p.ub = (u16*)take((size_t)NT * 512 * 2);
  p.w2t = (u16*)take((size_t)512 * 64 * 2);
  p.a2t = (u16*)take((size_t)512 * 64 * 2);
  p.g2t = (u16*)take((size_t)512 * 128 * 2);
#if 1
  p.p0 = 0; p.p1 = NPHASE;
  hipMemsetAsync(p.bar, 0, 16384, stream);
  void* args[] = {&p};
  hipError_t e = hipLaunchCooperativeKernel((void*)mega, dim3(grid_blocks), dim3(256), args, 0, stream);
  if (e != hipSuccess) fprintf(stderr, "cooperative launch failed: %s (grid %d)\n", hipGetErrorString(e), grid_blocks);
#else
  for (int ph = 0; ph < NPHASE; ph++) {
    p.p0 = ph; p.p1 = ph + 1;
    mega<<<dim3(grid_blocks), dim3(256), 0, stream>>>(p);
  }
#endif
}
```

```cpp
#include <hip/hip_runtime.h>
#include <hip/hip_cooperative_groups.h>
#include <cstdio>
namespace cg = cooperative_groups;

typedef unsigned short u16;
typedef __attribute__((ext_vector_type(8))) short bf16x8;
typedef __attribute__((ext_vector_type(4))) float f32x4;

#define NT 16512
#define PSTR 4480

#define O_RWKV_P 16908288ull
#define O_SHIFT_P 17039360ull
#define O_SSM_P 17046528ull
#define O_CONV_P 17570816ull
#define O_HGRN_P 17589248ull
#define O_RWKV_S 18113536ull
#define O_SHIFT_S 18637824ull
#define O_SSM_S 18666496ull
#define O_CONV_S 20763648ull
#define O_HGRN_S 20837376ull

struct Params {
  const float *x_prompt, *x_sample, *st_rwkv, *st_shift, *st_ssm, *st_conv, *st_hgrn, *c_prompt, *c_sample;
  const float *norm_mix_w, *norm_ffn_w, *norm_out_w, *ada_w, *ada_b, *w_in_ab, *w_out_ab, *mu_a, *w0, *w2, *a0, *a2,
      *g2, *k_k, *k_a, *r_k, *lnx_w, *lnx_b, *conv_w, *conv_b, *dt_bias, *a_log, *d_skip, *norm_b_w, *w_in_c,
      *w_out_c, *lb_param, *norm_c_w, *w_gate, *w_up, *w_down;
  float* out;
  float *mod, *bonus, *dtb;
  u16 *wb_in, *wb_out, *wb_gu, *wb_dn, *hm, *pbuf, *rw, *cv;
  float* scr;
  u16* ub;
  u16 *w2t, *a2t, *g2t;
  unsigned* bar;
  int p0, p1;
};

typedef const __attribute__((address_space(4))) Params& CP;
typedef const __attribute__((address_space(4))) Params* CPP;
__device__ __forceinline__ CPP getp() {
  CPP pp = (CPP)__builtin_amdgcn_kernarg_segment_ptr();
  asm volatile("" : "+s"(pp) : : "memory");
  return pp;
}
__device__ __forceinline__ int otid() {
  int t = threadIdx.x;
  asm volatile("" : "+v"(t));
  return t;
}
__device__ __forceinline__ float bf2f(u16 u) { return __uint_as_float(((unsigned)u) << 16); }
typedef float f32x2_t __attribute__((ext_vector_type(2)));
typedef __bf16 bf16x2_t __attribute__((ext_vector_type(2)));
__device__ __forceinline__ unsigned pack2(float a, float b) {
  f32x2_t v = {a, b};
  bf16x2_t r = __builtin_convertvector(v, bf16x2_t);
  return __builtin_bit_cast(unsigned, r);
}
__device__ __forceinline__ u16 f2bf(float f) { return (u16)(pack2(f, f) & 0xffffu); }
__device__ __forceinline__ float lo16(unsigned v) { return __uint_as_float(v << 16); }
__device__ __forceinline__ float hi16(unsigned v) { return __uint_as_float(v & 0xffff0000u); }
__device__ __forceinline__ float sigm(float x) { return __builtin_amdgcn_rcpf(1.f + __expf(-x)); }
__device__ __forceinline__ float silu_(float x) { return x * __builtin_amdgcn_rcpf(1.f + __expf(-x)); }
__device__ __forceinline__ float softplus_(float x) {
  const float e = __expf(x);
  return x > 20.f ? x : (e < 1e-4f ? e * (1.f - 0.5f * e) : __logf(1.f + e));
}
__device__ __forceinline__ float tanh_(float x) { return 1.f - 2.f * __builtin_amdgcn_rcpf(1.f + __expf(2.f * x)); }

__device__ __forceinline__ int row_seq(int m) { return m < 16384 ? (m >> 13) : 2 + ((m - 16384) >> 4); }
__device__ __forceinline__ int seq_row0(int s) { return s < 2 ? s * 8192 : 16384 + (s - 2) * 16; }
__device__ __forceinline__ int seq_len(int s) { return s < 2 ? 8192 : 16; }
__device__ __forceinline__ float* out_state(float* out, int s, int j, size_t baseP, size_t baseS, size_t sz) {
  return s < 2 ? out + baseP + (size_t)(s * 2 + j) * sz : out + baseS + (size_t)((s - 2) * 2 + j) * sz;
}

template <int CTRL>
__device__ __forceinline__ float dpp_f(float x) {
  return __int_as_float(__builtin_amdgcn_update_dpp(0, __float_as_int(x), CTRL, 0xf, 0xf, false));
}
__device__ __forceinline__ float red16(float x) {
  x += dpp_f<0xB1>(x);
  x += dpp_f<0x4E>(x);
  x += dpp_f<0x124>(x);
  x += dpp_f<0x128>(x);
  return x;
}
__device__ __forceinline__ float red32_hi(float x) {
  x = red16(x);
  float y = __int_as_float(__builtin_amdgcn_update_dpp(0, __float_as_int(x), 0x142, 0xA, 0xf, false));
  return x + y;
}
__device__ __forceinline__ float wave_sum(float x) {
  x = red16(x);
  x += __int_as_float(__builtin_amdgcn_update_dpp(0, __float_as_int(x), 0x142, 0xA, 0xf, false));
  x += __int_as_float(__builtin_amdgcn_update_dpp(0, __float_as_int(x), 0x143, 0xC, 0xf, false));
  return __int_as_float(__builtin_amdgcn_readlane(__float_as_int(x), 63));
}

__device__ void phase_mod(CP p, char* smem, int bid, int nb) {
  if (bid >= 384) return;
  float* sc = (float*)smem;
  float* red = sc + 10 * 1024;
  const int tid = otid(), lane = tid & 63, wv = tid >> 6;
  for (int i = tid; i < 10 * 1024; i += 256) {
    int s = i >> 10, k = i & 1023;
    float c = s < 2 ? p.c_prompt[s * 1024 + k] : p.c_sample[(s - 2) * 1024 + k];
    sc[i] = silu_(c);
  }
  __syncthreads();
  for (int u = bid; u < 384; u += nb) {
    int L = u / 96, cgp = u % 96;
    int col = cgp * 64 + lane;
    const float* W = p.ada_w + (size_t)L * 1024 * 6144 + col;
    float acc[10];
#pragma unroll
    for (int s = 0; s < 10; s++) acc[s] = 0.f;
    int k0 = wv * 256;
#pragma unroll 4
    for (int k = k0; k < k0 + 256; k += 4) {
      float w0 = W[(size_t)k * 6144], w1 = W[(size_t)(k + 1) * 6144], w2 = W[(size_t)(k + 2) * 6144],
            w3 = W[(size_t)(k + 3) * 6144];
#pragma unroll
      for (int s = 0; s < 10; s++) {
        float4 c4 = *(const float4*)&sc[s * 1024 + k];
        acc[s] += c4.x * w0 + c4.y * w1 + c4.z * w2 + c4.w * w3;
      }
    }
#pragma unroll
    for (int s = 0; s < 10; s++) red[(wv * 10 + s) * 64 + lane] = acc[s];
    __syncthreads();
    for (int i = tid; i < 640; i += 256) {
      int s = i >> 6, l = i & 63;
      float v = red[(0 * 10 + s) * 64 + l] + red[(1 * 10 + s) * 64 + l] + red[(2 * 10 + s) * 64 + l] +
                red[(3 * 10 + s) * 64 + l];
      int c = cgp * 64 + l;
      p.mod[((size_t)L * 10 + s) * 6144 + c] = v + p.ada_b[L * 6144 + c];
    }
    __syncthreads();
  }
}

__device__ __forceinline__ void wconv_tile(const float* __restrict__ src, int K, int N, u16* __restrict__ dst, int k0,
                                           int n0, int mode, float* tile) {
  const int tid = otid();
#pragma unroll
  for (int i = 0; i < 4; i++) {
    int r = i * 16 + (tid >> 4), c = (tid & 15) * 4;
    int n = n0 + c;
    float4 v4 = n < N ? *(const float4*)(src + (size_t)(k0 + r) * N + n) : make_float4(0.f, 0.f, 0.f, 0.f);
    tile[r * 65 + c] = v4.x; tile[r * 65 + c + 1] = v4.y; tile[r * 65 + c + 2] = v4.z; tile[r * 65 + c + 3] = v4.w;
  }
  __syncthreads();
  int n = tid >> 2, kc = (tid & 3) * 16;
  unsigned pk[8];
#pragma unroll
  for (int i = 0; i < 8; i++) pk[i] = pack2(tile[(kc + 2 * i) * 65 + n], tile[(kc + 2 * i + 1) * 65 + n]);
  int gn = n0 + n;
  int row = mode == 0 ? gn : ((gn >> 4) * 32 + (gn & 15) + (mode == 2 ? 16 : 0));
  uint4* d = (uint4*)(dst + (size_t)row * K + k0 + kc);
  d[0] = make_uint4(pk[0], pk[1], pk[2], pk[3]);
  d[1] = make_uint4(pk[4], pk[5], pk[6], pk[7]);
  __syncthreads();
}

__device__ void phase_wconv(CP p, int L, char* smem, int bid, int nb) {
  float* tile = (float*)smem;
  const int j = L >> 1;
  const bool even = (L & 1) == 0;
  const int ntn_in = even ? 70 : 64;
  const int n_in = 16 * ntn_in;
  const int n_out = even ? 24 * 16 : 16 * 16;
  const int n_g = 16 * 44;
  const int n_lora = even ? 32 : 0;
  const int total = n_in + n_out + 3 * n_g + n_lora;
  for (int u = bid; u < total; u += nb) {
    int li = u;
    if (li < n_in) {
      int kt = li / ntn_in, nt = li % ntn_in;
      if (even)
        wconv_tile(p.w_in_ab + (size_t)j * 1024 * 4368, 1024, 4368, p.wb_in, kt * 64, nt * 64, 0, tile);
      else
        wconv_tile(p.w_in_c + (size_t)j * 1024 * 4096, 1024, 4096, p.wb_in, kt * 64, nt * 64, 0, tile);
      continue;
    }
    li -= n_in;
    if (li < n_out) {
      int kt = li / 16, nt = li % 16;
      if (even)
        wconv_tile(p.w_out_ab + (size_t)j * 1536 * 1024, 1536, 1024, p.wb_out, kt * 64, nt * 64, 0, tile);
      else
        wconv_tile(p.w_out_c + (size_t)j * 1024 * 1024, 1024, 1024, p.wb_out, kt * 64, nt * 64, 0, tile);
      continue;
    }
    li -= n_out;
    if (li < n_g) {
      int kt = li / 44, nt = li % 44;
      wconv_tile(p.w_gate + (size_t)L * 1024 * 2816, 1024, 2816, p.wb_gu, kt * 64, nt * 64, 1, tile);
      continue;
    }
    li -= n_g;
    if (li < n_g) {
      int kt = li / 44, nt = li % 44;
      wconv_tile(p.w_up + (size_t)L * 1024 * 2816, 1024, 2816, p.wb_gu, kt * 64, nt * 64, 2, tile);
      continue;
    }
    li -= n_g;
    if (li < n_g) {
      int kt = li / 16, nt = li % 16;
      wconv_tile(p.w_down + (size_t)L * 2816 * 1024, 2816, 1024, p.wb_dn, kt * 64, nt * 64, 0, tile);
      continue;
    }
    li -= n_g;
    if (li < 8) wconv_tile(p.w2 + (size_t)j * 64 * 512, 64, 512, p.w2t, 0, li * 64, 0, tile);
    else if (li < 16) wconv_tile(p.a2 + (size_t)j * 64 * 512, 64, 512, p.a2t, 0, (li - 8) * 64, 0, tile);
    else wconv_tile(p.g2 + (size_t)j * 128 * 512, 128, 512, p.g2t, ((li - 16) >> 3) * 64, ((li - 16) & 7) * 64, 0, tile);
  }
}

__device__ void phase_norm(CP p, int L, int which, int bid, int nb) {
  const int tid = otid(), lane = tid & 63, wv = tid >> 6;
  const bool first = (L == 0 && which == 0);
  const float* nw = (which ? p.norm_ffn_w : p.norm_mix_w) + L * 1024;
  float* X = p.out;
  for (int row = bid * 4 + wv; row < NT; row += nb * 4) {
    const float* x = first ? (row < 16384 ? p.x_prompt + (size_t)row * 1024 : p.x_sample + (size_t)(row - 16384) * 1024)
                           : X + (size_t)row * 1024;
    float4 v[4];
    float ss = 0.f;
#pragma unroll
    for (int i = 0; i < 4; i++) {
      v[i] = *(const float4*)(x + i * 256 + lane * 4);
      ss += v[i].x * v[i].x + v[i].y * v[i].y + v[i].z * v[i].z + v[i].w * v[i].w;
    }
    ss = wave_sum(ss);
    float rstd = rsqrtf(ss * (1.f / 1024.f) + 1e-6f);
    int s = row_seq(row);
    const float* md = p.mod + ((size_t)L * 10 + s) * 6144 + (which ? 3072 : 0);
#pragma unroll
    for (int i = 0; i < 4; i++) {
      int c = i * 256 + lane * 4;
      float4 w4 = *(const float4*)(nw + c);
      float4 sh = *(const float4*)(md + c);
      float4 sc = *(const float4*)(md + 1024 + c);
      float h0 = v[i].x * rstd * w4.x * (1.f + sc.x) + sh.x;
      float h1 = v[i].y * rstd * w4.y * (1.f + sc.y) + sh.y;
      float h2 = v[i].z * rstd * w4.z * (1.f + sc.z) + sh.z;
      float h3 = v[i].w * rstd * w4.w * (1.f + sc.w) + sh.w;
      *(uint2*)(p.hm + (size_t)row * 1024 + c) = make_uint2(pack2(h0, h1), pack2(h2, h3));
      if (first) *(float4*)(X + (size_t)row * 1024 + c) = v[i];
    }
  }
}

__device__ void phase_final(CP p, int bid, int nb) {
  const int tid = otid(), lane = tid & 63, wv = tid >> 6;
  float* X = p.out;
  for (int row = bid * 4 + wv; row < NT; row += nb * 4) {
    float* x = X + (size_t)row * 1024;
    float4 v[4];
    float ss = 0.f;
#pragma unroll
    for (int i = 0; i < 4; i++) {
      v[i] = *(const float4*)(x + i * 256 + lane * 4);
      ss += v[i].x * v[i].x + v[i].y * v[i].y + v[i].z * v[i].z + v[i].w * v[i].w;
    }
    ss = wave_sum(ss);
    float rstd = rsqrtf(ss * (1.f / 1024.f) + 1e-6f);
#pragma unroll
    for (int i = 0; i < 4; i++) {
      int c = i * 256 + lane * 4;
      float4 w4 = *(const float4*)(p.norm_out_w + c);
      float4 o;
      o.x = v[i].x * rstd * w4.x;
      o.y = v[i].y * rstd * w4.y;
      o.z = v[i].z * rstd * w4.z;
      o.w = v[i].w * rstd * w4.w;
      *(float4*)(x + c) = o;
    }
  }
}

__device__ void gemm_phase(CP p, const u16* __restrict__ A, int lda, const u16* __restrict__ Bt, int K,
                           int ntn, int epi, u16* __restrict__ outb, int ldo, int ncols, const float* __restrict__ gate,
                           char* smem, int bid, int nb) {
  u16* As = (u16*)smem;
  u16* Bs = As + 128 * 64;
  const int tid = otid(), lane = tid & 63, wv = tid >> 6;
  const int wm = wv >> 1, wn = wv & 1;
  const int lr = tid >> 3, lc = tid & 7;
  const int l15 = lane & 15, lq = lane >> 4;
  const int nk = K >> 6;
  const int nitems = (epi == 2) ? 128 * ntn + 8 * ntn : 129 * ntn;
#define G_DECODE(tile_, mt_, nt_, kt0_, kt1_, split_) { \
    kt0_ = 0; kt1_ = nk; split_ = false; \
    if (epi == 2 && (tile_) >= 128 * ntn) { \
      const int r_ = (tile_) - 128 * ntn; \
      mt_ = 128; nt_ = r_ >> 3; split_ = true; \
      kt0_ = ((r_ & 7) * nk) >> 3; kt1_ = (((r_ & 7) + 1) * nk) >> 3; \
    } else if (epi == 2 && nb == 512 && ntn == 4) { \
        \
      const int slot_ = (tile_) >> 3; \
      mt_ = ((tile_) & 7) * 16 + (slot_ >> 2); nt_ = slot_ & 3; \
    } else { mt_ = (tile_) / ntn; nt_ = (tile_) % ntn; } }
  uint4 ra0, ra1, ra2, ra3, rb0, rb1, rb2, rb3, rb4, rb5, rb6, rb7;
  const int voA = lr * lda + lc * 8, voB = lr * K + lc * 8;
  const int sA = 32 * lda, sB = 32 * K;
#define G_BL(rs_, vo_, so_) __builtin_bit_cast(uint4, __builtin_amdgcn_raw_buffer_load_b128(rs_, vo_, so_, 0))
#define G_LOADP(ab_, bb_, kt_) { \
    __amdgpu_buffer_rsrc_t ra_ = __builtin_amdgcn_make_buffer_rsrc((void*)(ab_), 0, 0x7ffffff0, 0x00020000); \
    __amdgpu_buffer_rsrc_t rb_ = __builtin_amdgcn_make_buffer_rsrc((void*)(bb_), 0, 0x7ffffff0, 0x00020000); \
    const int ka_ = (kt_) * 128; \
    ra0 = G_BL(ra_, voA * 2, ka_); ra1 = G_BL(ra_, voA * 2, ka_ + 2 * sA); ra2 = G_BL(ra_, voA * 2, ka_ + 4 * sA); ra3 = G_BL(ra_, voA * 2, ka_ + 6 * sA); \
    rb0 = G_BL(rb_, voB * 2, ka_); rb1 = G_BL(rb_, voB * 2, ka_ + 2 * sB); rb2 = G_BL(rb_, voB * 2, ka_ + 4 * sB); rb3 = G_BL(rb_, voB * 2, ka_ + 6 * sB); \
    rb4 = G_BL(rb_, voB * 2, ka_ + 8 * sB); rb5 = G_BL(rb_, voB * 2, ka_ + 10 * sB); rb6 = G_BL(rb_, voB * 2, ka_ + 12 * sB); rb7 = G_BL(rb_, voB * 2, ka_ + 14 * sB); }
  bool have = false;
  for (int tile = bid; tile < nitems; tile += nb) {
    int mt, nt, kt0, kt1;
    bool split;
    G_DECODE(tile, mt, nt, kt0, kt1, split)
    const int m0 = mt * 128, n0 = nt * 256;
    f32x4 acc0[4][4], acc1[4][4];
#pragma unroll
    for (int a = 0; a < 4; a++)
#pragma unroll
      for (int b = 0; b < 4; b++) { acc0[a][b] = (f32x4){0.f, 0.f, 0.f, 0.f}; acc1[a][b] = (f32x4){0.f, 0.f, 0.f, 0.f}; }
    const u16* Ab = A + (size_t)m0 * lda;
    const u16* Bb = Bt + (size_t)n0 * K;
    u16* Aw = As + lr * 64 + ((lc ^ (lr & 7)) * 8);
    u16* Bw = Bs + lr * 64 + ((lc ^ (lr & 7)) * 8);
    if (!have) G_LOADP(Ab, Bb, kt0)
    for (int kt = kt0; kt < kt1; kt++) {
      __syncthreads();
      *(uint4*)(Aw) = ra0; *(uint4*)(Aw + 32 * 64) = ra1; *(uint4*)(Aw + 64 * 64) = ra2; *(uint4*)(Aw + 96 * 64) = ra3;
      *(uint4*)(Bw) = rb0; *(uint4*)(Bw + 32 * 64) = rb1; *(uint4*)(Bw + 64 * 64) = rb2; *(uint4*)(Bw + 96 * 64) = rb3;
      *(uint4*)(Bw + 128 * 64) = rb4; *(uint4*)(Bw + 160 * 64) = rb5; *(uint4*)(Bw + 192 * 64) = rb6; *(uint4*)(Bw + 224 * 64) = rb7;
      __syncthreads();
      if (kt + 1 < kt1) G_LOADP(Ab, Bb, kt + 1)
      {
        const int sw0 = (lq ^ (l15 & 7)) * 8, sw1 = ((lq + 4) ^ (l15 & 7)) * 8;
        __builtin_amdgcn_s_setprio(1);
        const u16* Ar = As + (wm * 64 + l15) * 64;
        const u16* Br = Bs + (wn * 128 + l15) * 64;
        bf16x8 af0[4];
#pragma unroll
        for (int mi = 0; mi < 4; mi++) af0[mi] = *(const bf16x8*)(Ar + mi * 16 * 64 + sw0);
        bf16x8 bq0 = *(const bf16x8*)(Br + sw0);
        bf16x8 bq1 = *(const bf16x8*)(Br + 16 * 64 + sw0);
        __builtin_amdgcn_sched_barrier(0);
#define G_STEP(ACC, nidx, bcur, nextni, nextsw, donext) { \
          bf16x8 bn_ = bcur; \
          if (donext) bcur = *(const bf16x8*)(Br + (nextni) * 16 * 64 + (nextsw)); \
          _Pragma("unroll") for (int mi = 0; mi < 4; mi++) \
            ACC[mi][nidx] = __builtin_amdgcn_mfma_f32_16x16x32_bf16(af0[mi], bn_, ACC[mi][nidx], 0, 0, 0); \
          __builtin_amdgcn_sched_barrier(0); }
        G_STEP(acc0, 0, bq0, 2, sw0, true)
        G_STEP(acc0, 1, bq1, 3, sw0, true)
        G_STEP(acc0, 2, bq0, 4, sw0, true)
        G_STEP(acc0, 3, bq1, 5, sw0, true)
        G_STEP(acc1, 0, bq0, 6, sw0, true)
        G_STEP(acc1, 1, bq1, 7, sw0, true)
        G_STEP(acc1, 2, bq0, 0, sw1, true)
        G_STEP(acc1, 3, bq1, 1, sw1, true)
#pragma unroll
        for (int mi = 0; mi < 4; mi++) af0[mi] = *(const bf16x8*)(Ar + mi * 16 * 64 + sw1);
        __builtin_amdgcn_sched_barrier(0);
        G_STEP(acc0, 0, bq0, 2, sw1, true)
        G_STEP(acc0, 1, bq1, 3, sw1, true)
        G_STEP(acc0, 2, bq0, 4, sw1, true)
        G_STEP(acc0, 3, bq1, 5, sw1, true)
        G_STEP(acc1, 0, bq0, 6, sw1, true)
        G_STEP(acc1, 1, bq1, 7, sw1, true)
        G_STEP(acc1, 2, bq0, 0, 0, false)
        G_STEP(acc1, 3, bq1, 0, 0, false)
        __builtin_amdgcn_s_setprio(0);
      }
    }
    {
      const int ntile = tile + nb;
      have = ntile < nitems;
      if (have) {
        int mt2, nt2, k0n, k1n; bool sp2;
        G_DECODE(ntile, mt2, nt2, k0n, k1n, sp2)
        (void)k1n; (void)sp2;
        G_LOADP(A + (size_t)(mt2 * 128) * lda, Bt + (size_t)(nt2 * 256) * K, k0n)
      }
    }
    if (epi == 2) {
#pragma unroll
      for (int mi = 0; mi < 4; mi++)
#pragma unroll
        for (int jj = 0; jj < 4; jj++) {
          int row = m0 + wm * 64 + mi * 16 + lq * 4 + jj;
          int s = row_seq(row);
          const float* g = gate + (size_t)s * 6144;
          float* xr = p.out + (size_t)row * 1024;
#pragma unroll
          for (int ni = 0; ni < 4; ni++) {
            int col = n0 + wn * 128 + ni * 16 + l15;
            if (split) { atomicAdd(&xr[col], g[col] * acc0[mi][ni][jj]); atomicAdd(&xr[col + 64], g[col + 64] * acc1[mi][ni][jj]); }
            else { xr[col] += g[col] * acc0[mi][ni][jj]; xr[col + 64] += g[col + 64] * acc1[mi][ni][jj]; }
          }
        }
    } else if (epi == 0) {
      u16* Cs = (u16*)smem;
#define EPI0_HALF(hp, ACC) { \
        __syncthreads(); \
        _Pragma("unroll") for (int mi = 0; mi < 4; mi++) \
          _Pragma("unroll") for (int n4 = 0; n4 < 4; n4++) \
            _Pragma("unroll") for (int jj = 0; jj < 4; jj++) { \
              int r = wm * 64 + mi * 16 + lq * 4 + jj, c = wn * 64 + n4 * 16 + l15; \
              Cs[r * 136 + c] = f2bf(ACC[mi][n4][jj]); } \
        __syncthreads(); \
        _Pragma("unroll") for (int i = 0; i < 8; i++) { \
          int q = tid + 256 * i; \
          int r = q >> 4, ch = q & 15; \
          int gcol = n0 + (ch >> 3) * 128 + (hp) * 64 + (ch & 7) * 8; \
          if (gcol < ncols) *(uint4*)(outb + (size_t)(m0 + r) * ldo + gcol) = *(const uint4*)(Cs + r * 136 + ch * 8); } }
      EPI0_HALF(0, acc0)
      EPI0_HALF(1, acc1)
    } else {
      __syncthreads();
      u16* Cs = (u16*)smem;
#pragma unroll
      for (int mi = 0; mi < 4; mi++)
#pragma unroll
        for (int i2 = 0; i2 < 2; i2++)
#pragma unroll
          for (int jj = 0; jj < 4; jj++) {
            int r = wm * 64 + mi * 16 + lq * 4 + jj, c = wn * 64 + i2 * 16 + l15;
            float g0 = acc0[mi][2 * i2][jj], u0 = acc0[mi][2 * i2 + 1][jj];
            float g1 = acc1[mi][2 * i2][jj], u1 = acc1[mi][2 * i2 + 1][jj];
            Cs[r * 136 + c] = f2bf(silu_(g0) * u0);
            Cs[r * 136 + c + 32] = f2bf(silu_(g1) * u1);
          }
      __syncthreads();
#pragma unroll
      for (int i = 0; i < 8; i++) {
        int q = tid + 256 * i;
        int r = q >> 4, ch = q & 15;
        *(uint4*)(outb + (size_t)(m0 + r) * ldo + nt * 128 + ch * 8) = *(const uint4*)(Cs + r * 136 + ch * 8);
      }
    }
  }
}

__device__ void phase_prep_even(CP p, int j, char* smem, int bid, int nb) {
  const int tid = otid();
  const u16* P = p.pbuf;
  {
    u16* txb = (u16*)smem;
    u16* xab = txb + 16 * 72;
    float* resw = (float*)(xab + 16 * 72);
    float* resa = resw + 8 * 512;
    for (int i = tid; i < 2 * 16 * 72; i += 256) txb[i] = 0;
    const int half = tid >> 7, hk = tid & 127, h = hk >> 4, kq = hk & 15;
    const int c4 = h * 64 + kq * 4;
    const float* mu = p.mu_a + j * 1792;
    for (int u = bid; u < NT / 8; u += nb) {
      const int m0 = u * 8;
      const int s = row_seq(m0);
      const int r0 = seq_row0(s);
      __syncthreads();
#pragma unroll
      for (int i = 0; i < 4; i++) {
        int idx = tid + 256 * i;
        int tok = idx >> 7, cc = idx & 127;
        int m = m0 + tok;
        int col = 1536 + cc;
        float pc = bf2f(P[(size_t)m * PSTR + col]);
        float pp = (m > r0) ? bf2f(P[(size_t)(m - 1) * PSTR + col])
                            : (s >= 2 ? p.st_shift[((size_t)(s - 2) * 2 + j) * 1792 + col] : 0.f);
        float pm = pc + (pp - pc) * mu[col];
        if (cc < 64)
          txb[tok * 72 + cc] = f2bf(tanh_(pm));
        else
          xab[tok * 72 + cc - 64] = f2bf(pm);
      }
      __syncthreads();
      {
        const int lane = tid & 63, wv = tid >> 6, l15 = lane & 15, lq = lane >> 4;
        bf16x8 aw[2], aa[2];
#pragma unroll
        for (int ks = 0; ks < 2; ks++) {
          aw[ks] = *(const bf16x8*)(txb + l15 * 72 + ks * 32 + lq * 8);
          aa[ks] = *(const bf16x8*)(xab + l15 * 72 + ks * 32 + lq * 8);
        }
#pragma unroll
        for (int nt = 0; nt < 8; nt++) {
          const int n = wv * 128 + nt * 16 + l15;
          f32x4 cw = (f32x4){0.f, 0.f, 0.f, 0.f}, ca = (f32x4){0.f, 0.f, 0.f, 0.f};
#pragma unroll
          for (int ks = 0; ks < 2; ks++) {
            bf16x8 bw = *(const bf16x8*)(p.w2t + (size_t)n * 64 + ks * 32 + lq * 8);
            bf16x8 ba = *(const bf16x8*)(p.a2t + (size_t)n * 64 + ks * 32 + lq * 8);
            cw = __builtin_amdgcn_mfma_f32_16x16x32_bf16(aw[ks], bw, cw, 0, 0, 0);
            ca = __builtin_amdgcn_mfma_f32_16x16x32_bf16(aa[ks], ba, ca, 0, 0, 0);
          }
          if (lq < 2) {
#pragma unroll
            for (int jj = 0; jj < 4; jj++) {
              resw[(lq * 4 + jj) * 512 + n] = cw[jj];
              resa[(lq * 4 + jj) * 512 + n] = ca[jj];
            }
          }
        }
      }
      __syncthreads();
      float accw[4][4], acca[4][4];
#pragma unroll
      for (int tk = 0; tk < 4; tk++) {
        float4 rw4 = *(const float4*)(resw + (half * 4 + tk) * 512 + c4);
        float4 ra4 = *(const float4*)(resa + (half * 4 + tk) * 512 + c4);
        accw[tk][0] = rw4.x; accw[tk][1] = rw4.y; accw[tk][2] = rw4.z; accw[tk][3] = rw4.w;
        acca[tk][0] = ra4.x; acca[tk][1] = ra4.y; acca[tk][2] = ra4.z; acca[tk][3] = ra4.w;
      }
      float4 w0v = *(const float4*)(p.w0 + j * 512 + c4);
      float4 a0v = *(const float4*)(p.a0 + j * 512 + c4);
      float4 kkv = *(const float4*)(p.k_k + j * 512 + c4);
      float4 kav = *(const float4*)(p.k_a + j * 512 + c4);
      float4 rkv = *(const float4*)(p.r_k + j * 512 + c4);
      float4 mur = *(const float4*)(mu + c4);
      float4 muk = *(const float4*)(mu + 512 + c4);
      float4 muv = *(const float4*)(mu + 1024 + c4);
      const float w0a[4] = {w0v.x, w0v.y, w0v.z, w0v.w};
      const float a0a[4] = {a0v.x, a0v.y, a0v.z, a0v.w};
      const float kka[4] = {kkv.x, kkv.y, kkv.z, kkv.w};
      const float kaa[4] = {kav.x, kav.y, kav.z, kav.w};
      const float rka[4] = {rkv.x, rkv.y, rkv.z, rkv.w};
      const float mura[4] = {mur.x, mur.y, mur.z, mur.w};
      const float muka[4] = {muk.x, muk.y, muk.z, muk.w};
      const float muva[4] = {muv.x, muv.y, muv.z, muv.w};
#pragma unroll
      for (int tk = 0; tk < 4; tk++) {
        const int m = m0 + half * 4 + tk;
        uint2 pr = *(const uint2*)(P + (size_t)m * PSTR + c4);
        uint2 pk = *(const uint2*)(P + (size_t)m * PSTR + 512 + c4);
        uint2 pv = *(const uint2*)(P + (size_t)m * PSTR + 1024 + c4);
        float rc[4] = {lo16(pr.x), hi16(pr.x), lo16(pr.y), hi16(pr.y)};
        float kc[4] = {lo16(pk.x), hi16(pk.x), lo16(pk.y), hi16(pk.y)};
        float vc[4] = {lo16(pv.x), hi16(pv.x), lo16(pv.y), hi16(pv.y)};
        float rp[4], kp[4], vp[4];
        if (m > r0) {
          uint2 qr = *(const uint2*)(P + (size_t)(m - 1) * PSTR + c4);
          uint2 qk = *(const uint2*)(P + (size_t)(m - 1) * PSTR + 512 + c4);
          uint2 qv = *(const uint2*)(P + (size_t)(m - 1) * PSTR + 1024 + c4);
          rp[0] = lo16(qr.x); rp[1] = hi16(qr.x); rp[2] = lo16(qr.y); rp[3] = hi16(qr.y);
          kp[0] = lo16(qk.x); kp[1] = hi16(qk.x); kp[2] = lo16(qk.y); kp[3] = hi16(qk.y);
          vp[0] = lo16(qv.x); vp[1] = hi16(qv.x); vp[2] = lo16(qv.y); vp[3] = hi16(qv.y);
        } else if (s >= 2) {
          const float* sp = p.st_shift + ((size_t)(s - 2) * 2 + j) * 1792;
#pragma unroll
          for (int e = 0; e < 4; e++) { rp[e] = sp[c4 + e]; kp[e] = sp[512 + c4 + e]; vp[e] = sp[1024 + c4 + e]; }
        } else {
#pragma unroll
          for (int e = 0; e < 4; e++) { rp[e] = 0.f; kp[e] = 0.f; vp[e] = 0.f; }
        }
        float r[4], k[4], v[4], kk[4], kn[4], bb[4], ee[4];
        float ssq = 0.f, bsum = 0.f;
#pragma unroll
        for (int e = 0; e < 4; e++) {
          r[e] = rc[e] + (rp[e] - rc[e]) * mura[e];
          k[e] = kc[e] + (kp[e] - kc[e]) * muka[e];
          v[e] = vc[e] + (vp[e] - vc[e]) * muva[e];
          float wpre = w0a[e] + accw[tk][e];
          float w = -softplus_(-wpre) - 0.5f;
          { const float ew = __expf(w); ee[e] = ew < 1e-3f ? ew * (1.f - 0.5f * ew) : 1.f - __expf(-ew); }
          float a = sigm(a0a[e] + acca[tk][e]);
          kk[e] = k[e] * kka[e];
          ssq += kk[e] * kk[e];
          kn[e] = k[e] * (1.f + (a - 1.f) * kaa[e]);
          bb[e] = a;
          bsum += r[e] * kn[e] * rka[e];
        }
        ssq = red16(ssq);
        bsum = red16(bsum);
        float inv = rsqrtf(fmaxf(ssq, 1e-24f));
#pragma unroll
        for (int e = 0; e < 4; e++) { kk[e] *= inv; bb[e] = kk[e] * bb[e]; }
        if (kq == 0) p.bonus[(size_t)m * 8 + h] = bsum;
        uint4* dst = (uint4*)(p.rw + (((size_t)m * 8 + h) * 16 + kq) * 24);
        dst[0] = make_uint4(pack2(r[0], r[1]), pack2(r[2], r[3]), pack2(kn[0], kn[1]), pack2(kn[2], kn[3]));
        dst[1] = make_uint4(pack2(kk[0], kk[1]), pack2(kk[2], kk[3]), pack2(bb[0], bb[1]), pack2(bb[2], bb[3]));
        dst[2] = make_uint4(pack2(ee[0], ee[1]), pack2(ee[2], ee[3]), pack2(v[0], v[1]), pack2(v[2], v[3]));
      }
    }
  }
  for (int idx = bid * 256 + tid; idx < 10 * 1792; idx += nb * 256) {
    int s = idx / 1792, c = idx % 1792;
    int m = seq_row0(s) + seq_len(s) - 1;
    float* o = out_state(p.out, s, j, O_SHIFT_P, O_SHIFT_S, 1792);
    o[c] = bf2f(P[(size_t)m * PSTR + c]);
  }
  for (int u = bid; u < NT / 16; u += nb) {
    const int mb = u * 16;
    const int s = row_seq(mb);
    const int r0 = seq_row0(s);
    if (tid < 192) {
      const int c0 = tid * 8;
      const int t0 = mb - r0;
      float wgt[4][8], bia[8];
      {
        float4 b0 = *(const float4*)(p.conv_b + j * 1536 + c0), b1 = *(const float4*)(p.conv_b + j * 1536 + c0 + 4);
        bia[0] = b0.x; bia[1] = b0.y; bia[2] = b0.z; bia[3] = b0.w; bia[4] = b1.x; bia[5] = b1.y; bia[6] = b1.z; bia[7] = b1.w;
#pragma unroll
        for (int tap = 0; tap < 4; tap++) {
          const float* cw = p.conv_w + ((size_t)j * 4 + tap) * 1536 + c0;
          float4 w0 = *(const float4*)cw, w1 = *(const float4*)(cw + 4);
          wgt[tap][0] = w0.x; wgt[tap][1] = w0.y; wgt[tap][2] = w0.z; wgt[tap][3] = w0.w;
          wgt[tap][4] = w1.x; wgt[tap][5] = w1.y; wgt[tap][6] = w1.z; wgt[tap][7] = w1.w;
        }
      }
#pragma unroll 1
      for (int hf = 0; hf < 2; hf++) {
      uint4 rows[11];
#pragma unroll
      for (int i = 0; i < 11; i++) {
        const int tt = t0 + hf * 8 - 3 + i;
        if (tt >= 0) {
          rows[i] = *(const uint4*)(P + (size_t)(r0 + tt) * PSTR + 2816 + c0);
        } else if (s >= 2) {
          const float* cs = p.st_conv + (((size_t)(s - 2) * 2 + j) * 3 + (tt + 3)) * 1536 + c0;
          float4 q0 = *(const float4*)cs, q1 = *(const float4*)(cs + 4);
          rows[i] = make_uint4(pack2(q0.x, q0.y), pack2(q0.z, q0.w), pack2(q1.x, q1.y), pack2(q1.z, q1.w));
        } else {
          rows[i] = make_uint4(0, 0, 0, 0);
        }
      }
#pragma unroll
      for (int t = 0; t < 8; t++) {
        float acc[8];
#pragma unroll
        for (int e = 0; e < 8; e++) acc[e] = bia[e];
#pragma unroll
        for (int tap = 0; tap < 4; tap++) {
          const uint4 q = rows[t + tap];
          acc[0] += wgt[tap][0] * lo16(q.x); acc[1] += wgt[tap][1] * hi16(q.x);
          acc[2] += wgt[tap][2] * lo16(q.y); acc[3] += wgt[tap][3] * hi16(q.y);
          acc[4] += wgt[tap][4] * lo16(q.z); acc[5] += wgt[tap][5] * hi16(q.z);
          acc[6] += wgt[tap][6] * lo16(q.w); acc[7] += wgt[tap][7] * hi16(q.w);
        }
        *(uint4*)(p.cv + (size_t)(mb + hf * 8 + t) * 1536 + c0) =
            make_uint4(pack2(silu_(acc[0]), silu_(acc[1])), pack2(silu_(acc[2]), silu_(acc[3])),
                       pack2(silu_(acc[4]), silu_(acc[5])), pack2(silu_(acc[6]), silu_(acc[7])));
      }
      }
    }
    {
      int tok = tid >> 4, hh = tid & 15;
      int m = mb + tok;
      float dtv = softplus_(bf2f(P[(size_t)m * PSTR + 4352 + hh]) + p.dt_bias[j * 16 + hh]);
      float* cs = (float*)smem;
      __syncthreads();
      cs[tid] = -dtv * __expf(p.a_log[j * 16 + hh]);
      __syncthreads();
      float G = 0.f;
      for (int i = 0; i <= tok; i++) G += cs[i * 16 + hh];
      p.dtb[(size_t)m * 32 + hh] = dtv;
      p.dtb[(size_t)m * 32 + 16 + hh] = G;
    }
  }
  for (int idx = bid * 256 + tid; idx < 10 * 3 * 1536; idx += nb * 256) {
    int s = idx / 4608, rem = idx % 4608;
    int r = rem / 1536, c = rem % 1536;
    int m = seq_row0(s) + seq_len(s) - 3 + r;
    float* o = out_state(p.out, s, j, O_CONV_P, O_CONV_S, 4608);
    o[rem] = bf2f(P[(size_t)m * PSTR + 2816 + c]);
  }
}

__device__ __forceinline__ void cvt8_store(float* d, uint4 v) {
  *(float4*)d = make_float4(lo16(v.x), hi16(v.x), lo16(v.y), hi16(v.y));
  *(float4*)(d + 4) = make_float4(lo16(v.z), hi16(v.z), lo16(v.w), hi16(v.w));
}

#define RK_NOC 4
#define RK_BASE(p) ((p).scr + 2100000)
#define RK_LS(p) (RK_BASE(p))
#define RK_PS(p) (RK_BASE(p) + 262144)
#define RK_SI(p) (RK_BASE(p) + 524288)
template <int PART>
__device__ __forceinline__ void rwkv_scan_item(CP p, int j, int s, int h, int rg, int oc, int noc, char* smem) {
  float* Lb = (float*)smem;
  float* ob = Lb + 2 * 16 * 16 * 28;
  const int tid = otid(), lane = tid & 63, wv = tid >> 6;
  const int rl = lane >> 4, kq = lane & 15;
  const int R = rg * 16 + wv * 4 + rl;
  const int T = seq_len(s) / noc, m0 = seq_row0(s) + oc * T;
  float S[4];
  if (PART == 1) {
#pragma unroll
    for (int e = 0; e < 4; e++) S[e] = (R == kq * 4 + e) ? 1.f : 0.f;
  } else if (s >= 2) {
    float4 q = *(const float4*)(p.st_rwkv + ((((size_t)(s - 2) * 2 + j) * 8 + h) * 64 + R) * 64 + kq * 4);
    S[0] = q.x; S[1] = q.y; S[2] = q.z; S[3] = q.w;
  } else {
    S[0] = S[1] = S[2] = S[3] = 0.f;
  }
  const u16* src = p.rw + ((size_t)m0 * 8 + h) * 16 * 24;
  const int q0 = tid, q1 = tid + 256, q2 = tid + 512;
  const int so0 = (q0 / 48) * 3072 + (q0 % 48) * 8, so1 = (q1 / 48) * 3072 + (q1 % 48) * 8,
            so2 = (q2 / 48) * 3072 + (q2 % 48) * 8;
  const int do0 = ((q0 / 48) * 16 + (q0 % 48) / 3) * 28 + ((q0 % 48) % 3) * 8,
            do1 = ((q1 / 48) * 16 + (q1 % 48) / 3) * 28 + ((q1 % 48) % 3) * 8,
            do2 = ((q2 / 48) * 16 + (q2 % 48) / 3) * 28 + ((q2 % 48) % 3) * 8;
  u16* outp = PART ? p.ub + (size_t)(m0 + (tid >> 4)) * 512 + h * 64 + rg * 16 + (tid & 15)
                   : p.hm + (size_t)(m0 + (tid >> 4)) * 1536 + h * 64 + rg * 16 + (tid & 15);
  const int ostr = PART ? 16 * 512 : 16 * 1536;
  const int nbat = T >> 4;
  uint4 a0, a1, a2, c0, c1, c2;
#define RW_ISSUE(r0, r1, r2, bt) { const u16* sp_ = src + (size_t)(bt) * 16 * 3072; \
    r0 = *(const uint4*)(sp_ + so0); r1 = *(const uint4*)(sp_ + so1); r2 = *(const uint4*)(sp_ + so2); }
#define RW_STASH(r0, r1, r2, bi) { float* d_ = Lb + (bi) * (16 * 16 * 28); \
    cvt8_store(d_ + do0, r0); cvt8_store(d_ + do1, r1); cvt8_store(d_ + do2, r2); }
#define RW_COMPUTE(bt) { \
    const float* cur = Lb + ((bt) & 1) * (16 * 16 * 28); \
    float* obc = ob + ((bt) & 1) * 256; \
    float op[16]; \
    _Pragma("unroll") for (int st = 0; st < 16; st++) { \
      const float* sl = cur + (st * 16 + kq) * 28; \
      float4 r4 = *(const float4*)(sl), k4 = *(const float4*)(sl + 4), kk4 = *(const float4*)(sl + 8), \
             b4 = *(const float4*)(sl + 12), e4 = *(const float4*)(sl + 16); \
      float v = PART ? 0.f : cur[(st * 16 + (R >> 2)) * 28 + 20 + (R & 3)]; \
      float sa = (S[0] * kk4.x + S[1] * kk4.y) + (S[2] * kk4.z + S[3] * kk4.w); \
      sa = -red16(sa); \
      S[0] = fmaf(S[0], -e4.x, S[0]); S[1] = fmaf(S[1], -e4.y, S[1]); \
      S[2] = fmaf(S[2], -e4.z, S[2]); S[3] = fmaf(S[3], -e4.w, S[3]); \
      S[0] = fmaf(v, k4.x, S[0]); S[1] = fmaf(v, k4.y, S[1]); \
      S[2] = fmaf(v, k4.z, S[2]); S[3] = fmaf(v, k4.w, S[3]); \
      S[0] = fmaf(sa, b4.x, S[0]); S[1] = fmaf(sa, b4.y, S[1]); \
      S[2] = fmaf(sa, b4.z, S[2]); S[3] = fmaf(sa, b4.w, S[3]); \
      op[st] = (S[0] * r4.x + S[1] * r4.y) + (S[2] * r4.z + S[3] * r4.w); \
      if ((st & 3) == 3) __builtin_amdgcn_sched_barrier(0); \
    } \
    _Pragma("unroll") for (int st = 0; st < 16; st++) op[st] = red16(op[st]); \
    if (kq == 0) { _Pragma("unroll") for (int st = 0; st < 16; st++) obc[st * 16 + wv * 4 + rl] = op[st]; } }
#define RW_OUT(bt) { outp[(size_t)(bt) * ostr] = f2bf(ob[((bt) & 1) * 256 + tid]); }
  __syncthreads();
  RW_ISSUE(a0, a1, a2, 0)
  RW_STASH(a0, a1, a2, 0)
  if (1 < nbat) RW_ISSUE(a0, a1, a2, 1)
  if (2 < nbat) RW_ISSUE(c0, c1, c2, 2)
  __syncthreads();
  for (int b = 0; b < nbat; b += 2) {
    RW_COMPUTE(b)
    if (b + 1 < nbat) RW_STASH(a0, a1, a2, 1)
    __syncthreads();
    RW_OUT(b)
    if (b + 1 >= nbat) break;
    if (b + 3 < nbat) RW_ISSUE(a0, a1, a2, b + 3)
    RW_COMPUTE(b + 1)
    if (b + 2 < nbat) RW_STASH(c0, c1, c2, 0)
    __syncthreads();
    RW_OUT(b + 1)
    if (b + 4 < nbat) RW_ISSUE(c0, c1, c2, b + 4)
  }
  if (noc == 1) {
    float* o = out_state(p.out, s, j, O_RWKV_P, O_RWKV_S, 32768);
    *(float4*)(o + ((size_t)h * 64 + R) * 64 + kq * 4) = make_float4(S[0], S[1], S[2], S[3]);
  } else {
    float* o = (PART ? RK_PS(p) : RK_LS(p)) + (size_t)((s * 8 + h) * 4 + oc) * 4096;
    *(float4*)(o + (size_t)R * 64 + kq * 4) = make_float4(S[0], S[1], S[2], S[3]);
  }
  __syncthreads();
}

__device__ __forceinline__ void rwkv_combine_item(CP p, int j, int s, int h, char* smem) {
  float* Sl = (float*)smem;
  const int tid = otid();
  const int r = tid >> 2, jq = tid & 3;
  const size_t idx0 = (size_t)(s * 8 + h) * 4;
  float cur[16];
  {
    const float* l0 = RK_LS(p) + idx0 * 4096 + r * 64 + jq * 16;
#pragma unroll
    for (int c = 0; c < 16; c++) cur[c] = l0[c];
  }
  for (int oc = 1; oc < RK_NOC; oc++) {
    float* si = RK_SI(p) + (idx0 + oc) * 4096 + r * 64 + jq * 16;
    __syncthreads();
#pragma unroll
    for (int c = 0; c < 16; c++) { si[c] = cur[c]; Sl[r * 65 + jq * 16 + c] = cur[c]; }
    __syncthreads();
    float nx[16];
    {
      const float* lo = RK_LS(p) + (idx0 + oc) * 4096 + r * 64 + jq * 16;
#pragma unroll
      for (int c = 0; c < 16; c++) nx[c] = lo[c];
    }
    const float* pm = RK_PS(p) + (idx0 + oc) * 4096 + jq * 16;
    for (int i = 0; i < 64; i++) {
      const float sv = Sl[r * 65 + i];
      const float4 p0 = *(const float4*)(pm + i * 64), p1 = *(const float4*)(pm + i * 64 + 4),
                   p2 = *(const float4*)(pm + i * 64 + 8), p3 = *(const float4*)(pm + i * 64 + 12);
      nx[0] += sv * p0.x; nx[1] += sv * p0.y; nx[2] += sv * p0.z; nx[3] += sv * p0.w;
      nx[4] += sv * p1.x; nx[5] += sv * p1.y; nx[6] += sv * p1.z; nx[7] += sv * p1.w;
      nx[8] += sv * p2.x; nx[9] += sv * p2.y; nx[10] += sv * p2.z; nx[11] += sv * p2.w;
      nx[12] += sv * p3.x; nx[13] += sv * p3.y; nx[14] += sv * p3.z; nx[15] += sv * p3.w;
    }
#pragma unroll
    for (int c = 0; c < 16; c++) cur[c] = nx[c];
  }
  float* o = out_state(p.out, s, j, O_RWKV_P, O_RWKV_S, 32768) + ((size_t)h * 64 + r) * 64 + jq * 16;
#pragma unroll
  for (int c = 0; c < 16; c++) o[c] = cur[c];
  __syncthreads();
}

typedef __attribute__((ext_vector_type(4))) short bf16x4;
#define MB_SL(p) ((p).scr)
#define MB_DD(p) ((p).scr + 256 * 8192)
#define MB_NOC 8
template <int MODE>
__device__ __forceinline__ void mamba_scan_item(CP p, int j, int s, int h, int oc, int noc, char* smem) {
  u16* Bs = (u16*)smem;
  u16* Cs = Bs + 2 * 16 * 136;
  u16* BTs = Cs + 2 * 16 * 136;
  u16* XTs = BTs + 2 * 128 * 24;
  u16* XBs = XTs + 2 * 64 * 24;
  u16* SsT = XBs + 2 * 64 * 24;
  float* Gs = (float*)(SsT + 64 * 136);
  const int tid = otid(), lane = tid & 63, wv = tid >> 6;
  const int l15 = lane & 15, lq = lane >> 4;
  const int g = h >> 3;
  const int T = seq_len(s);
  const int nch = (T >> 4) / noc;
  const int m0 = seq_row0(s) + oc * nch * 16;
  f32x4 acc[8];
#pragma unroll
  for (int nt = 0; nt < 8; nt++) acc[nt] = (f32x4){0.f, 0.f, 0.f, 0.f};
  float prodD = 1.f;
  if (MODE == 1) {
    if (s >= 2) {
      const float* sp = p.st_ssm + (((size_t)(s - 2) * 2 + j) * 16 + h) * 8192 + (size_t)(wv * 16 + lq * 4) * 128 + l15;
#pragma unroll
      for (int nt = 0; nt < 8; nt++)
        acc[nt] = (f32x4){sp[nt * 16], sp[128 + nt * 16], sp[256 + nt * 16], sp[384 + nt * 16]};
    } else {
      for (int cp = 0; cp < oc; cp++) {
        const size_t idx = (size_t)((s * 16 + h) * 8 + cp);
        const float dd = MB_DD(p)[idx];
        const float* sp = MB_SL(p) + idx * 8192 + (size_t)(wv * 16 + lq * 4) * 128 + l15;
#pragma unroll
        for (int nt = 0; nt < 8; nt++)
          acc[nt] = (f32x4){acc[nt][0] * dd + sp[nt * 16], acc[nt][1] * dd + sp[128 + nt * 16],
                            acc[nt][2] * dd + sp[256 + nt * 16], acc[nt][3] * dd + sp[384 + nt * 16]};
      }
    }
  }
  const u16* Pb = p.cv + (size_t)(m0 + (tid >> 4)) * 1536 + 1024 + g * 128 + (tid & 15) * 8;
  const u16* Px = p.cv + (size_t)(m0 + ((tid >> 3) & 15)) * 1536 + h * 64 + (tid & 7) * 8;
  const float* Pdt = p.dtb + (size_t)(m0 + ((tid >> 3) & 15)) * 32 + h;
  const float* PgL = p.dtb + (size_t)(m0 + 15) * 32 + 16 + h;
  const float* PG = p.dtb + (size_t)(m0 + (tid & 15)) * 32 + 16 + h;
  uint4 ab, ac, ax, cb, cc, cx;
  float adt = 0.f, ag = 0.f, agl = 0.f, aG = 0.f, cdt = 0.f, cg = 0.f, cgl = 0.f, cG = 0.f;
  ab = make_uint4(0, 0, 0, 0); ac = ab; ax = ab; cb = ab; cc = ab; cx = ab;
#define MM_ISSUE(rb, rc, rx, rdt, rg, rgl, rG, c) { \
    rb = *(const uint4*)(Pb + (size_t)(c) * 16 * 1536); \
    if (MODE == 1) rc = *(const uint4*)(Pb + (size_t)(c) * 16 * 1536 + 256); \
    if (tid < 128) { rx = *(const uint4*)(Px + (size_t)(c) * 16 * 1536); rdt = Pdt[(size_t)(c) * 16 * 32]; \
      rg = Pdt[(size_t)(c) * 16 * 32 + 16]; rgl = PgL[(size_t)(c) * 16 * 32]; } \
    if (tid < 16) rG = PG[(size_t)(c) * 16 * 32]; }
#define MM_T8(dst, rv, sc) { \
      dst[0 * 24] = f2bf(lo16(rv.x) * (sc)); dst[1 * 24] = f2bf(hi16(rv.x) * (sc)); dst[2 * 24] = f2bf(lo16(rv.y) * (sc)); dst[3 * 24] = f2bf(hi16(rv.y) * (sc)); \
      dst[4 * 24] = f2bf(lo16(rv.z) * (sc)); dst[5 * 24] = f2bf(hi16(rv.z) * (sc)); dst[6 * 24] = f2bf(lo16(rv.w) * (sc)); dst[7 * 24] = f2bf(hi16(rv.w) * (sc)); }
#define MM_STASH(rb, rc, rx, rdt, rg, rgl, rG, bi) { \
    if (MODE == 1) { *(uint4*)(Bs + (bi) * (16 * 136) + (tid >> 4) * 136 + (tid & 15) * 8) = rb; \
                     *(uint4*)(Cs + (bi) * (16 * 136) + (tid >> 4) * 136 + (tid & 15) * 8) = rc; } \
    { u16* bd_ = BTs + (bi) * (128 * 24) + ((tid & 15) * 8) * 24 + (tid >> 4); \
      bd_[0 * 24] = (u16)(rb.x & 0xffff); bd_[1 * 24] = (u16)(rb.x >> 16); bd_[2 * 24] = (u16)(rb.y & 0xffff); bd_[3 * 24] = (u16)(rb.y >> 16); \
      bd_[4 * 24] = (u16)(rb.z & 0xffff); bd_[5 * 24] = (u16)(rb.z >> 16); bd_[6 * 24] = (u16)(rb.w & 0xffff); bd_[7 * 24] = (u16)(rb.w >> 16); } \
    if (tid < 128) { const float sb_ = rdt * __expf(rgl - rg); \
      u16* xb_ = XBs + (bi) * (64 * 24) + ((tid & 7) * 8) * 24 + (tid >> 3); MM_T8(xb_, rx, sb_) \
      if (MODE == 1) { u16* xt_ = XTs + (bi) * (64 * 24) + ((tid & 7) * 8) * 24 + (tid >> 3); MM_T8(xt_, rx, rdt) } } \
    if (tid < 16) { Gs[(bi) * 32 + tid] = rG; if (tid == 15) Gs[(bi) * 32 + 16] = __expf(rG); } }
  __syncthreads();
  MM_ISSUE(ab, ac, ax, adt, ag, agl, aG, 0)
  MM_STASH(ab, ac, ax, adt, ag, agl, aG, 0)
  if (1 < nch) MM_ISSUE(ab, ac, ax, adt, ag, agl, aG, 1)
  if (2 < nch) MM_ISSUE(cb, cc, cx, cdt, cg, cgl, cG, 2)
  for (int c = 0; c < nch; c++) {
    const int bi = c & 1;
    if (MODE == 1) {
#pragma unroll
      for (int nt = 0; nt < 8; nt++)
#pragma unroll
        for (int jj = 0; jj < 4; jj++)
          SsT[(wv * 16 + lq * 4 + jj) * 136 + nt * 16 + l15] = f2bf(acc[nt][jj]);
    }
    __syncthreads();
    if (c + 1 < nch) {
      if (bi == 0) { MM_STASH(ab, ac, ax, adt, ag, agl, aG, 1) if (c + 3 < nch) MM_ISSUE(ab, ac, ax, adt, ag, agl, aG, c + 3) }
      else { MM_STASH(cb, cc, cx, cdt, cg, cgl, cG, 0) if (c + 3 < nch) MM_ISSUE(cb, cc, cx, cdt, cg, cgl, cG, c + 3) }
    }
    const u16* Bc = Bs + bi * (16 * 136);
    const u16* Cc = Cs + bi * (16 * 136);
    const u16* BTc = BTs + bi * (128 * 24);
    const u16* XTc = XTs + bi * (64 * 24);
    const u16* XBc = XBs + bi * (64 * 24);
    const float* Gc = Gs + bi * 32;
    if (MODE == 1) {
      f32x4 at = (f32x4){0.f, 0.f, 0.f, 0.f};
      bf16x8 cf[4];
#pragma unroll
      for (int ks = 0; ks < 4; ks++) {
        bf16x8 bfv = *(const bf16x8*)(Bc + l15 * 136 + ks * 32 + lq * 8);
        cf[ks] = *(const bf16x8*)(Cc + l15 * 136 + ks * 32 + lq * 8);
        at = __builtin_amdgcn_mfma_f32_16x16x32_bf16(bfv, cf[ks], at, 0, 0, 0);
      }
      const float Gt = Gc[l15];
      bf16x4 bat;
#pragma unroll
      for (int jj = 0; jj < 4; jj++) {
        const int sidx = lq * 4 + jj;
        bat[jj] = (short)f2bf(sidx <= l15 ? at[jj] * __expf(Gt - Gc[sidx]) : 0.f);
      }
      bf16x4 xt = *(const bf16x4*)(XTc + (wv * 16 + l15) * 24 + lq * 4);
      f32x4 ao1 = (f32x4){0.f, 0.f, 0.f, 0.f};
      ao1 = __builtin_amdgcn_mfma_f32_16x16x16bf16_1k(xt, bat, ao1, 0, 0, 0);
      f32x4 ao2 = (f32x4){0.f, 0.f, 0.f, 0.f};
#pragma unroll
      for (int ks = 0; ks < 4; ks++) {
        bf16x8 sf = *(const bf16x8*)(SsT + (wv * 16 + l15) * 136 + ks * 32 + lq * 8);
        ao2 = __builtin_amdgcn_mfma_f32_16x16x32_bf16(sf, cf[ks], ao2, 0, 0, 0);
      }
      const float eg = __expf(Gt);
      *(uint2*)(p.hm + (size_t)(m0 + c * 16 + l15) * 1536 + 512 + h * 64 + wv * 16 + lq * 4) =
          make_uint2(pack2(ao1[0] + ao2[0] * eg, ao1[1] + ao2[1] * eg), pack2(ao1[2] + ao2[2] * eg, ao1[3] + ao2[3] * eg));
    }
    {
      const float eGL = Gc[16];
      if (MODE == 0) prodD *= eGL;
      bf16x4 xb = *(const bf16x4*)(XBc + (wv * 16 + l15) * 24 + lq * 4);
#pragma unroll
      for (int nt = 0; nt < 8; nt++) {
        bf16x4 bt = *(const bf16x4*)(BTc + (nt * 16 + l15) * 24 + lq * 4);
        f32x4 cin = (f32x4){acc[nt][0] * eGL, acc[nt][1] * eGL, acc[nt][2] * eGL, acc[nt][3] * eGL};
        acc[nt] = __builtin_amdgcn_mfma_f32_16x16x16bf16_1k(xb, bt, cin, 0, 0, 0);
      }
    }
  }
  if (MODE == 0) {
    const size_t idx = (size_t)((s * 16 + h) * 8 + oc);
    float* sp = MB_SL(p) + idx * 8192 + (size_t)(wv * 16 + lq * 4) * 128 + l15;
#pragma unroll
    for (int nt = 0; nt < 8; nt++) {
      sp[nt * 16] = acc[nt][0]; sp[128 + nt * 16] = acc[nt][1]; sp[256 + nt * 16] = acc[nt][2]; sp[384 + nt * 16] = acc[nt][3];
    }
    if (tid == 0) MB_DD(p)[idx] = prodD;
  } else if (oc == noc - 1) {
    float* sp = out_state(p.out, s, j, O_SSM_P, O_SSM_S, 131072) + (size_t)h * 8192 + (size_t)(wv * 16 + lq * 4) * 128 + l15;
#pragma unroll
    for (int nt = 0; nt < 8; nt++) {
      sp[nt * 16] = acc[nt][0]; sp[128 + nt * 16] = acc[nt][1]; sp[256 + nt * 16] = acc[nt][2]; sp[384 + nt * 16] = acc[nt][3];
    }
  }
  __syncthreads();
}

__device__ void phase_scan_even_a(CP p, int j, char* smem, int bid, int nb) {
  const int nA = 32 * (MB_NOC - 1);
  for (int it = bid; it < 448 + nA + 256; it += nb) {
    int kind, q, oc = 0, noc = RK_NOC;
    if (it < 256) { kind = 0; q = it >> 2; oc = it & 3; }
    else if (it < 448) { kind = 1; q = (it - 256) / 3; oc = 1 + (it - 256) % 3; }
    else if (it < 448 + nA) { kind = 2; q = (it - 448) / (MB_NOC - 1); oc = (it - 448) % (MB_NOC - 1); }
    else { kind = 0; q = 64 + (it - 448 - nA); noc = 1; }
    if (kind == 2) mamba_scan_item<0>(p, j, q >> 4, q & 15, oc, MB_NOC, smem);
    else {
      const int s = q < 64 ? (q >> 5) : 2 + ((q - 64) >> 5);
      if (kind == 0) rwkv_scan_item<0>(p, j, s, (q >> 2) & 7, q & 3, oc, noc, smem);
      else rwkv_scan_item<1>(p, j, s, (q >> 2) & 7, q & 3, oc, noc, smem);
    }
  }
}
__device__ void phase_scan_even(CP p, int j, char* smem, int bid, int nb) {
  for (int it = bid; it < 16 + 32 * MB_NOC + 128; it += nb) {
    if (it < 16) { rwkv_combine_item(p, j, it >> 3, it & 7, smem); continue; }
    const int i2 = it - 16;
    int q, s, oc, noc;
    if (i2 < 32 * MB_NOC) { q = i2 / MB_NOC; oc = i2 % MB_NOC; noc = MB_NOC; s = q >> 4; }
    else { q = i2 - 32 * MB_NOC; oc = 0; noc = 1; s = 2 + (q >> 4); }
    mamba_scan_item<1>(p, j, s, q & 15, oc, noc, smem);
  }
}

__device__ void phase_post_even(CP p, int j, char* smem, int bid, int nb) {
  const int tid = otid(), lane = tid & 63, wv = tid >> 6;
  const u16* P = p.pbuf;
  {
    u16* sgb = (u16*)smem;
    float* ul = (float*)(sgb + 16 * 136) ;
    float* resg = ul + 8 * 512;
    for (int i = tid; i < 16 * 136; i += 256) sgb[i] = 0;
    const int half = tid >> 7, hk = tid & 127, h = hk >> 4, kq = hk & 15;
    const int c4 = h * 64 + kq * 4;
    const float* mu = p.mu_a + j * 1792;
    for (int u = bid; u < NT / 8; u += nb) {
      const int m0 = u * 8;
      const int s = row_seq(m0);
      const int r0 = seq_row0(s);
      __syncthreads();
#pragma unroll
      for (int i = 0; i < 4; i++) {
        int idx = tid + 256 * i;
        int tok = idx >> 7, cc = idx & 127;
        int m = m0 + tok;
        int col = 1664 + cc;
        float pc = bf2f(P[(size_t)m * PSTR + col]);
        float pp = (m > r0) ? bf2f(P[(size_t)(m - 1) * PSTR + col])
                            : (s >= 2 ? p.st_shift[((size_t)(s - 2) * 2 + j) * 1792 + col] : 0.f);
        float pm = pc + (pp - pc) * mu[col];
        sgb[tok * 136 + cc] = f2bf(sigm(pm));
      }
      const int ocu = (s < 2) ? ((m0 - r0) >> 11) : 0;
      if (ocu > 0) {
#pragma unroll
        for (int i = 0; i < 2; i++) {
          int idx = tid + 256 * i;
          uint4 uv = *(const uint4*)(p.ub + (size_t)m0 * 512 + idx * 8);
          cvt8_store(ul + idx * 8, uv);
        }
      }
      __syncthreads();
      float corr[4][4];
#pragma unroll
      for (int a = 0; a < 4; a++)
#pragma unroll
        for (int b = 0; b < 4; b++) corr[a][b] = 0.f;
      if (ocu > 0) {
        const float* sip = RK_SI(p) + (size_t)((s * 8 + h) * 4 + ocu) * 4096 + (size_t)(kq * 4) * 64;
#pragma unroll 2
        for (int i = 0; i < 64; i += 4) {
          float4 u4[4];
#pragma unroll
          for (int tk = 0; tk < 4; tk++) u4[tk] = *(const float4*)(ul + (half * 4 + tk) * 512 + h * 64 + i);
#pragma unroll
          for (int rr = 0; rr < 4; rr++) {
            float4 s4 = *(const float4*)(sip + rr * 64 + i);
#pragma unroll
            for (int tk = 0; tk < 4; tk++)
              corr[tk][rr] += s4.x * u4[tk].x + s4.y * u4[tk].y + s4.z * u4[tk].z + s4.w * u4[tk].w;
          }
        }
      }
      {
        const int lane = tid & 63, wv = tid >> 6, l15 = lane & 15, lq = lane >> 4;
        bf16x8 ag[4];
#pragma unroll
        for (int ks = 0; ks < 4; ks++) ag[ks] = *(const bf16x8*)(sgb + l15 * 136 + ks * 32 + lq * 8);
#pragma unroll
        for (int nt = 0; nt < 8; nt++) {
          const int n = wv * 128 + nt * 16 + l15;
          f32x4 cgv = (f32x4){0.f, 0.f, 0.f, 0.f};
#pragma unroll
          for (int ks = 0; ks < 4; ks++) {
            bf16x8 bg = *(const bf16x8*)(p.g2t + (size_t)n * 128 + ks * 32 + lq * 8);
            cgv = __builtin_amdgcn_mfma_f32_16x16x32_bf16(ag[ks], bg, cgv, 0, 0, 0);
          }
          if (lq < 2) {
#pragma unroll
            for (int jj = 0; jj < 4; jj++) resg[(lq * 4 + jj) * 512 + n] = cgv[jj];
          }
        }
      }
      __syncthreads();
      float accg[4][4];
#pragma unroll
      for (int tk = 0; tk < 4; tk++) {
        float4 rg4 = *(const float4*)(resg + (half * 4 + tk) * 512 + c4);
        accg[tk][0] = rg4.x; accg[tk][1] = rg4.y; accg[tk][2] = rg4.z; accg[tk][3] = rg4.w;
      }
      float4 lw = *(const float4*)(p.lnx_w + j * 512 + c4);
      float4 lb = *(const float4*)(p.lnx_b + j * 512 + c4);
      const float lwa[4] = {lw.x, lw.y, lw.z, lw.w};
      const float lba[4] = {lb.x, lb.y, lb.z, lb.w};
#pragma unroll
      for (int tk = 0; tk < 4; tk++) {
        const int m = m0 + half * 4 + tk;
        u16* op = p.hm + (size_t)m * 1536 + c4;
        uint2 oraw = *(const uint2*)op;
        float o[4] = {lo16(oraw.x) + corr[tk][0], hi16(oraw.x) + corr[tk][1], lo16(oraw.y) + corr[tk][2], hi16(oraw.y) + corr[tk][3]};
        float sm = red16(o[0] + o[1] + o[2] + o[3]);
        float mean = sm * (1.f / 64.f);
        float d0 = o[0] - mean, d1 = o[1] - mean, d2 = o[2] - mean, d3 = o[3] - mean;
        float var = red16(d0 * d0 + d1 * d1 + d2 * d2 + d3 * d3) * (1.f / 64.f);
        float rs = rsqrtf(var + 64e-5f);
        float bon = p.bonus[(size_t)m * 8 + h];
        uint4 sl2 = *(const uint4*)(p.rw + (((size_t)m * 8 + h) * 16 + kq) * 24 + 16);
        float v[4] = {lo16(sl2.z), hi16(sl2.z), lo16(sl2.w), hi16(sl2.w)};
        float dd[4] = {d0, d1, d2, d3};
        float res[4];
#pragma unroll
        for (int e = 0; e < 4; e++) res[e] = (dd[e] * rs * lwa[e] + lba[e] + bon * v[e]) * accg[tk][e];
        *(uint2*)op = make_uint2(pack2(res[0], res[1]), pack2(res[2], res[3]));
      }
    }
  }
  for (int w = bid * 4 + wv; w < NT * 2; w += nb * 4) {
    int m = w >> 1, g = w & 1;
    u16* yp = p.hm + (size_t)m * 1536 + 512 + g * 512 + lane * 8;
    uint4 yr = *(const uint4*)yp;
    uint4 zr = *(const uint4*)(P + (size_t)m * PSTR + 1792 + g * 512 + lane * 8);
    float y[8] = {lo16(yr.x), hi16(yr.x), lo16(yr.y), hi16(yr.y), lo16(yr.z), hi16(yr.z), lo16(yr.w), hi16(yr.w)};
    float z[8] = {lo16(zr.x), hi16(zr.x), lo16(zr.y), hi16(zr.y), lo16(zr.z), hi16(zr.z), lo16(zr.w), hi16(zr.w)};
    uint4 xr = *(const uint4*)(p.cv + (size_t)m * 1536 + g * 512 + lane * 8);
    float x[8] = {lo16(xr.x), hi16(xr.x), lo16(xr.y), hi16(xr.y), lo16(xr.z), hi16(xr.z), lo16(xr.w), hi16(xr.w)};
    const float dsk = p.d_skip[j * 16 + g * 8 + (lane >> 3)];
    float ss = 0.f;
#pragma unroll
    for (int e = 0; e < 8; e++) { y[e] = (y[e] + dsk * x[e]) * silu_(z[e]); ss += y[e] * y[e]; }
    ss = wave_sum(ss);
    float rs = rsqrtf(ss * (1.f / 512.f) + 1e-5f);
    const float* nw = p.norm_b_w + j * 1024 + g * 512 + lane * 8;
    float4 n0 = *(const float4*)nw, n1 = *(const float4*)(nw + 4);
    *(uint4*)yp = make_uint4(pack2(y[0] * rs * n0.x, y[1] * rs * n0.y), pack2(y[2] * rs * n0.z, y[3] * rs * n0.w),
                             pack2(y[4] * rs * n1.x, y[5] * rs * n1.y), pack2(y[6] * rs * n1.z, y[7] * rs * n1.w));
  }
}

#define QK_OFF ((size_t)1032 * 1024 * 16)
__device__ void phase_prep_odd(CP p, int j, int bid, int nb) {
  const int tid = otid();
  const u16* P = p.pbuf;
  u16* KT = p.rw;
  u16* QK = p.rw + QK_OFF;
  float* DL = (float*)p.cv;
  for (int u = bid; u < (NT / 16) * 2; u += nb) {
    const int ci = u >> 1, k = ((u & 1) * 256 + tid) * 2;
    float lb0 = 0.f, lb1 = 0.f;
    if (j == 1) { lb0 = sigm(p.lb_param[1024 + k] - p.lb_param[k]); lb1 = sigm(p.lb_param[1025 + k] - p.lb_param[k + 1]); }
    const u16* base = P + (size_t)ci * 16 * PSTR + k;
    unsigned qr[16], fr[16];
#pragma unroll
    for (int t = 0; t < 16; t++) { qr[t] = *(const unsigned*)(base + (size_t)t * PSTR); fr[t] = *(const unsigned*)(base + (size_t)t * PSTR + 1024); }
    float G0 = 0.f, G1 = 0.f;
    unsigned kt0[8], kt1[8];
#pragma unroll
    for (int t = 0; t < 16; t++) {
      float q0 = lo16(qr[t]), q1 = hi16(qr[t]), f0 = lo16(fr[t]), f1 = hi16(fr[t]);
      float s0 = sigm(f0), s1 = sigm(f1);
      float ff0 = lb0 + (1.f - lb0) * s0, ff1 = lb1 + (1.f - lb1) * s1;
      float kk0 = (1.f - lb0) * (1.f - s0), kk1 = (1.f - lb1) * (1.f - s1);
      G0 += __logf(fmaxf(ff0, 1e-30f)); G1 += __logf(fmaxf(ff1, 1e-30f));
      float Q0 = silu_(q0) * __expf(G0), Q1 = silu_(q1) * __expf(G1);
      float K0 = kk0 * __expf(fminf(-G0, 80.f)), K1 = kk1 * __expf(fminf(-G1, 80.f));
      unsigned kb0 = f2bf(K0), kb1 = f2bf(K1);
      u16* qd = QK + (size_t)(ci * 16 + t) * 2048 + k;
      *(unsigned*)qd = pack2(Q0, Q1);
      *(unsigned*)(qd + 1024) = kb0 | (kb1 << 16);
      if (t & 1) { kt0[t >> 1] |= kb0 << 16; kt1[t >> 1] |= kb1 << 16; } else { kt0[t >> 1] = kb0; kt1[t >> 1] = kb1; }
    }
    *(float2*)(DL + (size_t)ci * 1024 + k) = make_float2(__expf(G0), __expf(G1));
    uint4* kd = (uint4*)(KT + ((size_t)ci * 1024 + k) * 16);
    kd[0] = make_uint4(kt0[0], kt0[1], kt0[2], kt0[3]);
    kd[1] = make_uint4(kt0[4], kt0[5], kt0[6], kt0[7]);
    kd[2] = make_uint4(kt1[0], kt1[1], kt1[2], kt1[3]);
    kd[3] = make_uint4(kt1[4], kt1[5], kt1[6], kt1[7]);
  }
}

#define HG_SL(p) ((float*)(p).cv + 2 * 1024 * 1024)
#define HG_DD(p) (HG_SL(p) + 2 * 8 * 8 * 16384)
template <int MODE>
__device__ __forceinline__ void hgrn_scan_item(CP p, int j, int s, int h, int vq, int oc, int noc, char* smem) {
  u16* Qs = (u16*)smem;
  u16* Ks = Qs + 2 * 16 * 136;
  u16* KTs = Ks + 2 * 16 * 136;
  u16* VTs = KTs + 2 * 128 * 24;
  u16* SsT = VTs + 2 * 32 * 24;
  float* dLs = (float*)(SsT + 2 * 32 * 136);
  const int tid = otid(), lane = tid & 63, wv = tid >> 6;
  const int l15 = lane & 15, lq = lane >> 4;
  const int T = seq_len(s);
  const int nch = (T >> 4) / noc;
  const int m0 = seq_row0(s) + oc * nch * 16;
  const int ci0 = m0 >> 4;
  f32x4 acc[2][2];
#pragma unroll
  for (int vt = 0; vt < 2; vt++)
#pragma unroll
    for (int kl = 0; kl < 2; kl++) acc[vt][kl] = (f32x4){0.f, 0.f, 0.f, 0.f};
  float prodD[2] = {1.f, 1.f};
  if (MODE == 1) {
    if (s >= 2) {
      const float* sp = p.st_hgrn + (((size_t)(s - 2) * 2 + j) * 8 + h) * 16384;
#pragma unroll
      for (int vt = 0; vt < 2; vt++)
#pragma unroll
        for (int kl = 0; kl < 2; kl++) {
          float4 q = *(const float4*)(sp + (size_t)((2 * wv + kl) * 16 + l15) * 128 + vq * 32 + vt * 16 + lq * 4);
          acc[vt][kl] = (f32x4){q.x, q.y, q.z, q.w};
        }
    } else {
      for (int cp = 0; cp < oc; cp++) {
        const size_t idx = (size_t)((s * 8 + h) * 8 + cp);
#pragma unroll
        for (int kl = 0; kl < 2; kl++) {
          const int k = (2 * wv + kl) * 16 + l15;
          const float dd = HG_DD(p)[idx * 128 + k];
#pragma unroll
          for (int vt = 0; vt < 2; vt++) {
            float4 L4 = *(const float4*)(HG_SL(p) + idx * 16384 + (size_t)k * 128 + vq * 32 + vt * 16 + lq * 4);
            acc[vt][kl] = (f32x4){acc[vt][kl][0] * dd + L4.x, acc[vt][kl][1] * dd + L4.y, acc[vt][kl][2] * dd + L4.z,
                                  acc[vt][kl][3] * dd + L4.w};
          }
        }
      }
    }
  }
  const u16* Pq = p.rw + QK_OFF + (size_t)(m0 + (tid >> 4)) * 2048 + h * 128 + (tid & 15) * 8;
  const u16* Pv = p.pbuf + (size_t)(m0 + ((tid >> 2) & 15)) * PSTR + 2048 + h * 128 + vq * 32 + (tid & 3) * 8;
  const u16* Pkt = p.rw + ((size_t)ci0 * 1024 + h * 128 + (tid >> 1)) * 16 + (tid & 1) * 8;
  const float* Pdl = (const float*)p.cv + (size_t)ci0 * 1024 + h * 128 + (tid & 31) * 4;
  uint4 aq, ak, akt, av, cq, ck, ckt, cvv;
  float4 ad, cd;
  aq = make_uint4(0, 0, 0, 0); ak = aq; cq = aq; ck = aq;
  av = make_uint4(0, 0, 0, 0); cvv = av; ad = make_float4(0, 0, 0, 0); cd = ad;
#define HM_ISSUE(rq, rk, rkt, rv, rd, c) { \
    if (MODE == 1) { rq = *(const uint4*)(Pq + (size_t)(c) * 16 * 2048); rk = *(const uint4*)(Pq + (size_t)(c) * 16 * 2048 + 1024); } \
    rkt = *(const uint4*)(Pkt + (size_t)(c) * 1024 * 16); \
    if (tid < 64) rv = *(const uint4*)(Pv + (size_t)(c) * 16 * PSTR); \
    if (tid < 32) rd = *(const float4*)(Pdl + (size_t)(c) * 1024); }
#define HM_STASH(rq, rk, rkt, rv, rd, bi) { \
    if (MODE == 1) { *(uint4*)(Qs + (bi) * (16 * 136) + (tid >> 4) * 136 + (tid & 15) * 8) = rq; \
    *(uint4*)(Ks + (bi) * (16 * 136) + (tid >> 4) * 136 + (tid & 15) * 8) = rk; } \
    *(uint4*)(KTs + (bi) * (128 * 24) + (tid >> 1) * 24 + (tid & 1) * 8) = rkt; \
    if (tid < 64) { u16* vd_ = VTs + (bi) * (32 * 24) + ((tid & 3) * 8) * 24 + (tid >> 2); \
      vd_[0 * 24] = (u16)(rv.x & 0xffff); vd_[1 * 24] = (u16)(rv.x >> 16); vd_[2 * 24] = (u16)(rv.y & 0xffff); vd_[3 * 24] = (u16)(rv.y >> 16); \
      vd_[4 * 24] = (u16)(rv.z & 0xffff); vd_[5 * 24] = (u16)(rv.z >> 16); vd_[6 * 24] = (u16)(rv.w & 0xffff); vd_[7 * 24] = (u16)(rv.w >> 16); } \
    if (tid < 32) *(float4*)(dLs + (bi) * 128 + tid * 4) = rd; }
  __syncthreads();
  HM_ISSUE(aq, ak, akt, av, ad, 0)
  HM_STASH(aq, ak, akt, av, ad, 0)
  if (1 < nch) HM_ISSUE(aq, ak, akt, av, ad, 1)
  if (2 < nch) HM_ISSUE(cq, ck, ckt, cvv, cd, 2)
  for (int c = 0; c < nch; c++) {
    const int bi = c & 1;
    if (MODE == 1) {
      u16* sd = SsT + bi * (32 * 136);
#pragma unroll
      for (int vt = 0; vt < 2; vt++)
#pragma unroll
        for (int kl = 0; kl < 2; kl++)
#pragma unroll
          for (int jj = 0; jj < 4; jj++)
            sd[(vt * 16 + lq * 4 + jj) * 136 + (2 * wv + kl) * 16 + l15] = f2bf(acc[vt][kl][jj]);
    }
    __syncthreads();
    if (c + 1 < nch) {
      if (bi == 0) { HM_STASH(aq, ak, akt, av, ad, 1) if (c + 3 < nch) HM_ISSUE(aq, ak, akt, av, ad, c + 3) }
      else { HM_STASH(cq, ck, ckt, cvv, cd, 0) if (c + 3 < nch) HM_ISSUE(cq, ck, ckt, cvv, cd, c + 3) }
    }
    const u16* Qc = Qs + bi * (16 * 136);
    const u16* Kc = Ks + bi * (16 * 136);
    const u16* KTc = KTs + bi * (128 * 24);
    const u16* VTc = VTs + bi * (32 * 24);
    const u16* Sc = SsT + bi * (32 * 136);
    if (MODE == 1 && wv < 2) {
      const int vt = wv;
      f32x4 at = (f32x4){0.f, 0.f, 0.f, 0.f};
      bf16x8 qf[4];
#pragma unroll
      for (int ks = 0; ks < 4; ks++) {
        bf16x8 kf = *(const bf16x8*)(Kc + l15 * 136 + ks * 32 + lq * 8);
        qf[ks] = *(const bf16x8*)(Qc + l15 * 136 + ks * 32 + lq * 8);
        at = __builtin_amdgcn_mfma_f32_16x16x32_bf16(kf, qf[ks], at, 0, 0, 0);
      }
      bf16x4 bat;
#pragma unroll
      for (int jj = 0; jj < 4; jj++) bat[jj] = (short)f2bf((lq * 4 + jj) <= l15 ? at[jj] : 0.f);
      bf16x4 vf = *(const bf16x4*)(VTc + (vt * 16 + l15) * 24 + lq * 4);
      f32x4 ao1 = (f32x4){0.f, 0.f, 0.f, 0.f};
      ao1 = __builtin_amdgcn_mfma_f32_16x16x16bf16_1k(vf, bat, ao1, 0, 0, 0);
      f32x4 ao2 = (f32x4){0.f, 0.f, 0.f, 0.f};
#pragma unroll
      for (int ks = 0; ks < 4; ks++) {
        bf16x8 sf = *(const bf16x8*)(Sc + (vt * 16 + l15) * 136 + ks * 32 + lq * 8);
        ao2 = __builtin_amdgcn_mfma_f32_16x16x32_bf16(sf, qf[ks], ao2, 0, 0, 0);
      }
      f32x4 ao = (f32x4){ao1[0] + ao2[0], ao1[1] + ao2[1], ao1[2] + ao2[2], ao1[3] + ao2[3]};
      *(uint2*)(p.hm + (size_t)(m0 + c * 16 + l15) * 1024 + h * 128 + vq * 32 + vt * 16 + lq * 4) =
          make_uint2(pack2(ao[0], ao[1]), pack2(ao[2], ao[3]));
    }
#pragma unroll
    for (int kl = 0; kl < 2; kl++) {
      const int kt = 2 * wv + kl;
      bf16x4 kb = *(const bf16x4*)(KTc + (kt * 16 + l15) * 24 + lq * 4);
      float dl = dLs[bi * 128 + kt * 16 + l15];
      if (MODE == 0) prodD[kl] *= dl;
#pragma unroll
      for (int vt = 0; vt < 2; vt++) {
        bf16x4 vf = *(const bf16x4*)(VTc + (vt * 16 + l15) * 24 + lq * 4);
        f32x4 a = __builtin_amdgcn_mfma_f32_16x16x16bf16_1k(vf, kb, acc[vt][kl], 0, 0, 0);
        acc[vt][kl] = (f32x4){a[0] * dl, a[1] * dl, a[2] * dl, a[3] * dl};
      }
    }
  }
  if (MODE == 0) {
    const size_t idx = (size_t)((s * 8 + h) * 8 + oc);
#pragma unroll
    for (int kl = 0; kl < 2; kl++) {
      const int k = (2 * wv + kl) * 16 + l15;
      if (vq == 0 && lq == 0) HG_DD(p)[idx * 128 + k] = prodD[kl];
#pragma unroll
      for (int vt = 0; vt < 2; vt++)
        *(float4*)(HG_SL(p) + idx * 16384 + (size_t)k * 128 + vq * 32 + vt * 16 + lq * 4) =
            make_float4(acc[vt][kl][0], acc[vt][kl][1], acc[vt][kl][2], acc[vt][kl][3]);
    }
  } else if (oc == noc - 1) {
    float* o = out_state(p.out, s, j, O_HGRN_P, O_HGRN_S, 131072) + (size_t)h * 16384;
#pragma unroll
    for (int vt = 0; vt < 2; vt++)
#pragma unroll
      for (int kl = 0; kl < 2; kl++)
        *(float4*)(o + (size_t)((2 * wv + kl) * 16 + l15) * 128 + vq * 32 + vt * 16 + lq * 4) =
            make_float4(acc[vt][kl][0], acc[vt][kl][1], acc[vt][kl][2], acc[vt][kl][3]);
  }
  __syncthreads();
}

#define HG_NOC 8
__device__ void phase_scan_odd_a(CP p, int j, char* smem, int bid, int nb) {
  for (int it = bid; it < 64 * (HG_NOC - 1); it += nb) {
    int q = it / (HG_NOC - 1), oc = it % (HG_NOC - 1);
    hgrn_scan_item<0>(p, j, q >> 5, (q >> 2) & 7, q & 3, oc, HG_NOC, smem);
  }
}
__device__ void phase_scan_odd(CP p, int j, char* smem, int bid, int nb) {
  for (int it = bid; it < 64 * HG_NOC + 256; it += nb) {
    int q, s, oc, noc;
    if (it < 64 * HG_NOC) { q = it / HG_NOC; oc = it % HG_NOC; noc = HG_NOC; s = q >> 5; }
    else { q = it - 64 * HG_NOC; oc = 0; noc = 1; s = 2 + (q >> 5); }
    hgrn_scan_item<1>(p, j, s, (q >> 2) & 7, q & 3, oc, noc, smem);
  }
}

__device__ void phase_post_odd(CP p, int j, int bid, int nb) {
  const int tid = otid(), lane = tid & 63, wv = tid >> 6;
  const u16* P = p.pbuf;
  for (int m = bid * 4 + wv; m < NT; m += nb * 4) {
    u16* op = p.hm + (size_t)m * 1024 + lane * 16;
    uint4 a = *(const uint4*)op, b = *(const uint4*)(op + 8);
    const u16* gp = P + (size_t)m * PSTR + 3072 + lane * 16;
    uint4 ga = *(const uint4*)gp, gb = *(const uint4*)(gp + 8);
    float o[16] = {lo16(a.x), hi16(a.x), lo16(a.y), hi16(a.y), lo16(a.z), hi16(a.z), lo16(a.w), hi16(a.w),
                   lo16(b.x), hi16(b.x), lo16(b.y), hi16(b.y), lo16(b.z), hi16(b.z), lo16(b.w), hi16(b.w)};
    float g[16] = {lo16(ga.x), hi16(ga.x), lo16(ga.y), hi16(ga.y), lo16(ga.z), hi16(ga.z), lo16(ga.w), hi16(ga.w),
                   lo16(gb.x), hi16(gb.x), lo16(gb.y), hi16(gb.y), lo16(gb.z), hi16(gb.z), lo16(gb.w), hi16(gb.w)};
    float ss = 0.f;
#pragma unroll
    for (int e = 0; e < 16; e++) ss += o[e] * o[e];
    ss += dpp_f<0xB1>(ss);
    ss += dpp_f<0x4E>(ss);
    ss += dpp_f<0x141>(ss);
    float rs = rsqrtf(ss * (1.f / 128.f) + 1e-5f);
    const float* nw = p.norm_c_w + j * 1024 + lane * 16;
    float r[16];
#pragma unroll
    for (int e = 0; e < 16; e++) r[e] = o[e] * rs * nw[e] * silu_(g[e]);
    *(uint4*)op = make_uint4(pack2(r[0], r[1]), pack2(r[2], r[3]), pack2(r[4], r[5]), pack2(r[6], r[7]));
    *(uint4*)(op + 8) = make_uint4(pack2(r[8], r[9]), pack2(r[10], r[11]), pack2(r[12], r[13]), pack2(r[14], r[15]));
  }
}


#define XB_TMO      128
#define XB_XCNT(j)  (256  + 64 * (j))
#define XB_XSUB(j)  (1280 + 64 * (j))
#define XB_XGEN(j)  (2304 + 64 * (j))
#define XB_TOP      3328
#define XB_TOPGEN   3392
#define XCD_BAR_WORDS 3456
#define XB_SPIN_CAP (1u << 22)
#define LAS __attribute__((address_space(3)))
__device__ __forceinline__ unsigned xb_ld(unsigned* p) { return __hip_atomic_load(p, __ATOMIC_RELAXED, __HIP_MEMORY_SCOPE_AGENT); }
__device__ __forceinline__ unsigned xb_add(unsigned* p, unsigned v) { return __hip_atomic_fetch_add(p, v, __ATOMIC_RELAXED, __HIP_MEMORY_SCOPE_AGENT); }
__device__ __forceinline__ unsigned xb_xcc_id() { return (unsigned)__builtin_amdgcn_s_getreg((3 << 11) | 20) & 0xFu; }
#define XB_SPIN(cond, bar) do { unsigned _sp = 0; while (cond) { __builtin_amdgcn_s_sleep(1); \
    if ((++_sp & 255u) == 0u) { if (xb_ld(&(bar)[XB_TMO])) break; if (_sp > XB_SPIN_CAP) { atomicAdd(&(bar)[XB_TMO], 1u); break; } } } } while (0)
struct XcdBarrier { unsigned* bar; unsigned x; volatile LAS unsigned* st; };
__device__ __forceinline__ XcdBarrier xcd_barrier_post(unsigned* bar, volatile LAS unsigned* st) {
  XcdBarrier b; b.bar = bar; b.x = xb_xcc_id(); b.st = st;
  if (threadIdx.x == 0) (void)xb_add(&bar[XB_XCNT(b.x)], 1u);
  return b;
}
__device__ __forceinline__ void xcd_barrier_complete(unsigned* bar, unsigned x, unsigned& nloc, unsigned& nx) {
  const unsigned G = gridDim.x * gridDim.y * gridDim.z;
  unsigned sum, cnt, mine, sp = 0u;
  for (;;) {
    sum = 0u; cnt = 0u; mine = 0u;
#pragma unroll
    for (unsigned j = 0; j < 16; ++j) { const unsigned c = xb_ld(&bar[XB_XCNT(j)]); sum += c; cnt += (c > 0u) ? 1u : 0u; mine = (j == x) ? c : mine; }
    if (sum == G) break;
    __builtin_amdgcn_s_sleep(1);
    if ((++sp & 255u) == 0u) { if (xb_ld(&bar[XB_TMO])) break; if (sp > XB_SPIN_CAP) { atomicAdd(&bar[XB_TMO], 1u); break; } }
  }
  nloc = mine > 0u ? mine : 1u; nx = cnt > 0u ? cnt : 1u;
}
__device__ __forceinline__ void xcd_barrier(const XcdBarrier& b) {
  asm volatile("s_waitcnt vmcnt(0)" ::: "memory");
  __syncthreads();
  if (threadIdx.x == 0) {
    unsigned* bar = b.bar;
    __builtin_amdgcn_s_waitcnt(0);
    unsigned nloc = b.st[0], nx = b.st[1];
    if (nloc == 0u) { xcd_barrier_complete(bar, b.x, nloc, nx); b.st[0] = nloc; b.st[1] = nx; }
    const unsigned old = xb_add(&bar[XB_XSUB(b.x)], 1u);
    const unsigned gen = old / nloc;
    if (old + 1u == (gen + 1u) * nloc) {
      __builtin_amdgcn_fence(__ATOMIC_RELEASE, "agent");
      asm volatile("s_waitcnt vmcnt(0)" ::: "memory");
      const unsigned og = xb_add(&bar[XB_TOP], 1u);
      const unsigned tg = og / nx;
      if (og + 1u == (tg + 1u) * nx) xb_add(&bar[XB_TOPGEN], 1u);
      else XB_SPIN(xb_ld(&bar[XB_TOPGEN]) == tg, bar);
      __builtin_amdgcn_fence(__ATOMIC_ACQUIRE, "agent");
      xb_add(&bar[XB_XGEN(b.x)], 1u);
      asm volatile("s_waitcnt vmcnt(0)" ::: "memory");
    } else {
      XB_SPIN(xb_ld(&bar[XB_XGEN(b.x)]) == gen, bar);
      __builtin_amdgcn_fence(__ATOMIC_ACQUIRE, "agent");
      asm volatile("s_waitcnt vmcnt(0)" ::: "memory");
    }
  }
  __syncthreads();
}

#define NPHASE 42
__global__ void __launch_bounds__(256, 2) mega(Params kp) {
  __shared__ __attribute__((aligned(16))) char smem[65536];
  cg::grid_group grid = cg::this_grid();
  const int ph0 = kp.p0, ph1 = kp.p1;
  volatile LAS unsigned* xst = (volatile LAS unsigned*)(smem + 65520);
  if (threadIdx.x == 0) { xst[0] = 0u; xst[1] = 0u; }
  __syncthreads();
  XcdBarrier xb = xcd_barrier_post(kp.bar, xst);
  if (ph1 > 1000) grid.sync();
  const bool multi = (ph1 - ph0) > 1;
  for (int ph = ph0; ph < ph1; ph++) {
    CP p = *getp();
    int bid = blockIdx.x, nb = gridDim.x;
    asm volatile("" : "+s"(bid), "+s"(nb));
    if (ph == 0) {
      phase_mod(p, smem, bid, nb);
    } else if (ph == NPHASE - 1) {
      phase_final(p, bid, nb);
    } else {
      const int L = (ph - 1) / 10, sp = (ph - 1) % 10;
      const int j = L >> 1;
      const bool even = (L & 1) == 0;
      int reps = 1;
#ifdef PROBE_SCAN
      if (sp == 4 && !even) reps = 2;
#endif
#ifdef PROBE_GEMM
      if (sp == 1 || sp == 8) reps = 2;
#endif
#ifdef PROBE_MISC
      if (sp == 0 || sp == 7 || sp == 2) reps = 2;
#endif
      for (int rep = 0; rep < reps; rep++) {
      bool do_gemm = false;
      const u16 *A = nullptr, *Bt = nullptr;
      u16* outb = nullptr;
      const float* gate = nullptr;
      int lda = 0, K = 0, ntn = 0, epi = 0, ldo = 0, ncols = 0;
      switch (sp) {
        case 0:
          phase_wconv(p, L, smem, bid, nb);
          phase_norm(p, L, 0, bid, nb);
          break;
        case 1:
          do_gemm = true; A = p.hm; lda = 1024; Bt = p.wb_in; K = 1024; ntn = even ? 18 : 16; epi = 0;
          outb = p.pbuf; ldo = PSTR; ncols = even ? PSTR : 4096;
          break;
        case 2:
          if (even) phase_prep_even(p, j, smem, bid, nb); else phase_prep_odd(p, j, bid, nb);
          break;
        case 3:
          if (even) phase_scan_even_a(p, j, smem, bid, nb); else phase_scan_odd_a(p, j, smem, bid, nb);
          break;
        case 4:
          if (even) phase_scan_even(p, j, smem, bid, nb); else phase_scan_odd(p, j, smem, bid, nb);
          break;
        case 5:
          if (even) phase_post_even(p, j, smem, bid, nb); else phase_post_odd(p, j, bid, nb);
          break;
        case 6:
          do_gemm = true; A = p.hm; lda = even ? 1536 : 1024; Bt = p.wb_out; K = lda; ntn = 4; epi = 2;
          gate = p.mod + (size_t)L * 10 * 6144 + 2048;
          break;
        case 7:
          phase_norm(p, L, 1, bid, nb);
          break;
        case 8:
          do_gemm = true; A = p.hm; lda = 1024; Bt = p.wb_gu; K = 1024; ntn = 22; epi = 1;
          outb = p.pbuf; ldo = 2816; ncols = 2816;
          break;
        default:
          do_gemm = true; A = p.pbuf; lda = 2816; Bt = p.wb_dn; K = 2816; ntn = 4; epi = 2;
          gate = p.mod + (size_t)L * 10 * 6144 + 5120;
          break;
      }
      if (do_gemm) gemm_phase(p, A, lda, Bt, K, ntn, epi, outb, ldo, ncols, gate, smem, bid, nb);
      }
    }
    if (multi && ph + 1 < ph1) xcd_barrier(xb);
  }
}

extern "C" void kernel_launch(void* const* d_in, const int* in_sizes, int n_in, void* d_out, int out_size, void* d_ws,
                              size_t ws_size, hipStream_t stream) {
  static int grid_blocks = 0;
  if (!grid_blocks) {
    int dev = 0, cus = 0, per_cu = 0;
    hipGetDevice(&dev);
    hipDeviceGetAttribute(&cus, hipDeviceAttributeMultiprocessorCount, dev);
    hipOccupancyMaxActiveBlocksPerMultiprocessor(&per_cu, mega, 256, 0);
    if (per_cu > 2) per_cu = 2;
    if (per_cu < 1) per_cu = 1;
    grid_blocks = cus * per_cu;
  }
  Params p{};
  const float* const* in = (const float* const*)d_in;
  p.x_prompt = in[0]; p.x_sample = in[1]; p.st_rwkv = in[2]; p.st_shift = in[3]; p.st_ssm = in[4]; p.st_conv = in[5];
  p.st_hgrn = in[6]; p.c_prompt = in[7]; p.c_sample = in[8]; p.norm_mix_w = in[9]; p.norm_ffn_w = in[10];
  p.norm_out_w = in[11]; p.ada_w = in[12]; p.ada_b = in[13]; p.w_in_ab = in[14]; p.w_out_ab = in[15]; p.mu_a = in[16];
  p.w0 = in[17]; p.w2 = in[18]; p.a0 = in[19]; p.a2 = in[20]; p.g2 = in[21]; p.k_k = in[22]; p.k_a = in[23];
  p.r_k = in[24]; p.lnx_w = in[25]; p.lnx_b = in[26]; p.conv_w = in[27]; p.conv_b = in[28]; p.dt_bias = in[29];
  p.a_log = in[30]; p.d_skip = in[31]; p.norm_b_w = in[32]; p.w_in_c = in[33]; p.w_out_c = in[34]; p.lb_param = in[35];
  p.norm_c_w = in[36]; p.w_gate = in[37]; p.w_up = in[38]; p.w_down = in[39];
  p.out = (float*)d_out;
  char* ws = (char*)d_ws;
  size_t off = 0;
  auto take = [&](size_t bytes) { char* r = ws + off; off += (bytes + 255) & ~(size_t)255; return r; };
  p.bar = (unsigned*)take(16384);
  p.mod = (float*)take((size_t)4 * 10 * 6144 * 4);
  p.bonus = (float*)take((size_t)NT * 8 * 4);
  p.dtb = (float*)take((size_t)NT * 32 * 4);
  p.wb_in = (u16*)take((size_t)4480 * 1024 * 2);
  p.wb_out = (u16*)take((size_t)1024 * 1536 * 2);
  p.wb_gu = (u16*)take((size_t)5632 * 1024 * 2);
  p.wb_dn = (u16*)take((size_t)1024 * 2816 * 2);
  p.hm = (u16*)take((size_t)NT * 1536 * 2);
  p.pbuf = (u16*)take((size_t)NT * PSTR * 2);
  p.rw = (u16*)take((size_t)NT * 8 * 16 * 24 * 2);
  p.cv = (u16*)take((size_t)NT * 1536 * 2);
  p.scr = (float*)take((size_t)12 * 1024 * 1024);
  p.ub = (u16*)take((size_t)NT * 512 * 2);
  p.w2t = (u16*)take((size_t)512 * 64 * 2);
  p.a2t = (u16*)take((size_t)512 * 64 * 2);
  p.g2t = (u16*)take((size_t)512 * 128 * 2);
#if 1
  p.p0 = 0; p.p1 = NPHASE;
  hipMemsetAsync(p.bar, 0, 16384, stream);
  void* args[] = {&p};
  hipError_t e = hipLaunchCooperativeKernel((void*)mega, dim3(grid_blocks), dim3(256), args, 0, stream);
  if (e != hipSuccess) fprintf(stderr, "cooperative launch failed: %s (grid %d)\n", hipGetErrorString(e), grid_blocks);
#else
  for (int ph = 0; ph < NPHASE; ph++) {
    p.p0 = ph; p.p1 = ph + 1;
    mega<<<dim3(grid_blocks), dim3(256), 0, stream>>>(p);
  }
#endif
}
```

```cpp
#include <hip/hip_runtime.h>
#include <hip/hip_cooperative_groups.h>
#include <cstdio>
namespace cg = cooperative_groups;

typedef unsigned short u16;
typedef __attribute__((ext_vector_type(8))) short bf16x8;
typedef __attribute__((ext_vector_type(4))) float f32x4;

#define NT 16512
#define PSTR 4480

#define O_RWKV_P 16908288ull
#define O_SHIFT_P 17039360ull
#define O_SSM_P 17046528ull
#define O_CONV_P 17570816ull
#define O_HGRN_P 17589248ull
#define O_RWKV_S 18113536ull
#define O_SHIFT_S 18637824ull
#define O_SSM_S 18666496ull
#define O_CONV_S 20763648ull
#define O_HGRN_S 20837376ull

struct Params {
  const float *x_prompt, *x_sample, *st_rwkv, *st_shift, *st_ssm, *st_conv, *st_hgrn, *c_prompt, *c_sample;
  const float *norm_mix_w, *norm_ffn_w, *norm_out_w, *ada_w, *ada_b, *w_in_ab, *w_out_ab, *mu_a, *w0, *w2, *a0, *a2,
      *g2, *k_k, *k_a, *r_k, *lnx_w, *lnx_b, *conv_w, *conv_b, *dt_bias, *a_log, *d_skip, *norm_b_w, *w_in_c,
      *w_out_c, *lb_param, *norm_c_w, *w_gate, *w_up, *w_down;
  float* out;
  float *mod, *bonus, *dtb;
  u16 *wb_in, *wb_out, *wb_gu, *wb_dn, *hm, *pbuf, *rw, *cv;
  float* scr;
  u16* ub;
  u16 *w2t, *a2t, *g2t;
  unsigned* bar;
  int p0, p1;
};

typedef const __attribute__((address_space(4))) Params& CP;
typedef const __attribute__((address_space(4))) Params* CPP;
__device__ __forceinline__ CPP getp() {
  CPP pp = (CPP)__builtin_amdgcn_kernarg_segment_ptr();
  asm volatile("" : "+s"(pp) : : "memory");
  return pp;
}
__device__ __forceinline__ int otid() {
  int t = threadIdx.x;
  asm volatile("" : "+v"(t));
  return t;
}
__device__ __forceinline__ float bf2f(u16 u) { return __uint_as_float(((unsigned)u) << 16); }
typedef float f32x2_t __attribute__((ext_vector_type(2)));
typedef __bf16 bf16x2_t __attribute__((ext_vector_type(2)));
__device__ __forceinline__ unsigned pack2(float a, float b) {
  f32x2_t v = {a, b};
  bf16x2_t r = __builtin_convertvector(v, bf16x2_t);
  return __builtin_bit_cast(unsigned, r);
}
__device__ __forceinline__ u16 f2bf(float f) { return (u16)(pack2(f, f) & 0xffffu); }
__device__ __forceinline__ float lo16(unsigned v) { return __uint_as_float(v << 16); }
__device__ __forceinline__ float hi16(unsigned v) { return __uint_as_float(v & 0xffff0000u); }
__device__ __forceinline__ float sigm(float x) { return __builtin_amdgcn_rcpf(1.f + __expf(-x)); }
__device__ __forceinline__ float silu_(float x) { return x * __builtin_amdgcn_rcpf(1.f + __expf(-x)); }
__device__ __forceinline__ float softplus_(float x) {
  const float e = __expf(x);
  return x > 20.f ? x : (e < 1e-4f ? e * (1.f - 0.5f * e) : __logf(1.f + e));
}
__device__ __forceinline__ float tanh_(float x) { return 1.f - 2.f * __builtin_amdgcn_rcpf(1.f + __expf(2.f * x)); }

__device__ __forceinline__ int row_seq(int m) { return m < 16384 ? (m >> 13) : 2 + ((m - 16384) >> 4); }
__device__ __forceinline__ int seq_row0(int s) { return s < 2 ? s * 8192 : 16384 + (s - 2) * 16; }
__device__ __forceinline__ int seq_len(int s) { return s < 2 ? 8192 : 16; }
__device__ __forceinline__ float* out_state(float* out, int s, int j, size_t baseP, size_t baseS, size_t sz) {
  return s < 2 ? out + baseP + (size_t)(s * 2 + j) * sz : out + baseS + (size_t)((s - 2) * 2 + j) * sz;
}

template <int CTRL>
__device__ __forceinline__ float dpp_f(float x) {
  return __int_as_float(__builtin_amdgcn_update_dpp(0, __float_as_int(x), CTRL, 0xf, 0xf, false));
}
__device__ __forceinline__ float red16(float x) {
  x += dpp_f<0xB1>(x);
  x += dpp_f<0x4E>(x);
  x += dpp_f<0x124>(x);
  x += dpp_f<0x128>(x);
  return x;
}
__device__ __forceinline__ float red32_hi(float x) {
  x = red16(x);
  float y = __int_as_float(__builtin_amdgcn_update_dpp(0, __float_as_int(x), 0x142, 0xA, 0xf, false));
  return x + y;
}
__device__ __forceinline__ float wave_sum(float x) {
  x = red16(x);
  x += __int_as_float(__builtin_amdgcn_update_dpp(0, __float_as_int(x), 0x142, 0xA, 0xf, false));
  x += __int_as_float(__builtin_amdgcn_update_dpp(0, __float_as_int(x), 0x143, 0xC, 0xf, false));
  return __int_as_float(__builtin_amdgcn_readlane(__float_as_int(x), 63));
}

__device__ void phase_mod(CP p, char* smem, int bid, int nb) {
  if (bid >= 384) return;
  float* sc = (float*)smem;
  float* red = sc + 10 * 1024;
  const int tid = otid(), lane = tid & 63, wv = tid >> 6;
  for (int i = tid; i < 10 * 1024; i += 256) {
    int s = i >> 10, k = i & 1023;
    float c = s < 2 ? p.c_prompt[s * 1024 + k] : p.c_sample[(s - 2) * 1024 + k];
    sc[i] = silu_(c);
  }
  __syncthreads();
  for (int u = bid; u < 384; u += nb) {
    int L = u / 96, cgp = u % 96;
    int col = cgp * 64 + lane;
    const float* W = p.ada_w + (size_t)L * 1024 * 6144 + col;
    float acc[10];
#pragma unroll
    for (int s = 0; s < 10; s++) acc[s] = 0.f;
    int k0 = wv * 256;
#pragma unroll 4
    for (int k = k0; k < k0 + 256; k += 4) {
      float w0 = W[(size_t)k * 6144], w1 = W[(size_t)(k + 1) * 6144], w2 = W[(size_t)(k + 2) * 6144],
            w3 = W[(size_t)(k + 3) * 6144];
#pragma unroll
      for (int s = 0; s < 10; s++) {
        float4 c4 = *(const float4*)&sc[s * 1024 + k];
        acc[s] += c4.x * w0 + c4.y * w1 + c4.z * w2 + c4.w * w3;
      }
    }
#pragma unroll
    for (int s = 0; s < 10; s++) red[(wv * 10 + s) * 64 + lane] = acc[s];
    __syncthreads();
    for (int i = tid; i < 640; i += 256) {
      int s = i >> 6, l = i & 63;
      float v = red[(0 * 10 + s) * 64 + l] + red[(1 * 10 + s) * 64 + l] + red[(2 * 10 + s) * 64 + l] +
                red[(3 * 10 + s) * 64 + l];
      int c = cgp * 64 + l;
      p.mod[((size_t)L * 10 + s) * 6144 + c] = v + p.ada_b[L * 6144 + c];
    }
    __syncthreads();
  }
}

__device__ __forceinline__ void wconv_tile(const float* __restrict__ src, int K, int N, u16* __restrict__ dst, int k0,
                                           int n0, int mode, float* tile) {
  const int tid = otid();
#pragma unroll
  for (int i = 0; i < 4; i++) {
    int r = i * 16 + (tid >> 4), c = (tid & 15) * 4;
    int n = n0 + c;
    float4 v4 = n < N ? *(const float4*)(src + (size_t)(k0 + r) * N + n) : make_float4(0.f, 0.f, 0.f, 0.f);
    tile[r * 65 + c] = v4.x; tile[r * 65 + c + 1] = v4.y; tile[r * 65 + c + 2] = v4.z; tile[r * 65 + c + 3] = v4.w;
  }
  __syncthreads();
  int n = tid >> 2, kc = (tid & 3) * 16;
  unsigned pk[8];
#pragma unroll
  for (int i = 0; i < 8; i++) pk[i] = pack2(tile[(kc + 2 * i) * 65 + n], tile[(kc + 2 * i + 1) * 65 + n]);
  int gn = n0 + n;
  int row = mode == 0 ? gn : ((gn >> 4) * 32 + (gn & 15) + (mode == 2 ? 16 : 0));
  uint4* d = (uint4*)(dst + (size_t)row * K + k0 + kc);
  d[0] = make_uint4(pk[0], pk[1], pk[2], pk[3]);
  d[1] = make_uint4(pk[4], pk[5], pk[6], pk[7]);
  __syncthreads();
}

__device__ void phase_wconv(CP p, int L, char* smem, int bid, int nb) {
  float* tile = (float*)smem;
  const int j = L >> 1;
  const bool even = (L & 1) == 0;
  const int ntn_in = even ? 70 : 64;
  const int n_in = 16 * ntn_in;
  const int n_out = even ? 24 * 16 : 16 * 16;
  const int n_g = 16 * 44;
  const int n_lora = even ? 32 : 0;
  const int total = n_in + n_out + 3 * n_g + n_lora;
  for (int u = bid; u < total; u += nb) {
    int li = u;
    if (li < n_in) {
      int kt = li / ntn_in, nt = li % ntn_in;
      if (even)
        wconv_tile(p.w_in_ab + (size_t)j * 1024 * 4368, 1024, 4368, p.wb_in, kt * 64, nt * 64, 0, tile);
      else
        wconv_tile(p.w_in_c + (size_t)j * 1024 * 4096, 1024, 4096, p.wb_in, kt * 64, nt * 64, 0, tile);
      continue;
    }
    li -= n_in;
    if (li < n_out) {
      int kt = li / 16, nt = li % 16;
      if (even)
        wconv_tile(p.w_out_ab + (size_t)j * 1536 * 1024, 1536, 1024, p.wb_out, kt * 64, nt * 64, 0, tile);
      else
        wconv_tile(p.w_out_c + (size_t)j * 1024 * 1024, 1024, 1024, p.wb_out, kt * 64, nt * 64, 0, tile);
      continue;
    }
    li -= n_out;
    if (li < n_g) {
      int kt = li / 44, nt = li % 44;
      wconv_tile(p.w_gate + (size_t)L * 1024 * 2816, 1024, 2816, p.wb_gu, kt * 64, nt * 64, 1, tile);
      continue;
    }
    li -= n_g;
    if (li < n_g) {
      int kt = li / 44, nt = li % 44;
      wconv_tile(p.w_up + (size_t)L * 1024 * 2816, 1024, 2816, p.wb_gu, kt * 64, nt * 64, 2, tile);
      continue;
    }
    li -= n_g;
    if (li < n_g) {
      int kt = li / 16, nt = li % 16;
      wconv_tile(p.w_down + (size_t)L * 2816 * 1024, 2816, 1024, p.wb_dn, kt * 64, nt * 64, 0, tile);
      continue;
    }
    li -= n_g;
    if (li < 8) wconv_tile(p.w2 + (size_t)j * 64 * 512, 64, 512, p.w2t, 0, li * 64, 0, tile);
    else if (li < 16) wconv_tile(p.a2 + (size_t)j * 64 * 512, 64, 512, p.a2t, 0, (li - 8) * 64, 0, tile);
    else wconv_tile(p.g2 + (size_t)j * 128 * 512, 128, 512, p.g2t, ((li - 16) >> 3) * 64, ((li - 16) & 7) * 64, 0, tile);
  }
}

__device__ void phase_norm(CP p, int L, int which, int bid, int nb) {
  const int tid = otid(), lane = tid & 63, wv = tid >> 6;
  const bool first = (L == 0 && which == 0);
  const float* nw = (which ? p.norm_ffn_w : p.norm_mix_w) + L * 1024;
  float* X = p.out;
  for (int row = bid * 4 + wv; row < NT; row += nb * 4) {
    const float* x = first ? (row < 16384 ? p.x_prompt + (size_t)row * 1024 : p.x_sample + (size_t)(row - 16384) * 1024)
                           : X + (size_t)row * 1024;
    float4 v[4];
    float ss = 0.f;
#pragma unroll
    for (int i = 0; i < 4; i++) {
      v[i] = *(const float4*)(x + i * 256 + lane * 4);
      ss += v[i].x * v[i].x + v[i].y * v[i].y + v[i].z * v[i].z + v[i].w * v[i].w;
    }
    ss = wave_sum(ss);
    float rstd = rsqrtf(ss * (1.f / 1024.f) + 1e-6f);
    int s = row_seq(row);
    const float* md = p.mod + ((size_t)L * 10 + s) * 6144 + (which ? 3072 : 0);
#pragma unroll
    for (int i = 0; i < 4; i++) {
      int c = i * 256 + lane * 4;
      float4 w4 = *(const float4*)(nw + c);
      float4 sh = *(const float4*)(md + c);
      float4 sc = *(const float4*)(md + 1024 + c);
      float h0 = v[i].x * rstd * w4.x * (1.f + sc.x) + sh.x;
      float h1 = v[i].y * rstd * w4.y * (1.f + sc.y) + sh.y;
      float h2 = v[i].z * rstd * w4.z * (1.f + sc.z) + sh.z;
      float h3 = v[i].w * rstd * w4.w * (1.f + sc.w) + sh.w;
      *(uint2*)(p.hm + (size_t)row * 1024 + c) = make_uint2(pack2(h0, h1), pack2(h2, h3));
      if (first) *(float4*)(X + (size_t)row * 1024 + c) = v[i];
    }
  }
}

__device__ void phase_final(CP p, int bid, int nb) {
  const int tid = otid(), lane = tid & 63, wv = tid >> 6;
  float* X = p.out;
  for (int row = bid * 4 + wv; row < NT; row += nb * 4) {
    float* x = X + (size_t)row * 1024;
    float4 v[4];
    float ss = 0.f;
#pragma unroll
    for (int i = 0; i < 4; i++) {
      v[i] = *(const float4*)(x + i * 256 + lane * 4);
      ss += v[i].x * v[i].x + v[i].y * v[i].y + v[i].z * v[i].z + v[i].w * v[i].w;
    }
    ss = wave_sum(ss);
    float rstd = rsqrtf(ss * (1.f / 1024.f) + 1e-6f);
#pragma unroll
    for (int i = 0; i < 4; i++) {
      int c = i * 256 + lane * 4;
      float4 w4 = *(const float4*)(p.norm_out_w + c);
      float4 o;
      o.x = v[i].x * rstd * w4.x;
      o.y = v[i].y * rstd * w4.y;
      o.z = v[i].z * rstd * w4.z;
      o.w = v[i].w * rstd * w4.w;
      *(float4*)(x + c) = o;
    }
  }
}

__device__ void gemm_phase(CP p, const u16* __restrict__ A, int lda, const u16* __restrict__ Bt, int K,
                           int ntn, int epi, u16* __restrict__ outb, int ldo, int ncols, const float* __restrict__ gate,
                           char* smem, int bid, int nb) {
  u16* As = (u16*)smem;
  u16* Bs = As + 128 * 64;
  const int tid = otid(), lane = tid & 63, wv = tid >> 6;
  const int wm = wv >> 1, wn = wv & 1;
  const int lr = tid >> 3, lc = tid & 7;
  const int l15 = lane & 15, lq = lane >> 4;
  const int nk = K >> 6;
  const int nitems = (epi == 2) ? 128 * ntn + 8 * ntn : 129 * ntn;
#define G_DECODE(tile_, mt_, nt_, kt0_, kt1_, split_) { \
    kt0_ = 0; kt1_ = nk; split_ = false; \
    if (epi == 2 && (tile_) >= 128 * ntn) { \
      const int r_ = (tile_) - 128 * ntn; \
      mt_ = 128; nt_ = r_ >> 3; split_ = true; \
      kt0_ = ((r_ & 7) * nk) >> 3; kt1_ = (((r_ & 7) + 1) * nk) >> 3; \
    } else if (epi == 2 && nb == 512 && ntn == 4) { \
        \
      const int slot_ = (tile_) >> 3; \
      mt_ = ((tile_) & 7) * 16 + (slot_ >> 2); nt_ = slot_ & 3; \
    } else { mt_ = (tile_) / ntn; nt_ = (tile_) % ntn; } }
  uint4 ra0, ra1, ra2, ra3, rb0, rb1, rb2, rb3, rb4, rb5, rb6, rb7;
  const int voA = lr * lda + lc * 8, voB = lr * K + lc * 8;
  const int sA = 32 * lda, sB = 32 * K;
#define G_BL(rs_, vo_, so_) __builtin_bit_cast(uint4, __builtin_amdgcn_raw_buffer_load_b128(rs_, vo_, so_, 0))
#define G_LOADP(ab_, bb_, kt_) { \
    __amdgpu_buffer_rsrc_t ra_ = __builtin_amdgcn_make_buffer_rsrc((void*)(ab_), 0, 0x7ffffff0, 0x00020000); \
    __amdgpu_buffer_rsrc_t rb_ = __builtin_amdgcn_make_buffer_rsrc((void*)(bb_), 0, 0x7ffffff0, 0x00020000); \
    const int ka_ = (kt_) * 128; \
    ra0 = G_BL(ra_, voA * 2, ka_); ra1 = G_BL(ra_, voA * 2, ka_ + 2 * sA); ra2 = G_BL(ra_, voA * 2, ka_ + 4 * sA); ra3 = G_BL(ra_, voA * 2, ka_ + 6 * sA); \
    rb0 = G_BL(rb_, voB * 2, ka_); rb1 = G_BL(rb_, voB * 2, ka_ + 2 * sB); rb2 = G_BL(rb_, voB * 2, ka_ + 4 * sB); rb3 = G_BL(rb_, voB * 2, ka_ + 6 * sB); \
    rb4 = G_BL(rb_, voB * 2, ka_ + 8 * sB); rb5 = G_BL(rb_, voB * 2, ka_ + 10 * sB); rb6 = G_BL(rb_, voB * 2, ka_ + 12 * sB); rb7 = G_BL(rb_, voB * 2, ka_ + 14 * sB); }
  bool have = false;
  for (int tile = bid; tile < nitems; tile += nb) {
    int mt, nt, kt0, kt1;
    bool split;
    G_DECODE(tile, mt, nt, kt0, kt1, split)
    const int m0 = mt * 128, n0 = nt * 256;
    f32x4 acc0[4][4], acc1[4][4];
#pragma unroll
    for (int a = 0; a < 4; a++)
#pragma unroll
      for (int b = 0; b < 4; b++) { acc0[a][b] = (f32x4){0.f, 0.f, 0.f, 0.f}; acc1[a][b] = (f32x4){0.f, 0.f, 0.f, 0.f}; }
    const u16* Ab = A + (size_t)m0 * lda;
    const u16* Bb = Bt + (size_t)n0 * K;
    u16* Aw = As + lr * 64 + ((lc ^ (lr & 7)) * 8);
    u16* Bw = Bs + lr * 64 + ((lc ^ (lr & 7)) * 8);
    if (!have) G_LOADP(Ab, Bb, kt0)
    for (int kt = kt0; kt < kt1; kt++) {
      __syncthreads();
      *(uint4*)(Aw) = ra0; *(uint4*)(Aw + 32 * 64) = ra1; *(uint4*)(Aw + 64 * 64) = ra2; *(uint4*)(Aw + 96 * 64) = ra3;
      *(uint4*)(Bw) = rb0; *(uint4*)(Bw + 32 * 64) = rb1; *(uint4*)(Bw + 64 * 64) = rb2; *(uint4*)(Bw + 96 * 64) = rb3;
      *(uint4*)(Bw + 128 * 64) = rb4; *(uint4*)(Bw + 160 * 64) = rb5; *(uint4*)(Bw + 192 * 64) = rb6; *(uint4*)(Bw + 224 * 64) = rb7;
      __syncthreads();
      if (kt + 1 < kt1) G_LOADP(Ab, Bb, kt + 1)
      {
        const int sw0 = (lq ^ (l15 & 7)) * 8, sw1 = ((lq + 4) ^ (l15 & 7)) * 8;
        __builtin_amdgcn_s_setprio(1);
        const u16* Ar = As + (wm * 64 + l15) * 64;
        const u16* Br = Bs + (wn * 128 + l15) * 64;
        bf16x8 af0[4];
#pragma unroll
        for (int mi = 0; mi < 4; mi++) af0[mi] = *(const bf16x8*)(Ar + mi * 16 * 64 + sw0);
        bf16x8 bq0 = *(const bf16x8*)(Br + sw0);
        bf16x8 bq1 = *(const bf16x8*)(Br + 16 * 64 + sw0);
        __builtin_amdgcn_sched_barrier(0);
#define G_STEP(ACC, nidx, bcur, nextni, nextsw, donext) { \
          bf16x8 bn_ = bcur; \
          if (donext) bcur = *(const bf16x8*)(Br + (nextni) * 16 * 64 + (nextsw)); \
          _Pragma("unroll") for (int mi = 0; mi < 4; mi++) \
            ACC[mi][nidx] = __builtin_amdgcn_mfma_f32_16x16x32_bf16(af0[mi], bn_, ACC[mi][nidx], 0, 0, 0); \
          __builtin_amdgcn_sched_barrier(0); }
        G_STEP(acc0, 0, bq0, 2, sw0, true)
        G_STEP(acc0, 1, bq1, 3, sw0, true)
        G_STEP(acc0, 2, bq0, 4, sw0, true)
        G_STEP(acc0, 3, bq1, 5, sw0, true)
        G_STEP(acc1, 0, bq0, 6, sw0, true)
        G_STEP(acc1, 1, bq1, 7, sw0, true)
        G_STEP(acc1, 2, bq0, 0, sw1, true)
        G_STEP(acc1, 3, bq1, 1, sw1, true)
#pragma unroll
        for (int mi = 0; mi < 4; mi++) af0[mi] = *(const bf16x8*)(Ar + mi * 16 * 64 + sw1);
        __builtin_amdgcn_sched_barrier(0);
        G_STEP(acc0, 0, bq0, 2, sw1, true)
        G_STEP(acc0, 1, bq1, 3, sw1, true)
        G_STEP(acc0, 2, bq0, 4, sw1, true)
        G_STEP(acc0, 3, bq1, 5, sw1, true)
        G_STEP(acc1, 0, bq0, 6, sw1, true)
        G_STEP(acc1, 1, bq1, 7, sw1, true)
        G_STEP(acc1, 2, bq0, 0, 0, false)
        G_STEP(acc1, 3, bq1, 0, 0, false)
        __builtin_amdgcn_s_setprio(0);
      }
    }
    {
      const int ntile = tile + nb;
      have = ntile < nitems;
      if (have) {
        int mt2, nt2, k0n, k1n; bool sp2;
        G_DECODE(ntile, mt2, nt2, k0n, k1n, sp2)
        (void)k1n; (void)sp2;
        G_LOADP(A + (size_t)(mt2 * 128) * lda, Bt + (size_t)(nt2 * 256) * K, k0n)
      }
    }
    if (epi == 2) {
#pragma unroll
      for (int mi = 0; mi < 4; mi++)
#pragma unroll
        for (int jj = 0; jj < 4; jj++) {
          int row = m0 + wm * 64 + mi * 16 + lq * 4 + jj;
          int s = row_seq(row);
          const float* g = gate + (size_t)s * 6144;
          float* xr = p.out + (size_t)row * 1024;
#pragma unroll
          for (int ni = 0; ni < 4; ni++) {
            int col = n0 + wn * 128 + ni * 16 + l15;
            if (split) { atomicAdd(&xr[col], g[col] * acc0[mi][ni][jj]); atomicAdd(&xr[col + 64], g[col + 64] * acc1[mi][ni][jj]); }
            else { xr[col] += g[col] * acc0[mi][ni][jj]; xr[col + 64] += g[col + 64] * acc1[mi][ni][jj]; }
          }
        }
    } else if (epi == 0) {
      u16* Cs = (u16*)smem;
#define EPI0_HALF(hp, ACC) { \
        __syncthreads(); \
        _Pragma("unroll") for (int mi = 0; mi < 4; mi++) \
          _Pragma("unroll") for (int n4 = 0; n4 < 4; n4++) \
            _Pragma("unroll") for (int jj = 0; jj < 4; jj++) { \
              int r = wm * 64 + mi * 16 + lq * 4 + jj, c = wn * 64 + n4 * 16 + l15; \
              Cs[r * 136 + c] = f2bf(ACC[mi][n4][jj]); } \
        __syncthreads(); \
        _Pragma("unroll") for (int i = 0; i < 8; i++) { \
          int q = tid + 256 * i; \
          int r = q >> 4, ch = q & 15; \
          int gcol = n0 + (ch >> 3) * 128 + (hp) * 64 + (ch & 7) * 8; \
          if (gcol < ncols) *(uint4*)(outb + (size_t)(m0 + r) * ldo + gcol) = *(const uint4*)(Cs + r * 136 + ch * 8); } }
      EPI0_HALF(0, acc0)
      EPI0_HALF(1, acc1)
    } else {
      __syncthreads();
      u16* Cs = (u16*)smem;
#pragma unroll
      for (int mi = 0; mi < 4; mi++)
#pragma unroll
        for (int i2 = 0; i2 < 2; i2++)
#pragma unroll
          for (int jj = 0; jj < 4; jj++) {
            int r = wm * 64 + mi * 16 + lq * 4 + jj, c = wn * 64 + i2 * 16 + l15;
            float g0 = acc0[mi][2 * i2][jj], u0 = acc0[mi][2 * i2 + 1][jj];
            float g1 = acc1[mi][2 * i2][jj], u1 = acc1[mi][2 * i2 + 1][jj];
            Cs[r * 136 + c] = f2bf(silu_(g0) * u0);
            Cs[r * 136 + c + 32] = f2bf(silu_(g1) * u1);
          }
      __syncthreads();
#pragma unroll
      for (int i = 0; i < 8; i++) {
        int q = tid + 256 * i;
        int r = q >> 4, ch = q & 15;
        *(uint4*)(outb + (size_t)(m0 + r) * ldo + nt * 128 + ch * 8) = *(const uint4*)(Cs + r * 136 + ch * 8);
      }
    }
  }
}

__device__ void phase_prep_even(CP p, int j, char* smem, int bid, int nb) {
  const int tid = otid();
  const u16* P = p.pbuf;
  {
    u16* txb = (u16*)smem;
    u16* xab = txb + 16 * 72;
    float* resw = (float*)(xab + 16 * 72);
    float* resa = resw + 8 * 512;
    for (int i = tid; i < 2 * 16 * 72; i += 256) txb[i] = 0;
    const int half = tid >> 7, hk = tid & 127, h = hk >> 4, kq = hk & 15;
    const int c4 = h * 64 + kq * 4;
    const float* mu = p.mu_a + j * 1792;
    for (int u = bid; u < NT / 8; u += nb) {
      const int m0 = u * 8;
      const int s = row_seq(m0);
      const int r0 = seq_row0(s);
      __syncthreads();
#pragma unroll
      for (int i = 0; i < 4; i++) {
        int idx = tid + 256 * i;
        int tok = idx >> 7, cc = idx & 127;
        int m = m0 + tok;
        int col = 1536 + cc;
        float pc = bf2f(P[(size_t)m * PSTR + col]);
        float pp = (m > r0) ? bf2f(P[(size_t)(m - 1) * PSTR + col])
                            : (s >= 2 ? p.st_shift[((size_t)(s - 2) * 2 + j) * 1792 + col] : 0.f);
        float pm = pc + (pp - pc) * mu[col];
        if (cc < 64)
          txb[tok * 72 + cc] = f2bf(tanh_(pm));
        else
          xab[tok * 72 + cc - 64] = f2bf(pm);
      }
      __syncthreads();
      {
        const int lane = tid & 63, wv = tid >> 6, l15 = lane & 15, lq = lane >> 4;
        bf16x8 aw[2], aa[2];
#pragma unroll
        for (int ks = 0; ks < 2; ks++) {
          aw[ks] = *(const bf16x8*)(txb + l15 * 72 + ks * 32 + lq * 8);
          aa[ks] = *(const bf16x8*)(xab + l15 * 72 + ks * 32 + lq * 8);
        }
#pragma unroll
        for (int nt = 0; nt < 8; nt++) {
          const int n = wv * 128 + nt * 16 + l15;
          f32x4 cw = (f32x4){0.f, 0.f, 0.f, 0.f}, ca = (f32x4){0.f, 0.f, 0.f, 0.f};
#pragma unroll
          for (int ks = 0; ks < 2; ks++) {
            bf16x8 bw = *(const bf16x8*)(p.w2t + (size_t)n * 64 + ks * 32 + lq * 8);
            bf16x8 ba = *(const bf16x8*)(p.a2t + (size_t)n * 64 + ks * 32 + lq * 8);
            cw = __builtin_amdgcn_mfma_f32_16x16x32_bf16(aw[ks], bw, cw, 0, 0, 0);
            ca = __builtin_amdgcn_mfma_f32_16x16x32_bf16(aa[ks], ba, ca, 0, 0, 0);
          }
          if (lq < 2) {
#pragma unroll
            for (int jj = 0; jj < 4; jj++) {
              resw[(lq * 4 + jj) * 512 + n] = cw[jj];
              resa[(lq * 4 + jj) * 512 + n] = ca[jj];
            }
          }
        }
      }
      __syncthreads();
      float accw[4][4], acca[4][4];
#pragma unroll
      for (int tk = 0; tk < 4; tk++) {
        float4 rw4 = *(const float4*)(resw + (half * 4 + tk) * 512 + c4);
        float4 ra4 = *(const float4*)(resa + (half * 4 + tk) * 512 + c4);
        accw[tk][0] = rw4.x; accw[tk][1] = rw4.y; accw[tk][2] = rw4.z; accw[tk][3] = rw4.w;
        acca[tk][0] = ra4.x; acca[tk][1] = ra4.y; acca[tk][2] = ra4.z; acca[tk][3] = ra4.w;
      }
      float4 w0v = *(const float4*)(p.w0 + j * 512 + c4);
      float4 a0v = *(const float4*)(p.a0 + j * 512 + c4);
      float4 kkv = *(const float4*)(p.k_k + j * 512 + c4);
      float4 kav = *(const float4*)(p.k_a + j * 512 + c4);
      float4 rkv = *(const float4*)(p.r_k + j * 512 + c4);
      float4 mur = *(const float4*)(mu + c4);
      float4 muk = *(const float4*)(mu + 512 + c4);
      float4 muv = *(const float4*)(mu + 1024 + c4);
      const float w0a[4] = {w0v.x, w0v.y, w0v.z, w0v.w};
      const float a0a[4] = {a0v.x, a0v.y, a0v.z, a0v.w};
      const float kka[4] = {kkv.x, kkv.y, kkv.z, kkv.w};
      const float kaa[4] = {kav.x, kav.y, kav.z, kav.w};
      const float rka[4] = {rkv.x, rkv.y, rkv.z, rkv.w};
      const float mura[4] = {mur.x, mur.y, mur.z, mur.w};
      const float muka[4] = {muk.x, muk.y, muk.z, muk.w};
      const float muva[4] = {muv.x, muv.y, muv.z, muv.w};
#pragma unroll
      for (int tk = 0; tk < 4; tk++) {
        const int m = m0 + half * 4 + tk;
        uint2 pr = *(const uint2*)(P + (size_t)m * PSTR + c4);
        uint2 pk = *(const uint2*)(P + (size_t)m * PSTR + 512 + c4);
        uint2 pv = *(const uint2*)(P + (size_t)m * PSTR + 1024 + c4);
        float rc[4] = {lo16(pr.x), hi16(pr.x), lo16(pr.y), hi16(pr.y)};
        float kc[4] = {lo16(pk.x), hi16(pk.x), lo16(pk.y), hi16(pk.y)};
        float vc[4] = {lo16(pv.x), hi16(pv.x), lo16(pv.y), hi16(pv.y)};
        float rp[4], kp[4], vp[4];
        if (m > r0) {
          uint2 qr = *(const uint2*)(P + (size_t)(m - 1) * PSTR + c4);
          uint2 qk = *(const uint2*)(P + (size_t)(m - 1) * PSTR + 512 + c4);
          uint2 qv = *(const uint2*)(P + (size_t)(m - 1) * PSTR + 1024 + c4);
          rp[0] = lo16(qr.x); rp[1] = hi16(qr.x); rp[2] = lo16(qr.y); rp[3] = hi16(qr.y);
          kp[0] = lo16(qk.x); kp[1] = hi16(qk.x); kp[2] = lo16(qk.y); kp[3] = hi16(qk.y);
          vp[0] = lo16(qv.x); vp[1] = hi16(qv.x); vp[2] = lo16(qv.y); vp[3] = hi16(qv.y);
        } else if (s >= 2) {
          const float* sp = p.st_shift + ((size_t)(s - 2) * 2 + j) * 1792;
#pragma unroll
          for (int e = 0; e < 4; e++) { rp[e] = sp[c4 + e]; kp[e] = sp[512 + c4 + e]; vp[e] = sp[1024 + c4 + e]; }
        } else {
#pragma unroll
          for (int e = 0; e < 4; e++) { rp[e] = 0.f; kp[e] = 0.f; vp[e] = 0.f; }
        }
        float r[4], k[4], v[4], kk[4], kn[4], bb[4], ee[4];
        float ssq = 0.f, bsum = 0.f;
#pragma unroll
        for (int e = 0; e < 4; e++) {
          r[e] = rc[e] + (rp[e] - rc[e]) * mura[e];
          k[e] = kc[e] + (kp[e] - kc[e]) * muka[e];
          v[e] = vc[e] + (vp[e] - vc[e]) * muva[e];
          float wpre = w0a[e] + accw[tk][e];
          float w = -softplus_(-wpre) - 0.5f;
          { const float ew = __expf(w); ee[e] = ew < 1e-3f ? ew * (1.f - 0.5f * ew) : 1.f - __expf(-ew); }
          float a = sigm(a0a[e] + acca[tk][e]);
          kk[e] = k[e] * kka[e];
          ssq += kk[e] * kk[e];
          kn[e] = k[e] * (1.f + (a - 1.f) * kaa[e]);
          bb[e] = a;
          bsum += r[e] * kn[e] * rka[e];
        }
        ssq = red16(ssq);
        bsum = red16(bsum);
        float inv = rsqrtf(fmaxf(ssq, 1e-24f));
#pragma unroll
        for (int e = 0; e < 4; e++) { kk[e] *= inv; bb[e] = kk[e] * bb[e]; }
        if (kq == 0) p.bonus[(size_t)m * 8 + h] = bsum;
        uint4* dst = (uint4*)(p.rw + (((size_t)m * 8 + h) * 16 + kq) * 24);
        dst[0] = make_uint4(pack2(r[0], r[1]), pack2(r[2], r[3]), pack2(kn[0], kn[1]), pack2(kn[2], kn[3]));
        dst[1] = make_uint4(pack2(kk[0], kk[1]), pack2(kk[2], kk[3]), pack2(bb[0], bb[1]), pack2(bb[2], bb[3]));
        dst[2] = make_uint4(pack2(ee[0], ee[1]), pack2(ee[2], ee[3]), pack2(v[0], v[1]), pack2(v[2], v[3]));
      }
    }
  }
  for (int idx = bid * 256 + tid; idx < 10 * 1792; idx += nb * 256) {
    int s = idx / 1792, c = idx % 1792;
    int m = seq_row0(s) + seq_len(s) - 1;
    float* o = out_state(p.out, s, j, O_SHIFT_P, O_SHIFT_S, 1792);
    o[c] = bf2f(P[(size_t)m * PSTR + c]);
  }
  for (int u = bid; u < NT / 16; u += nb) {
    const int mb = u * 16;
    const int s = row_seq(mb);
    const int r0 = seq_row0(s);
    if (tid < 192) {
      const int c0 = tid * 8;
      const int t0 = mb - r0;
      float wgt[4][8], bia[8];
      {
        float4 b0 = *(const float4*)(p.conv_b + j * 1536 + c0), b1 = *(const float4*)(p.conv_b + j * 1536 + c0 + 4);
        bia[0] = b0.x; bia[1] = b0.y; bia[2] = b0.z; bia[3] = b0.w; bia[4] = b1.x; bia[5] = b1.y; bia[6] = b1.z; bia[7] = b1.w;
#pragma unroll
        for (int tap = 0; tap < 4; tap++) {
          const float* cw = p.conv_w + ((size_t)j * 4 + tap) * 1536 + c0;
          float4 w0 = *(const float4*)cw, w1 = *(const float4*)(cw + 4);
          wgt[tap][0] = w0.x; wgt[tap][1] = w0.y; wgt[tap][2] = w0.z; wgt[tap][3] = w0.w;
          wgt[tap][4] = w1.x; wgt[tap][5] = w1.y; wgt[tap][6] = w1.z; wgt[tap][7] = w1.w;
        }
      }
#pragma unroll 1
      for (int hf = 0; hf < 2; hf++) {
      uint4 rows[11];
#pragma unroll
      for (int i = 0; i < 11; i++) {
        const int tt = t0 + hf * 8 - 3 + i;
        if (tt >= 0) {
          rows[i] = *(const uint4*)(P + (size_t)(r0 + tt) * PSTR + 2816 + c0);
        } else if (s >= 2) {
          const float* cs = p.st_conv + (((size_t)(s - 2) * 2 + j) * 3 + (tt + 3)) * 1536 + c0;
          float4 q0 = *(const float4*)cs, q1 = *(const float4*)(cs + 4);
          rows[i] = make_uint4(pack2(q0.x, q0.y), pack2(q0.z, q0.w), pack2(q1.x, q1.y), pack2(q1.z, q1.w));
        } else {
          rows[i] = make_uint4(0, 0, 0, 0);
        }
      }
#pragma unroll
      for (int t = 0; t < 8; t++) {
        float acc[8];
#pragma unroll
        for (int e = 0; e < 8; e++) acc[e] = bia[e];
#pragma unroll
        for (int tap = 0; tap < 4; tap++) {
          const uint4 q = rows[t + tap];
          acc[0] += wgt[tap][0] * lo16(q.x); acc[1] += wgt[tap][1] * hi16(q.x);
          acc[2] += wgt[tap][2] * lo16(q.y); acc[3] += wgt[tap][3] * hi16(q.y);
          acc[4] += wgt[tap][4] * lo16(q.z); acc[5] += wgt[tap][5] * hi16(q.z);
          acc[6] += wgt[tap][6] * lo16(q.w); acc[7] += wgt[tap][7] * hi16(q.w);
        }
        *(uint4*)(p.cv + (size_t)(mb + hf * 8 + t) * 1536 + c0) =
            make_uint4(pack2(silu_(acc[0]), silu_(acc[1])), pack2(silu_(acc[2]), silu_(acc[3])),
                       pack2(silu_(acc[4]), silu_(acc[5])), pack2(silu_(acc[6]), silu_(acc[7])));
      }
      }
    }
    {
      int tok = tid >> 4, hh = tid & 15;
      int m = mb + tok;
      float dtv = softplus_(bf2f(P[(size_t)m * PSTR + 4352 + hh]) + p.dt_bias[j * 16 + hh]);
      float* cs = (float*)smem;
      __syncthreads();
      cs[tid] = -dtv * __expf(p.a_log[j * 16 + hh]);
      __syncthreads();
      float G = 0.f;
      for (int i = 0; i <= tok; i++) G += cs[i * 16 + hh];
      p.dtb[(size_t)m * 32 + hh] = dtv;
      p.dtb[(size_t)m * 32 + 16 + hh] = G;
    }
  }
  for (int idx = bid * 256 + tid; idx < 10 * 3 * 1536; idx += nb * 256) {
    int s = idx / 4608, rem = idx % 4608;
    int r = rem / 1536, c = rem % 1536;
    int m = seq_row0(s) + seq_len(s) - 3 + r;
    float* o = out_state(p.out, s, j, O_CONV_P, O_CONV_S, 4608);
    o[rem] = bf2f(P[(size_t)m * PSTR + 2816 + c]);
  }
}

__device__ __forceinline__ void cvt8_store(float* d, uint4 v) {
  *(float4*)d = make_float4(lo16(v.x), hi16(v.x), lo16(v.y), hi16(v.y));
  *(float4*)(d + 4) = make_float4(lo16(v.z), hi16(v.z), lo16(v.w), hi16(v.w));
}

#define RK_NOC 4
#define RK_BASE(p) ((p).scr + 2100000)
#define RK_LS(p) (RK_BASE(p))
#define RK_PS(p) (RK_BASE(p) + 262144)
#define RK_SI(p) (RK_BASE(p) + 524288)
template <int PART>
__device__ __forceinline__ void rwkv_scan_item(CP p, int j, int s, int h, int rg, int oc, int noc, char* smem) {
  float* Lb = (float*)smem;
  float* ob = Lb + 2 * 16 * 16 * 28;
  const int tid = otid(), lane = tid & 63, wv = tid >> 6;
  const int rl = lane >> 4, kq = lane & 15;
  const int R = rg * 16 + wv * 4 + rl;
  const int T = seq_len(s) / noc, m0 = seq_row0(s) + oc * T;
  float S[4];
  if (PART == 1) {
#pragma unroll
    for (int e = 0; e < 4; e++) S[e] = (R == kq * 4 + e) ? 1.f : 0.f;
  } else if (s >= 2) {
    float4 q = *(const float4*)(p.st_rwkv + ((((size_t)(s - 2) * 2 + j) * 8 + h) * 64 + R) * 64 + kq * 4);
    S[0] = q.x; S[1] = q.y; S[2] = q.z; S[3] = q.w;
  } else {
    S[0] = S[1] = S[2] = S[3] = 0.f;
  }
  const u16* src = p.rw + ((size_t)m0 * 8 + h) * 16 * 24;
  const int q0 = tid, q1 = tid + 256, q2 = tid + 512;
  const int so0 = (q0 / 48) * 3072 + (q0 % 48) * 8, so1 = (q1 / 48) * 3072 + (q1 % 48) * 8,
            so2 = (q2 / 48) * 3072 + (q2 % 48) * 8;
  const int do0 = ((q0 / 48) * 16 + (q0 % 48) / 3) * 28 + ((q0 % 48) % 3) * 8,
            do1 = ((q1 / 48) * 16 + (q1 % 48) / 3) * 28 + ((q1 % 48) % 3) * 8,
            do2 = ((q2 / 48) * 16 + (q2 % 48) / 3) * 28 + ((q2 % 48) % 3) * 8;
  u16* outp = PART ? p.ub + (size_t)(m0 + (tid >> 4)) * 512 + h * 64 + rg * 16 + (tid & 15)
                   : p.hm + (size_t)(m0 + (tid >> 4)) * 1536 + h * 64 + rg * 16 + (tid & 15);
  const int ostr = PART ? 16 * 512 : 16 * 1536;
  const int nbat = T >> 4;
  uint4 a0, a1, a2, c0, c1, c2;
#define RW_ISSUE(r0, r1, r2, bt) { const u16* sp_ = src + (size_t)(bt) * 16 * 3072; \
    r0 = *(const uint4*)(sp_ + so0); r1 = *(const uint4*)(sp_ + so1); r2 = *(const uint4*)(sp_ + so2); }
#define RW_STASH(r0, r1, r2, bi) { float* d_ = Lb + (bi) * (16 * 16 * 28); \
    cvt8_store(d_ + do0, r0); cvt8_store(d_ + do1, r1); cvt8_store(d_ + do2, r2); }
#define RW_COMPUTE(bt) { \
    const float* cur = Lb + ((bt) & 1) * (16 * 16 * 28); \
    float* obc = ob + ((bt) & 1) * 256; \
    float op[16]; \
    f32x2_t Sa = {S[0], S[1]}, Sb = {S[2], S[3]}; \
    _Pragma("unroll") for (int st = 0; st < 16; st++) { \
      const float* sl = cur + (st * 16 + kq) * 28; \
      float4 r4 = *(const float4*)(sl), k4 = *(const float4*)(sl + 4), kk4 = *(const float4*)(sl + 8), \
             b4 = *(const float4*)(sl + 12), e4 = *(const float4*)(sl + 16); \
      float v = PART ? 0.f : cur[(st * 16 + (R >> 2)) * 28 + 20 + (R & 3)]; \
      f32x2_t t_ = Sa * (f32x2_t){kk4.x, kk4.y}; \
      t_ = Sb * (f32x2_t){kk4.z, kk4.w} + t_; \
      const float sa = -red16(t_.x + t_.y); \
      Sa = Sa - Sa * (f32x2_t){e4.x, e4.y}; Sb = Sb - Sb * (f32x2_t){e4.z, e4.w}; \
      Sa = (f32x2_t){v, v} * (f32x2_t){k4.x, k4.y} + Sa; Sb = (f32x2_t){v, v} * (f32x2_t){k4.z, k4.w} + Sb; \
      Sa = (f32x2_t){sa, sa} * (f32x2_t){b4.x, b4.y} + Sa; Sb = (f32x2_t){sa, sa} * (f32x2_t){b4.z, b4.w} + Sb; \
      f32x2_t u_ = Sa * (f32x2_t){r4.x, r4.y}; \
      u_ = Sb * (f32x2_t){r4.z, r4.w} + u_; \
      op[st] = u_.x + u_.y; \
      if ((st & 3) == 3) __builtin_amdgcn_sched_barrier(0); \
    } \
    S[0] = Sa.x; S[1] = Sa.y; S[2] = Sb.x; S[3] = Sb.y; \
    _Pragma("unroll") for (int st = 0; st < 16; st++) op[st] = red16(op[st]); \
    if (kq == 0) { _Pragma("unroll") for (int st = 0; st < 16; st++) obc[st * 16 + wv * 4 + rl] = op[st]; } }
#define RW_OUT(bt) { outp[(size_t)(bt) * ostr] = f2bf(ob[((bt) & 1) * 256 + tid]); }
  __syncthreads();
  RW_ISSUE(a0, a1, a2, 0)
  RW_STASH(a0, a1, a2, 0)
  if (1 < nbat) RW_ISSUE(a0, a1, a2, 1)
  if (2 < nbat) RW_ISSUE(c0, c1, c2, 2)
  __syncthreads();
  for (int b = 0; b < nbat; b += 2) {
    RW_COMPUTE(b)
    if (b + 1 < nbat) RW_STASH(a0, a1, a2, 1)
    __syncthreads();
    RW_OUT(b)
    if (b + 1 >= nbat) break;
    if (b + 3 < nbat) RW_ISSUE(a0, a1, a2, b + 3)
    RW_COMPUTE(b + 1)
    if (b + 2 < nbat) RW_STASH(c0, c1, c2, 0)
    __syncthreads();
    RW_OUT(b + 1)
    if (b + 4 < nbat) RW_ISSUE(c0, c1, c2, b + 4)
  }
  if (noc == 1) {
    float* o = out_state(p.out, s, j, O_RWKV_P, O_RWKV_S, 32768);
    *(float4*)(o + ((size_t)h * 64 + R) * 64 + kq * 4) = make_float4(S[0], S[1], S[2], S[3]);
  } else {
    float* o = (PART ? RK_PS(p) : RK_LS(p)) + (size_t)((s * 8 + h) * 4 + oc) * 4096;
    *(float4*)(o + (size_t)R * 64 + kq * 4) = make_float4(S[0], S[1], S[2], S[3]);
  }
  __syncthreads();
}

__device__ __forceinline__ void rwkv_combine_item(CP p, int j, int s, int h, char* smem) {
  float* Sl = (float*)smem;
  const int tid = otid();
  const int r = tid >> 2, jq = tid & 3;
  const size_t idx0 = (size_t)(s * 8 + h) * 4;
  float cur[16];
  {
    const float* l0 = RK_LS(p) + idx0 * 4096 + r * 64 + jq * 16;
#pragma unroll
    for (int c = 0; c < 16; c++) cur[c] = l0[c];
  }
  for (int oc = 1; oc < RK_NOC; oc++) {
    float* si = RK_SI(p) + (idx0 + oc) * 4096 + r * 64 + jq * 16;
    __syncthreads();
#pragma unroll
    for (int c = 0; c < 16; c++) { si[c] = cur[c]; Sl[r * 65 + jq * 16 + c] = cur[c]; }
    __syncthreads();
    float nx[16];
    {
      const float* lo = RK_LS(p) + (idx0 + oc) * 4096 + r * 64 + jq * 16;
#pragma unroll
      for (int c = 0; c < 16; c++) nx[c] = lo[c];
    }
    const float* pm = RK_PS(p) + (idx0 + oc) * 4096 + jq * 16;
    for (int i = 0; i < 64; i++) {
      const float sv = Sl[r * 65 + i];
      const float4 p0 = *(const float4*)(pm + i * 64), p1 = *(const float4*)(pm + i * 64 + 4),
                   p2 = *(const float4*)(pm + i * 64 + 8), p3 = *(const float4*)(pm + i * 64 + 12);
      nx[0] += sv * p0.x; nx[1] += sv * p0.y; nx[2] += sv * p0.z; nx[3] += sv * p0.w;
      nx[4] += sv * p1.x; nx[5] += sv * p1.y; nx[6] += sv * p1.z; nx[7] += sv * p1.w;
      nx[8] += sv * p2.x; nx[9] += sv * p2.y; nx[10] += sv * p2.z; nx[11] += sv * p2.w;
      nx[12] += sv * p3.x; nx[13] += sv * p3.y; nx[14] += sv * p3.z; nx[15] += sv * p3.w;
    }
#pragma unroll
    for (int c = 0; c < 16; c++) cur[c] = nx[c];
  }
  float* o = out_state(p.out, s, j, O_RWKV_P, O_RWKV_S, 32768) + ((size_t)h * 64 + r) * 64 + jq * 16;
#pragma unroll
  for (int c = 0; c < 16; c++) o[c] = cur[c];
  __syncthreads();
}

typedef __attribute__((ext_vector_type(4))) short bf16x4;
#define MB_SL(p) ((p).scr)
#define MB_DD(p) ((p).scr + 256 * 8192)
#define MB_NOC 8
template <int MODE>
__device__ __forceinline__ void mamba_scan_item(CP p, int j, int s, int h, int oc, int noc, char* smem) {
  u16* Bs = (u16*)smem;
  u16* Cs = Bs + 2 * 16 * 136;
  u16* BTs = Cs + 2 * 16 * 136;
  u16* XTs = BTs + 2 * 128 * 24;
  u16* XBs = XTs + 2 * 64 * 24;
  u16* SsT = XBs + 2 * 64 * 24;
  float* Gs = (float*)(SsT + 64 * 136);
  const int tid = otid(), lane = tid & 63, wv = tid >> 6;
  const int l15 = lane & 15, lq = lane >> 4;
  const int g = h >> 3;
  const int T = seq_len(s);
  const int nch = (T >> 4) / noc;
  const int m0 = seq_row0(s) + oc * nch * 16;
  f32x4 acc[8];
#pragma unroll
  for (int nt = 0; nt < 8; nt++) acc[nt] = (f32x4){0.f, 0.f, 0.f, 0.f};
  float prodD = 1.f;
  if (MODE == 1) {
    if (s >= 2) {
      const float* sp = p.st_ssm + (((size_t)(s - 2) * 2 + j) * 16 + h) * 8192 + (size_t)(wv * 16 + lq * 4) * 128 + l15;
#pragma unroll
      for (int nt = 0; nt < 8; nt++)
        acc[nt] = (f32x4){sp[nt * 16], sp[128 + nt * 16], sp[256 + nt * 16], sp[384 + nt * 16]};
    } else {
      for (int cp = 0; cp < oc; cp++) {
        const size_t idx = (size_t)((s * 16 + h) * 8 + cp);
        const float dd = MB_DD(p)[idx];
        const float* sp = MB_SL(p) + idx * 8192 + (size_t)(wv * 16 + lq * 4) * 128 + l15;
#pragma unroll
        for (int nt = 0; nt < 8; nt++)
          acc[nt] = (f32x4){acc[nt][0] * dd + sp[nt * 16], acc[nt][1] * dd + sp[128 + nt * 16],
                            acc[nt][2] * dd + sp[256 + nt * 16], acc[nt][3] * dd + sp[384 + nt * 16]};
      }
    }
  }
  const u16* Pb = p.cv + (size_t)(m0 + (tid >> 4)) * 1536 + 1024 + g * 128 + (tid & 15) * 8;
  const u16* Px = p.cv + (size_t)(m0 + ((tid >> 3) & 15)) * 1536 + h * 64 + (tid & 7) * 8;
  const float* Pdt = p.dtb + (size_t)(m0 + ((tid >> 3) & 15)) * 32 + h;
  const float* PgL = p.dtb + (size_t)(m0 + 15) * 32 + 16 + h;
  const float* PG = p.dtb + (size_t)(m0 + (tid & 15)) * 32 + 16 + h;
  uint4 ab, ac, ax, cb, cc, cx;
  float adt = 0.f, ag = 0.f, agl = 0.f, aG = 0.f, cdt = 0.f, cg = 0.f, cgl = 0.f, cG = 0.f;
  ab = make_uint4(0, 0, 0, 0); ac = ab; ax = ab; cb = ab; cc = ab; cx = ab;
#define MM_ISSUE(rb, rc, rx, rdt, rg, rgl, rG, c) { \
    rb = *(const uint4*)(Pb + (size_t)(c) * 16 * 1536); \
    if (MODE == 1) rc = *(const uint4*)(Pb + (size_t)(c) * 16 * 1536 + 256); \
    if (tid < 128) { rx = *(const uint4*)(Px + (size_t)(c) * 16 * 1536); rdt = Pdt[(size_t)(c) * 16 * 32]; \
      rg = Pdt[(size_t)(c) * 16 * 32 + 16]; rgl = PgL[(size_t)(c) * 16 * 32]; } \
    if (tid < 16) rG = PG[(size_t)(c) * 16 * 32]; }
#define MM_T8(dst, rv, sc) { \
      dst[0 * 24] = f2bf(lo16(rv.x) * (sc)); dst[1 * 24] = f2bf(hi16(rv.x) * (sc)); dst[2 * 24] = f2bf(lo16(rv.y) * (sc)); dst[3 * 24] = f2bf(hi16(rv.y) * (sc)); \
      dst[4 * 24] = f2bf(lo16(rv.z) * (sc)); dst[5 * 24] = f2bf(hi16(rv.z) * (sc)); dst[6 * 24] = f2bf(lo16(rv.w) * (sc)); dst[7 * 24] = f2bf(hi16(rv.w) * (sc)); }
#define MM_STASH(rb, rc, rx, rdt, rg, rgl, rG, bi) { \
    if (MODE == 1) { *(uint4*)(Bs + (bi) * (16 * 136) + (tid >> 4) * 136 + (tid & 15) * 8) = rb; \
                     *(uint4*)(Cs + (bi) * (16 * 136) + (tid >> 4) * 136 + (tid & 15) * 8) = rc; } \
    { u16* bd_ = BTs + (bi) * (128 * 24) + ((tid & 15) * 8) * 24 + (tid >> 4); \
      bd_[0 * 24] = (u16)(rb.x & 0xffff); bd_[1 * 24] = (u16)(rb.x >> 16); bd_[2 * 24] = (u16)(rb.y & 0xffff); bd_[3 * 24] = (u16)(rb.y >> 16); \
      bd_[4 * 24] = (u16)(rb.z & 0xffff); bd_[5 * 24] = (u16)(rb.z >> 16); bd_[6 * 24] = (u16)(rb.w & 0xffff); bd_[7 * 24] = (u16)(rb.w >> 16); } \
    if (tid < 128) { const float sb_ = rdt * __expf(rgl - rg); \
      u16* xb_ = XBs + (bi) * (64 * 24) + ((tid & 7) * 8) * 24 + (tid >> 3); MM_T8(xb_, rx, sb_) \
      if (MODE == 1) { u16* xt_ = XTs + (bi) * (64 * 24) + ((tid & 7) * 8) * 24 + (tid >> 3); MM_T8(xt_, rx, rdt) } } \
    if (tid < 16) { Gs[(bi) * 32 + tid] = rG; if (tid == 15) Gs[(bi) * 32 + 16] = __expf(rG); } }
  __syncthreads();
  MM_ISSUE(ab, ac, ax, adt, ag, agl, aG, 0)
  MM_STASH(ab, ac, ax, adt, ag, agl, aG, 0)
  if (1 < nch) MM_ISSUE(ab, ac, ax, adt, ag, agl, aG, 1)
  if (2 < nch) MM_ISSUE(cb, cc, cx, cdt, cg, cgl, cG, 2)
  for (int c = 0; c < nch; c++) {
    const int bi = c & 1;
    if (MODE == 1) {
#pragma unroll
      for (int nt = 0; nt < 8; nt++)
#pragma unroll
        for (int jj = 0; jj < 4; jj++)
          SsT[(wv * 16 + lq * 4 + jj) * 136 + nt * 16 + l15] = f2bf(acc[nt][jj]);
    }
    __syncthreads();
    if (c + 1 < nch) {
      if (bi == 0) { MM_STASH(ab, ac, ax, adt, ag, agl, aG, 1) if (c + 3 < nch) MM_ISSUE(ab, ac, ax, adt, ag, agl, aG, c + 3) }
      else { MM_STASH(cb, cc, cx, cdt, cg, cgl, cG, 0) if (c + 3 < nch) MM_ISSUE(cb, cc, cx, cdt, cg, cgl, cG, c + 3) }
    }
    const u16* Bc = Bs + bi * (16 * 136);
    const u16* Cc = Cs + bi * (16 * 136);
    const u16* BTc = BTs + bi * (128 * 24);
    const u16* XTc = XTs + bi * (64 * 24);
    const u16* XBc = XBs + bi * (64 * 24);
    const float* Gc = Gs + bi * 32;
    if (MODE == 1) {
      f32x4 at = (f32x4){0.f, 0.f, 0.f, 0.f};
      bf16x8 cf[4];
#pragma unroll
      for (int ks = 0; ks < 4; ks++) {
        bf16x8 bfv = *(const bf16x8*)(Bc + l15 * 136 + ks * 32 + lq * 8);
        cf[ks] = *(const bf16x8*)(Cc + l15 * 136 + ks * 32 + lq * 8);
        at = __builtin_amdgcn_mfma_f32_16x16x32_bf16(bfv, cf[ks], at, 0, 0, 0);
      }
      const float Gt = Gc[l15];
      bf16x4 bat;
#pragma unroll
      for (int jj = 0; jj < 4; jj++) {
        const int sidx = lq * 4 + jj;
        bat[jj] = (short)f2bf(sidx <= l15 ? at[jj] * __expf(Gt - Gc[sidx]) : 0.f);
      }
      bf16x4 xt = *(const bf16x4*)(XTc + (wv * 16 + l15) * 24 + lq * 4);
      f32x4 ao1 = (f32x4){0.f, 0.f, 0.f, 0.f};
      ao1 = __builtin_amdgcn_mfma_f32_16x16x16bf16_1k(xt, bat, ao1, 0, 0, 0);
      f32x4 ao2 = (f32x4){0.f, 0.f, 0.f, 0.f};
#pragma unroll
      for (int ks = 0; ks < 4; ks++) {
        bf16x8 sf = *(const bf16x8*)(SsT + (wv * 16 + l15) * 136 + ks * 32 + lq * 8);
        ao2 = __builtin_amdgcn_mfma_f32_16x16x32_bf16(sf, cf[ks], ao2, 0, 0, 0);
      }
      const float eg = __expf(Gt);
      *(uint2*)(p.hm + (size_t)(m0 + c * 16 + l15) * 1536 + 512 + h * 64 + wv * 16 + lq * 4) =
          make_uint2(pack2(ao1[0] + ao2[0] * eg, ao1[1] + ao2[1] * eg), pack2(ao1[2] + ao2[2] * eg, ao1[3] + ao2[3] * eg));
    }
    {
      const float eGL = Gc[16];
      if (MODE == 0) prodD *= eGL;
      bf16x4 xb = *(const bf16x4*)(XBc + (wv * 16 + l15) * 24 + lq * 4);
#pragma unroll
      for (int nt = 0; nt < 8; nt++) {
        bf16x4 bt = *(const bf16x4*)(BTc + (nt * 16 + l15) * 24 + lq * 4);
        f32x4 cin = (f32x4){acc[nt][0] * eGL, acc[nt][1] * eGL, acc[nt][2] * eGL, acc[nt][3] * eGL};
        acc[nt] = __builtin_amdgcn_mfma_f32_16x16x16bf16_1k(xb, bt, cin, 0, 0, 0);
      }
    }
  }
  if (MODE == 0) {
    const size_t idx = (size_t)((s * 16 + h) * 8 + oc);
    float* sp = MB_SL(p) + idx * 8192 + (size_t)(wv * 16 + lq * 4) * 128 + l15;
#pragma unroll
    for (int nt = 0; nt < 8; nt++) {
      sp[nt * 16] = acc[nt][0]; sp[128 + nt * 16] = acc[nt][1]; sp[256 + nt * 16] = acc[nt][2]; sp[384 + nt * 16] = acc[nt][3];
    }
    if (tid == 0) MB_DD(p)[idx] = prodD;
  } else if (oc == noc - 1) {
    float* sp = out_state(p.out, s, j, O_SSM_P, O_SSM_S, 131072) + (size_t)h * 8192 + (size_t)(wv * 16 + lq * 4) * 128 + l15;
#pragma unroll
    for (int nt = 0; nt < 8; nt++) {
      sp[nt * 16] = acc[nt][0]; sp[128 + nt * 16] = acc[nt][1]; sp[256 + nt * 16] = acc[nt][2]; sp[384 + nt * 16] = acc[nt][3];
    }
  }
  __syncthreads();
}

__device__ void phase_scan_even_a(CP p, int j, char* smem, int bid, int nb) {
  const int nA = 32 * (MB_NOC - 1);
  for (int it = bid; it < 448 + nA + 256; it += nb) {
    int kind, q, oc = 0, noc = RK_NOC;
    if (it < 256) { kind = 0; q = it >> 2; oc = it & 3; }
    else if (it < 448) { kind = 1; q = (it - 256) / 3; oc = 1 + (it - 256) % 3; }
    else if (it < 448 + nA) { kind = 2; q = (it - 448) / (MB_NOC - 1); oc = (it - 448) % (MB_NOC - 1); }
    else { kind = 0; q = 64 + (it - 448 - nA); noc = 1; }
    if (kind == 2) mamba_scan_item<0>(p, j, q >> 4, q & 15, oc, MB_NOC, smem);
    else {
      const int s = q < 64 ? (q >> 5) : 2 + ((q - 64) >> 5);
      if (kind == 0) rwkv_scan_item<0>(p, j, s, (q >> 2) & 7, q & 3, oc, noc, smem);
      else rwkv_scan_item<1>(p, j, s, (q >> 2) & 7, q & 3, oc, noc, smem);
    }
  }
}
__device__ void phase_scan_even(CP p, int j, char* smem, int bid, int nb) {
  for (int it = bid; it < 16 + 32 * MB_NOC + 128; it += nb) {
    if (it < 16) { rwkv_combine_item(p, j, it >> 3, it & 7, smem); continue; }
    const int i2 = it - 16;
    int q, s, oc, noc;
    if (i2 < 32 * MB_NOC) { q = i2 / MB_NOC; oc = i2 % MB_NOC; noc = MB_NOC; s = q >> 4; }
    else { q = i2 - 32 * MB_NOC; oc = 0; noc = 1; s = 2 + (q >> 4); }
    mamba_scan_item<1>(p, j, s, q & 15, oc, noc, smem);
  }
}

__device__ void phase_post_even(CP p, int j, char* smem, int bid, int nb) {
  const int tid = otid(), lane = tid & 63, wv = tid >> 6;
  const u16* P = p.pbuf;
  {
    u16* sgb = (u16*)smem;
    float* ul = (float*)(sgb + 16 * 136) ;
    float* resg = ul + 8 * 512;
    for (int i = tid; i < 16 * 136; i += 256) sgb[i] = 0;
    const int half = tid >> 7, hk = tid & 127, h = hk >> 4, kq = hk & 15;
    const int c4 = h * 64 + kq * 4;
    const float* mu = p.mu_a + j * 1792;
    for (int u = bid; u < NT / 8; u += nb) {
      const int m0 = u * 8;
      const int s = row_seq(m0);
      const int r0 = seq_row0(s);
      __syncthreads();
#pragma unroll
      for (int i = 0; i < 4; i++) {
        int idx = tid + 256 * i;
        int tok = idx >> 7, cc = idx & 127;
        int m = m0 + tok;
        int col = 1664 + cc;
        float pc = bf2f(P[(size_t)m * PSTR + col]);
        float pp = (m > r0) ? bf2f(P[(size_t)(m - 1) * PSTR + col])
                            : (s >= 2 ? p.st_shift[((size_t)(s - 2) * 2 + j) * 1792 + col] : 0.f);
        float pm = pc + (pp - pc) * mu[col];
        sgb[tok * 136 + cc] = f2bf(sigm(pm));
      }
      const int ocu = (s < 2) ? ((m0 - r0) >> 11) : 0;
      if (ocu > 0) {
#pragma unroll
        for (int i = 0; i < 2; i++) {
          int idx = tid + 256 * i;
          uint4 uv = *(const uint4*)(p.ub + (size_t)m0 * 512 + idx * 8);
          cvt8_store(ul + idx * 8, uv);
        }
      }
      __syncthreads();
      float corr[4][4];
#pragma unroll
      for (int a = 0; a < 4; a++)
#pragma unroll
        for (int b = 0; b < 4; b++) corr[a][b] = 0.f;
      if (ocu > 0) {
        const float* sip = RK_SI(p) + (size_t)((s * 8 + h) * 4 + ocu) * 4096 + (size_t)(kq * 4) * 64;
#pragma unroll 2
        for (int i = 0; i < 64; i += 4) {
          float4 u4[4];
#pragma unroll
          for (int tk = 0; tk < 4; tk++) u4[tk] = *(const float4*)(ul + (half * 4 + tk) * 512 + h * 64 + i);
#pragma unroll
          for (int rr = 0; rr < 4; rr++) {
            float4 s4 = *(const float4*)(sip + rr * 64 + i);
#pragma unroll
            for (int tk = 0; tk < 4; tk++)
              corr[tk][rr] += s4.x * u4[tk].x + s4.y * u4[tk].y + s4.z * u4[tk].z + s4.w * u4[tk].w;
          }
        }
      }
      {
        const int lane = tid & 63, wv = tid >> 6, l15 = lane & 15, lq = lane >> 4;
        bf16x8 ag[4];
#pragma unroll
        for (int ks = 0; ks < 4; ks++) ag[ks] = *(const bf16x8*)(sgb + l15 * 136 + ks * 32 + lq * 8);
#pragma unroll
        for (int nt = 0; nt < 8; nt++) {
          const int n = wv * 128 + nt * 16 + l15;
          f32x4 cgv = (f32x4){0.f, 0.f, 0.f, 0.f};
#pragma unroll
          for (int ks = 0; ks < 4; ks++) {
            bf16x8 bg = *(const bf16x8*)(p.g2t + (size_t)n * 128 + ks * 32 + lq * 8);
            cgv = __builtin_amdgcn_mfma_f32_16x16x32_bf16(ag[ks], bg, cgv, 0, 0, 0);
          }
          if (lq < 2) {
#pragma unroll
            for (int jj = 0; jj < 4; jj++) resg[(lq * 4 + jj) * 512 + n] = cgv[jj];
          }
        }
      }
      __syncthreads();
      float accg[4][4];
#pragma unroll
      for (int tk = 0; tk < 4; tk++) {
        float4 rg4 = *(const float4*)(resg + (half * 4 + tk) * 512 + c4);
        accg[tk][0] = rg4.x; accg[tk][1] = rg4.y; accg[tk][2] = rg4.z; accg[tk][3] = rg4.w;
      }
      float4 lw = *(const float4*)(p.lnx_w + j * 512 + c4);
      float4 lb = *(const float4*)(p.lnx_b + j * 512 + c4);
      const float lwa[4] = {lw.x, lw.y, lw.z, lw.w};
      const float lba[4] = {lb.x, lb.y, lb.z, lb.w};
#pragma unroll
      for (int tk = 0; tk < 4; tk++) {
        const int m = m0 + half * 4 + tk;
        u16* op = p.hm + (size_t)m * 1536 + c4;
        uint2 oraw = *(const uint2*)op;
        float o[4] = {lo16(oraw.x) + corr[tk][0], hi16(oraw.x) + corr[tk][1], lo16(oraw.y) + corr[tk][2], hi16(oraw.y) + corr[tk][3]};
        float sm = red16(o[0] + o[1] + o[2] + o[3]);
        float mean = sm * (1.f / 64.f);
        float d0 = o[0] - mean, d1 = o[1] - mean, d2 = o[2] - mean, d3 = o[3] - mean;
        float var = red16(d0 * d0 + d1 * d1 + d2 * d2 + d3 * d3) * (1.f / 64.f);
        float rs = rsqrtf(var + 64e-5f);
        float bon = p.bonus[(size_t)m * 8 + h];
        uint4 sl2 = *(const uint4*)(p.rw + (((size_t)m * 8 + h) * 16 + kq) * 24 + 16);
        float v[4] = {lo16(sl2.z), hi16(sl2.z), lo16(sl2.w), hi16(sl2.w)};
        float dd[4] = {d0, d1, d2, d3};
        float res[4];
#pragma unroll
        for (int e = 0; e < 4; e++) res[e] = (dd[e] * rs * lwa[e] + lba[e] + bon * v[e]) * accg[tk][e];
        *(uint2*)op = make_uint2(pack2(res[0], res[1]), pack2(res[2], res[3]));
      }
    }
  }
  for (int w = bid * 4 + wv; w < NT * 2; w += nb * 4) {
    int m = w >> 1, g = w & 1;
    u16* yp = p.hm + (size_t)m * 1536 + 512 + g * 512 + lane * 8;
    uint4 yr = *(const uint4*)yp;
    uint4 zr = *(const uint4*)(P + (size_t)m * PSTR + 1792 + g * 512 + lane * 8);
    float y[8] = {lo16(yr.x), hi16(yr.x), lo16(yr.y), hi16(yr.y), lo16(yr.z), hi16(yr.z), lo16(yr.w), hi16(yr.w)};
    float z[8] = {lo16(zr.x), hi16(zr.x), lo16(zr.y), hi16(zr.y), lo16(zr.z), hi16(zr.z), lo16(zr.w), hi16(zr.w)};
    uint4 xr = *(const uint4*)(p.cv + (size_t)m * 1536 + g * 512 + lane * 8);
    float x[8] = {lo16(xr.x), hi16(xr.x), lo16(xr.y), hi16(xr.y), lo16(xr.z), hi16(xr.z), lo16(xr.w), hi16(xr.w)};
    const float dsk = p.d_skip[j * 16 + g * 8 + (lane >> 3)];
    float ss = 0.f;
#pragma unroll
    for (int e = 0; e < 8; e++) { y[e] = (y[e] + dsk * x[e]) * silu_(z[e]); ss += y[e] * y[e]; }
    ss = wave_sum(ss);
    float rs = rsqrtf(ss * (1.f / 512.f) + 1e-5f);
    const float* nw = p.norm_b_w + j * 1024 + g * 512 + lane * 8;
    float4 n0 = *(const float4*)nw, n1 = *(const float4*)(nw + 4);
    *(uint4*)yp = make_uint4(pack2(y[0] * rs * n0.x, y[1] * rs * n0.y), pack2(y[2] * rs * n0.z, y[3] * rs * n0.w),
                             pack2(y[4] * rs * n1.x, y[5] * rs * n1.y), pack2(y[6] * rs * n1.z, y[7] * rs * n1.w));
  }
}

#define QK_OFF ((size_t)1032 * 1024 * 16)
__device__ void phase_prep_odd(CP p, int j, int bid, int nb) {
  const int tid = otid();
  const u16* P = p.pbuf;
  u16* KT = p.rw;
  u16* QK = p.rw + QK_OFF;
  float* DL = (float*)p.cv;
  for (int u = bid; u < (NT / 16) * 2; u += nb) {
    const int ci = u >> 1, k = ((u & 1) * 256 + tid) * 2;
    float lb0 = 0.f, lb1 = 0.f;
    if (j == 1) { lb0 = sigm(p.lb_param[1024 + k] - p.lb_param[k]); lb1 = sigm(p.lb_param[1025 + k] - p.lb_param[k + 1]); }
    const u16* base = P + (size_t)ci * 16 * PSTR + k;
    unsigned qr[16], fr[16];
#pragma unroll
    for (int t = 0; t < 16; t++) { qr[t] = *(const unsigned*)(base + (size_t)t * PSTR); fr[t] = *(const unsigned*)(base + (size_t)t * PSTR + 1024); }
    float G0 = 0.f, G1 = 0.f;
    unsigned kt0[8], kt1[8];
#pragma unroll
    for (int t = 0; t < 16; t++) {
      float q0 = lo16(qr[t]), q1 = hi16(qr[t]), f0 = lo16(fr[t]), f1 = hi16(fr[t]);
      float s0 = sigm(f0), s1 = sigm(f1);
      float ff0 = lb0 + (1.f - lb0) * s0, ff1 = lb1 + (1.f - lb1) * s1;
      float kk0 = (1.f - lb0) * (1.f - s0), kk1 = (1.f - lb1) * (1.f - s1);
      G0 += __logf(fmaxf(ff0, 1e-30f)); G1 += __logf(fmaxf(ff1, 1e-30f));
      float Q0 = silu_(q0) * __expf(G0), Q1 = silu_(q1) * __expf(G1);
      float K0 = kk0 * __expf(fminf(-G0, 80.f)), K1 = kk1 * __expf(fminf(-G1, 80.f));
      unsigned kb0 = f2bf(K0), kb1 = f2bf(K1);
      u16* qd = QK + (size_t)(ci * 16 + t) * 2048 + k;
      *(unsigned*)qd = pack2(Q0, Q1);
      *(unsigned*)(qd + 1024) = kb0 | (kb1 << 16);
      if (t & 1) { kt0[t >> 1] |= kb0 << 16; kt1[t >> 1] |= kb1 << 16; } else { kt0[t >> 1] = kb0; kt1[t >> 1] = kb1; }
    }
    *(float2*)(DL + (size_t)ci * 1024 + k) = make_float2(__expf(G0), __expf(G1));
    uint4* kd = (uint4*)(KT + ((size_t)ci * 1024 + k) * 16);
    kd[0] = make_uint4(kt0[0], kt0[1], kt0[2], kt0[3]);
    kd[1] = make_uint4(kt0[4], kt0[5], kt0[6], kt0[7]);
    kd[2] = make_uint4(kt1[0], kt1[1], kt1[2], kt1[3]);
    kd[3] = make_uint4(kt1[4], kt1[5], kt1[6], kt1[7]);
  }
}

#define HG_SL(p) ((float*)(p).cv + 2 * 1024 * 1024)
#define HG_DD(p) (HG_SL(p) + 2 * 8 * 8 * 16384)
template <int MODE>
__device__ __forceinline__ void hgrn_scan_item(CP p, int j, int s, int h, int vq, int oc, int noc, char* smem) {
  u16* Qs = (u16*)smem;
  u16* Ks = Qs + 2 * 16 * 136;
  u16* KTs = Ks + 2 * 16 * 136;
  u16* VTs = KTs + 2 * 128 * 24;
  u16* SsT = VTs + 2 * 32 * 24;
  float* dLs = (float*)(SsT + 2 * 32 * 136);
  const int tid = otid(), lane = tid & 63, wv = tid >> 6;
  const int l15 = lane & 15, lq = lane >> 4;
  const int T = seq_len(s);
  const int nch = (T >> 4) / noc;
  const int m0 = seq_row0(s) + oc * nch * 16;
  const int ci0 = m0 >> 4;
  f32x4 acc[2][2];
#pragma unroll
  for (int vt = 0; vt < 2; vt++)
#pragma unroll
    for (int kl = 0; kl < 2; kl++) acc[vt][kl] = (f32x4){0.f, 0.f, 0.f, 0.f};
  float prodD[2] = {1.f, 1.f};
  if (MODE == 1) {
    if (s >= 2) {
      const float* sp = p.st_hgrn + (((size_t)(s - 2) * 2 + j) * 8 + h) * 16384;
#pragma unroll
      for (int vt = 0; vt < 2; vt++)
#pragma unroll
        for (int kl = 0; kl < 2; kl++) {
          float4 q = *(const float4*)(sp + (size_t)((2 * wv + kl) * 16 + l15) * 128 + vq * 32 + vt * 16 + lq * 4);
          acc[vt][kl] = (f32x4){q.x, q.y, q.z, q.w};
        }
    } else {
      for (int cp = 0; cp < oc; cp++) {
        const size_t idx = (size_t)((s * 8 + h) * 8 + cp);
#pragma unroll
        for (int kl = 0; kl < 2; kl++) {
          const int k = (2 * wv + kl) * 16 + l15;
          const float dd = HG_DD(p)[idx * 128 + k];
#pragma unroll
          for (int vt = 0; vt < 2; vt++) {
            float4 L4 = *(const float4*)(HG_SL(p) + idx * 16384 + (size_t)k * 128 + vq * 32 + vt * 16 + lq * 4);
            acc[vt][kl] = (f32x4){acc[vt][kl][0] * dd + L4.x, acc[vt][kl][1] * dd + L4.y, acc[vt][kl][2] * dd + L4.z,
                                  acc[vt][kl][3] * dd + L4.w};
          }
        }
      }
    }
  }
  const u16* Pq = p.rw + QK_OFF + (size_t)(m0 + (tid >> 4)) * 2048 + h * 128 + (tid & 15) * 8;
  const u16* Pv = p.pbuf + (size_t)(m0 + ((tid >> 2) & 15)) * PSTR + 2048 + h * 128 + vq * 32 + (tid & 3) * 8;
  const u16* Pkt = p.rw + ((size_t)ci0 * 1024 + h * 128 + (tid >> 1)) * 16 + (tid & 1) * 8;
  const float* Pdl = (const float*)p.cv + (size_t)ci0 * 1024 + h * 128 + (tid & 31) * 4;
  uint4 aq, ak, akt, av, cq, ck, ckt, cvv;
  float4 ad, cd;
  aq = make_uint4(0, 0, 0, 0); ak = aq; cq = aq; ck = aq;
  av = make_uint4(0, 0, 0, 0); cvv = av; ad = make_float4(0, 0, 0, 0); cd = ad;
#define HM_ISSUE(rq, rk, rkt, rv, rd, c) { \
    if (MODE == 1) { rq = *(const uint4*)(Pq + (size_t)(c) * 16 * 2048); rk = *(const uint4*)(Pq + (size_t)(c) * 16 * 2048 + 1024); } \
    rkt = *(const uint4*)(Pkt + (size_t)(c) * 1024 * 16); \
    if (tid < 64) rv = *(const uint4*)(Pv + (size_t)(c) * 16 * PSTR); \
    if (tid < 32) rd = *(const float4*)(Pdl + (size_t)(c) * 1024); }
#define HM_STASH(rq, rk, rkt, rv, rd, bi) { \
    if (MODE == 1) { *(uint4*)(Qs + (bi) * (16 * 136) + (tid >> 4) * 136 + (tid & 15) * 8) = rq; \
    *(uint4*)(Ks + (bi) * (16 * 136) + (tid >> 4) * 136 + (tid & 15) * 8) = rk; } \
    *(uint4*)(KTs + (bi) * (128 * 24) + (tid >> 1) * 24 + (tid & 1) * 8) = rkt; \
    if (tid < 64) { u16* vd_ = VTs + (bi) * (32 * 24) + ((tid & 3) * 8) * 24 + (tid >> 2); \
      vd_[0 * 24] = (u16)(rv.x & 0xffff); vd_[1 * 24] = (u16)(rv.x >> 16); vd_[2 * 24] = (u16)(rv.y & 0xffff); vd_[3 * 24] = (u16)(rv.y >> 16); \
      vd_[4 * 24] = (u16)(rv.z & 0xffff); vd_[5 * 24] = (u16)(rv.z >> 16); vd_[6 * 24] = (u16)(rv.w & 0xffff); vd_[7 * 24] = (u16)(rv.w >> 16); } \
    if (tid < 32) *(float4*)(dLs + (bi) * 128 + tid * 4) = rd; }
  __syncthreads();
  HM_ISSUE(aq, ak, akt, av, ad, 0)
  HM_STASH(aq, ak, akt, av, ad, 0)
  if (1 < nch) HM_ISSUE(aq, ak, akt, av, ad, 1)
  if (2 < nch) HM_ISSUE(cq, ck, ckt, cvv, cd, 2)
  for (int c = 0; c < nch; c++) {
    const int bi = c & 1;
    if (MODE == 1) {
      u16* sd = SsT + bi * (32 * 136);
#pragma unroll
      for (int vt = 0; vt < 2; vt++)
#pragma unroll
        for (int kl = 0; kl < 2; kl++)
#pragma unroll
          for (int jj = 0; jj < 4; jj++)
            sd[(vt * 16 + lq * 4 + jj) * 136 + (2 * wv + kl) * 16 + l15] = f2bf(acc[vt][kl][jj]);
    }
    __syncthreads();
    if (c + 1 < nch) {
      if (bi == 0) { HM_STASH(aq, ak, akt, av, ad, 1) if (c + 3 < nch) HM_ISSUE(aq, ak, akt, av, ad, c + 3) }
      else { HM_STASH(cq, ck, ckt, cvv, cd, 0) if (c + 3 < nch) HM_ISSUE(cq, ck, ckt, cvv, cd, c + 3) }
    }
    const u16* Qc = Qs + bi * (16 * 136);
    const u16* Kc = Ks + bi * (16 * 136);
    const u16* KTc = KTs + bi * (128 * 24);
    const u16* VTc = VTs + bi * (32 * 24);
    const u16* Sc = SsT + bi * (32 * 136);
    if (MODE == 1 && wv < 2) {
      const int vt = wv;
      f32x4 at = (f32x4){0.f, 0.f, 0.f, 0.f};
      bf16x8 qf[4];
#pragma unroll
      for (int ks = 0; ks < 4; ks++) {
        bf16x8 kf = *(const bf16x8*)(Kc + l15 * 136 + ks * 32 + lq * 8);
        qf[ks] = *(const bf16x8*)(Qc + l15 * 136 + ks * 32 + lq * 8);
        at = __builtin_amdgcn_mfma_f32_16x16x32_bf16(kf, qf[ks], at, 0, 0, 0);
      }
      bf16x4 bat;
#pragma unroll
      for (int jj = 0; jj < 4; jj++) bat[jj] = (short)f2bf((lq * 4 + jj) <= l15 ? at[jj] : 0.f);
      bf16x4 vf = *(const bf16x4*)(VTc + (vt * 16 + l15) * 24 + lq * 4);
      f32x4 ao1 = (f32x4){0.f, 0.f, 0.f, 0.f};
      ao1 = __builtin_amdgcn_mfma_f32_16x16x16bf16_1k(vf, bat, ao1, 0, 0, 0);
      f32x4 ao2 = (f32x4){0.f, 0.f, 0.f, 0.f};
#pragma unroll
      for (int ks = 0; ks < 4; ks++) {
        bf16x8 sf = *(const bf16x8*)(Sc + (vt * 16 + l15) * 136 + ks * 32 + lq * 8);
        ao2 = __builtin_amdgcn_mfma_f32_16x16x32_bf16(sf, qf[ks], ao2, 0, 0, 0);
      }
      f32x4 ao = (f32x4){ao1[0] + ao2[0], ao1[1] + ao2[1], ao1[2] + ao2[2], ao1[3] + ao2[3]};
      *(uint2*)(p.hm + (size_t)(m0 + c * 16 + l15) * 1024 + h * 128 + vq * 32 + vt * 16 + lq * 4) =
          make_uint2(pack2(ao[0], ao[1]), pack2(ao[2], ao[3]));
    }
#pragma unroll
    for (int kl = 0; kl < 2; kl++) {
      const int kt = 2 * wv + kl;
      bf16x4 kb = *(const bf16x4*)(KTc + (kt * 16 + l15) * 24 + lq * 4);
      float dl = dLs[bi * 128 + kt * 16 + l15];
      if (MODE == 0) prodD[kl] *= dl;
#pragma unroll
      for (int vt = 0; vt < 2; vt++) {
        bf16x4 vf = *(const bf16x4*)(VTc + (vt * 16 + l15) * 24 + lq * 4);
        f32x4 a = __builtin_amdgcn_mfma_f32_16x16x16bf16_1k(vf, kb, acc[vt][kl], 0, 0, 0);
        acc[vt][kl] = (f32x4){a[0] * dl, a[1] * dl, a[2] * dl, a[3] * dl};
      }
    }
  }
  if (MODE == 0) {
    const size_t idx = (size_t)((s * 8 + h) * 8 + oc);
#pragma unroll
    for (int kl = 0; kl < 2; kl++) {
      const int k = (2 * wv + kl) * 16 + l15;
      if (vq == 0 && lq == 0) HG_DD(p)[idx * 128 + k] = prodD[kl];
#pragma unroll
      for (int vt = 0; vt < 2; vt++)
        *(float4*)(HG_SL(p) + idx * 16384 + (size_t)k * 128 + vq * 32 + vt * 16 + lq * 4) =
            make_float4(acc[vt][kl][0], acc[vt][kl][1], acc[vt][kl][2], acc[vt][kl][3]);
    }
  } else if (oc == noc - 1) {
    float* o = out_state(p.out, s, j, O_HGRN_P, O_HGRN_S, 131072) + (size_t)h * 16384;
#pragma unroll
    for (int vt = 0; vt < 2; vt++)
#pragma unroll
      for (int kl = 0; kl < 2; kl++)
        *(float4*)(o + (size_t)((2 * wv + kl) * 16 + l15) * 128 + vq * 32 + vt * 16 + lq * 4) =
            make_float4(acc[vt][kl][0], acc[vt][kl][1], acc[vt][kl][2], acc[vt][kl][3]);
  }
  __syncthreads();
}

#define HG_NOC 8
__device__ void phase_scan_odd_a(CP p, int j, char* smem, int bid, int nb) {
  for (int it = bid; it < 64 * (HG_NOC - 1); it += nb) {
    int q = it / (HG_NOC - 1), oc = it % (HG_NOC - 1);
    hgrn_scan_item<0>(p, j, q >> 5, (q >> 2) & 7, q & 3, oc, HG_NOC, smem);
  }
}
__device__ void phase_scan_odd(CP p, int j, char* smem, int bid, int nb) {
  for (int it = bid; it < 64 * HG_NOC + 256; it += nb) {
    int q, s, oc, noc;
    if (it < 64 * HG_NOC) { q = it / HG_NOC; oc = it % HG_NOC; noc = HG_NOC; s = q >> 5; }
    else { q = it - 64 * HG_NOC; oc = 0; noc = 1; s = 2 + (q >> 5); }
    hgrn_scan_item<1>(p, j, s, (q >> 2) & 7, q & 3, oc, noc, smem);
  }
}

__device__ void phase_post_odd(CP p, int j, int bid, int nb) {
  const int tid = otid(), lane = tid & 63, wv = tid >> 6;
  const u16* P = p.pbuf;
  for (int m = bid * 4 + wv; m < NT; m += nb * 4) {
    u16* op = p.hm + (size_t)m * 1024 + lane * 16;
    uint4 a = *(const uint4*)op, b = *(const uint4*)(op + 8);
    const u16* gp = P + (size_t)m * PSTR + 3072 + lane * 16;
    uint4 ga = *(const uint4*)gp, gb = *(const uint4*)(gp + 8);
    float o[16] = {lo16(a.x), hi16(a.x), lo16(a.y), hi16(a.y), lo16(a.z), hi16(a.z), lo16(a.w), hi16(a.w),
                   lo16(b.x), hi16(b.x), lo16(b.y), hi16(b.y), lo16(b.z), hi16(b.z), lo16(b.w), hi16(b.w)};
    float g[16] = {lo16(ga.x), hi16(ga.x), lo16(ga.y), hi16(ga.y), lo16(ga.z), hi16(ga.z), lo16(ga.w), hi16(ga.w),
                   lo16(gb.x), hi16(gb.x), lo16(gb.y), hi16(gb.y), lo16(gb.z), hi16(gb.z), lo16(gb.w), hi16(gb.w)};
    float ss = 0.f;
#pragma unroll
    for (int e = 0; e < 16; e++) ss += o[e] * o[e];
    ss += dpp_f<0xB1>(ss);
    ss += dpp_f<0x4E>(ss);
    ss += dpp_f<0x141>(ss);
    float rs = rsqrtf(ss * (1.f / 128.f) + 1e-5f);
    const float* nw = p.norm_c_w + j * 1024 + lane * 16;
    float r[16];
#pragma unroll
    for (int e = 0; e < 16; e++) r[e] = o[e] * rs * nw[e] * silu_(g[e]);
    *(uint4*)op = make_uint4(pack2(r[0], r[1]), pack2(r[2], r[3]), pack2(r[4], r[5]), pack2(r[6], r[7]));
    *(uint4*)(op + 8) = make_uint4(pack2(r[8], r[9]), pack2(r[10], r[11]), pack2(r[12], r[13]), pack2(r[14], r[15]));
  }
}


#define XB_TMO      128
#define XB_XCNT(j)  (256  + 64 * (j))
#define XB_XSUB(j)  (1280 + 64 * (j))
#define XB_XGEN(j)  (2304 + 64 * (j))
#define XB_TOP      3328
#define XB_TOPGEN   3392
#define XCD_BAR_WORDS 3456
#define XB_SPIN_CAP (1u << 22)
#define LAS __attribute__((address_space(3)))
__device__ __forceinline__ unsigned xb_ld(unsigned* p) { return __hip_atomic_load(p, __ATOMIC_RELAXED, __HIP_MEMORY_SCOPE_AGENT); }
__device__ __forceinline__ unsigned xb_add(unsigned* p, unsigned v) { return __hip_atomic_fetch_add(p, v, __ATOMIC_RELAXED, __HIP_MEMORY_SCOPE_AGENT); }
__device__ __forceinline__ unsigned xb_xcc_id() { return (unsigned)__builtin_amdgcn_s_getreg((3 << 11) | 20) & 0xFu; }
#define XB_SPIN(cond, bar) do { unsigned _sp = 0; while (cond) { __builtin_amdgcn_s_sleep(1); \
    if ((++_sp & 255u) == 0u) { if (xb_ld(&(bar)[XB_TMO])) break; if (_sp > XB_SPIN_CAP) { atomicAdd(&(bar)[XB_TMO], 1u); break; } } } } while (0)
struct XcdBarrier { unsigned* bar; unsigned x; volatile LAS unsigned* st; };
__device__ __forceinline__ XcdBarrier xcd_barrier_post(unsigned* bar, volatile LAS unsigned* st) {
  XcdBarrier b; b.bar = bar; b.x = xb_xcc_id(); b.st = st;
  if (threadIdx.x == 0) (void)xb_add(&bar[XB_XCNT(b.x)], 1u);
  return b;
}
__device__ __forceinline__ void xcd_barrier_complete(unsigned* bar, unsigned x, unsigned& nloc, unsigned& nx) {
  const unsigned G = gridDim.x * gridDim.y * gridDim.z;
  unsigned sum, cnt, mine, sp = 0u;
  for (;;) {
    sum = 0u; cnt = 0u; mine = 0u;
#pragma unroll
    for (unsigned j = 0; j < 16; ++j) { const unsigned c = xb_ld(&bar[XB_XCNT(j)]); sum += c; cnt += (c > 0u) ? 1u : 0u; mine = (j == x) ? c : mine; }
    if (sum == G) break;
    __builtin_amdgcn_s_sleep(1);
    if ((++sp & 255u) == 0u) { if (xb_ld(&bar[XB_TMO])) break; if (sp > XB_SPIN_CAP) { atomicAdd(&bar[XB_TMO], 1u); break; } }
  }
  nloc = mine > 0u ? mine : 1u; nx = cnt > 0u ? cnt : 1u;
}
__device__ __forceinline__ void xcd_barrier(const XcdBarrier& b) {
  asm volatile("s_waitcnt vmcnt(0)" ::: "memory");
  __syncthreads();
  if (threadIdx.x == 0) {
    unsigned* bar = b.bar;
    __builtin_amdgcn_s_waitcnt(0);
    unsigned nloc = b.st[0], nx = b.st[1];
    if (nloc == 0u) { xcd_barrier_complete(bar, b.x, nloc, nx); b.st[0] = nloc; b.st[1] = nx; }
    const unsigned old = xb_add(&bar[XB_XSUB(b.x)], 1u);
    const unsigned gen = old / nloc;
    if (old + 1u == (gen + 1u) * nloc) {
      __builtin_amdgcn_fence(__ATOMIC_RELEASE, "agent");
      asm volatile("s_waitcnt vmcnt(0)" ::: "memory");
      const unsigned og = xb_add(&bar[XB_TOP], 1u);
      const unsigned tg = og / nx;
      if (og + 1u == (tg + 1u) * nx) xb_add(&bar[XB_TOPGEN], 1u);
      else XB_SPIN(xb_ld(&bar[XB_TOPGEN]) == tg, bar);
      __builtin_amdgcn_fence(__ATOMIC_ACQUIRE, "agent");
      xb_add(&bar[XB_XGEN(b.x)], 1u);
      asm volatile("s_waitcnt vmcnt(0)" ::: "memory");
    } else {
      XB_SPIN(xb_ld(&bar[XB_XGEN(b.x)]) == gen, bar);
      __builtin_amdgcn_fence(__ATOMIC_ACQUIRE, "agent");
      asm volatile("s_waitcnt vmcnt(0)" ::: "memory");
    }
  }
  __syncthreads();
}

#define NPHASE 42
__global__ void __launch_bounds__(256, 2) mega(Params kp) {
  __shared__ __attribute__((aligned(16))) char smem[65536];
  cg::grid_group grid = cg::this_grid();
  const int ph0 = kp.p0, ph1 = kp.p1;
  volatile LAS unsigned* xst = (volatile LAS unsigned*)(smem + 65520);
  if (threadIdx.x == 0) { xst[0] = 0u; xst[1] = 0u; }
  __syncthreads();
  XcdBarrier xb = xcd_barrier_post(kp.bar, xst);
  if (ph1 > 1000) grid.sync();
  const bool multi = (ph1 - ph0) > 1;
  for (int ph = ph0; ph < ph1; ph++) {
    CP p = *getp();
    int bid = blockIdx.x, nb = gridDim.x;
    asm volatile("" : "+s"(bid), "+s"(nb));
    if (ph == 0) {
      phase_mod(p, smem, bid, nb);
    } else if (ph == NPHASE - 1) {
      phase_final(p, bid, nb);
    } else {
      const int L = (ph - 1) / 10, sp = (ph - 1) % 10;
      const int j = L >> 1;
      const bool even = (L & 1) == 0;
      int reps = 1;
#ifdef PROBE_SCAN
      if (sp == 4 && !even) reps = 2;
#endif
#ifdef PROBE_GEMM
      if (sp == 1 || sp == 8) reps = 2;
#endif
#ifdef PROBE_MISC
      if (sp == 0 || sp == 7 || sp == 2) reps = 2;
#endif
      for (int rep = 0; rep < reps; rep++) {
      bool do_gemm = false;
      const u16 *A = nullptr, *Bt = nullptr;
      u16* outb = nullptr;
      const float* gate = nullptr;
      int lda = 0, K = 0, ntn = 0, epi = 0, ldo = 0, ncols = 0;
      switch (sp) {
        case 0:
          phase_wconv(p, L, smem, bid, nb);
          phase_norm(p, L, 0, bid, nb);
          break;
        case 1:
          do_gemm = true; A = p.hm; lda = 1024; Bt = p.wb_in; K = 1024; ntn = even ? 18 : 16; epi = 0;
          outb = p.pbuf; ldo = PSTR; ncols = even ? PSTR : 4096;
          break;
        case 2:
          if (even) phase_prep_even(p, j, smem, bid, nb); else phase_prep_odd(p, j, bid, nb);
          break;
        case 3:
          if (even) phase_scan_even_a(p, j, smem, bid, nb); else phase_scan_odd_a(p, j, smem, bid, nb);
          break;
        case 4:
          if (even) phase_scan_even(p, j, smem, bid, nb); else phase_scan_odd(p, j, smem, bid, nb);
          break;
        case 5:
          if (even) phase_post_even(p, j, smem, bid, nb); else phase_post_odd(p, j, bid, nb);
          break;
        case 6:
          do_gemm = true; A = p.hm; lda = even ? 1536 : 1024; Bt = p.wb_out; K = lda; ntn = 4; epi = 2;
          gate = p.mod + (size_t)L * 10 * 6144 + 2048;
          break;
        case 7:
          phase_norm(p, L, 1, bid, nb);
          break;
        case 8:
          do_gemm = true; A = p.hm; lda = 1024; Bt = p.wb_gu; K = 1024; ntn = 22; epi = 1;
          outb = p.pbuf; ldo = 2816; ncols = 2816;
          break;
        default:
          do_gemm = true; A = p.pbuf; lda = 2816; Bt = p.wb_dn; K = 2816; ntn = 4; epi = 2;
          gate = p.mod + (size_t)L * 10 * 6144 + 5120;
          break;
      }
      if (do_gemm) gemm_phase(p, A, lda, Bt, K, ntn, epi, outb, ldo, ncols, gate, smem, bid, nb);
      }
    }
    if (multi && ph + 1 < ph1) xcd_barrier(xb);
  }
}

extern "C" void kernel_launch(void* const* d_in, const int* in_sizes, int n_in, void* d_out, int out_size, void* d_ws,
                              size_t ws_size, hipStream_t stream) {
  static int grid_blocks = 0;
  if (!grid_blocks) {
    int dev = 0, cus = 0, per_cu = 0;
    hipGetDevice(&dev);
    hipDeviceGetAttribute(&cus, hipDeviceAttributeMultiprocessorCount, dev);
    hipOccupancyMaxActiveBlocksPerMultiprocessor(&per_cu, mega, 256, 0);
    if (per_cu > 2) per_cu = 2;
    if (per_cu < 1) per_cu = 1;
    grid_blocks = cus * per_cu;
  }
  Params p{};
  const float* const* in = (const float* const*)d_in;
  p.x_prompt = in[0]; p.x_sample = in[1]; p.st_rwkv = in[2]; p.st_shift = in[3]; p.st_ssm = in[4]; p.st_conv = in[5];
  p.st_hgrn = in[6]; p.c_prompt = in[7]; p.c_sample = in[8]; p.norm_mix_w = in[9]; p.norm_ffn_w = in[10];
  p.norm_out_w = in[11]; p.ada_w = in[12]; p.ada_b = in[13]; p.w_in_ab = in[14]; p.w_out_ab = in[15]; p.mu_a = in[16];
  p.w0 = in[17]; p.w2 = in[18]; p.a0 = in[19]; p.a2 = in[20]; p.g2 = in[21]; p.k_k = in[22]; p.k_a = in[23];
  p.r_k = in[24]; p.lnx_w = in[25]; p.lnx_b = in[26]; p.conv_w = in[27]; p.conv_b = in[28]; p.dt_bias = in[29];
  p.a_log = in[30]; p.d_skip = in[31]; p.norm_b_w = in[32]; p.w_in_c = in[33]; p.w_out_c = in[34]; p.lb_param = in[35];
  p.norm_c_w = in[36]; p.w_gate = in[37]; p.w_up = in[38]; p.w_down = in[39];
  p.out = (float*)d_out;
  char* ws = (char*)d_ws;
  size_t off = 0;
  auto take = [&](size_t bytes) { char* r = ws + off; off += (bytes + 255) & ~(size_t)255; return r; };
  p.bar = (unsigned*)take(16384);
  p.mod = (float*)take((size_t)4 * 10 * 6144 * 4);
  p.bonus = (float*)take((size_t)NT * 8 * 4);
  p.dtb = (float*)take((size_t)NT * 32 * 4);
  p.wb_in = (u16*)take((size_t)4480 * 1024 * 2);
  p.wb_out = (u16*)take((size_t)1024 * 1536 * 2);
  p.wb_gu = (u16*)take((size_t)5632 * 1024 * 2);
  p.wb_dn = (u16*)take((size_t)1024 * 2816 * 2);
  p.hm = (u16*)take((size_t)NT * 1536 * 2);
  p.pbuf = (u16*)take((size_t)NT * PSTR * 2);
  p.rw = (u16*)take((size_t)NT * 8 * 16 * 24 * 2);
  p.cv = (u16*)take((size_t)NT * 1536 * 2);
  p.scr = (float*)take((size_t)12 * 1024 * 1024);
  p.ub = (u16*)take((size_t)NT * 512 * 2);
  p.w2t = (u16*)take((size_t)512 * 64 * 2);
  p.a2t = (u16*)take((size_t)512 * 64 * 2);
  p.g2t = (u16*)take((size_t)512 * 128 * 2);
#if 1
  p.p0 = 0; p.p1 = NPHASE;
  hipMemsetAsync(p.bar, 0, 16384, stream);
  void* args[] = {&p};
  hipError_t e = hipLaunchCooperativeKernel((void*)mega, dim3(grid_blocks), dim3(256), args, 0, stream);
  if (e != hipSuccess) fprintf(stderr, "cooperative launch failed: %s (grid %d)\n", hipGetErrorString(e), grid_blocks);
#else
  for (int ph = 0; ph < NPHASE; ph++) {
    p.p0 = ph; p.p1 = ph + 1;
    mega<<<dim3(grid_blocks), dim3(256), 0, stream>>>(p);
  }
#endif
}
```

```cpp
#include <hip/hip_runtime.h>
#include <hip/hip_cooperative_groups.h>
#include <cstdio>
namespace cg = cooperative_groups;

typedef unsigned short u16;
typedef __attribute__((ext_vector_type(8))) short bf16x8;
typedef __attribute__((ext_vector_type(4))) float f32x4;

#define NT 16512
#define PSTR 4480

#define O_RWKV_P 16908288ull
#define O_SHIFT_P 17039360ull
#define O_SSM_P 17046528ull
#define O_CONV_P 17570816ull
#define O_HGRN_P 17589248ull
#define O_RWKV_S 18113536ull
#define O_SHIFT_S 18637824ull
#define O_SSM_S 18666496ull
#define O_CONV_S 20763648ull
#define O_HGRN_S 20837376ull

struct Params {
  const float *x_prompt, *x_sample, *st_rwkv, *st_shift, *st_ssm, *st_conv, *st_hgrn, *c_prompt, *c_sample;
  const float *norm_mix_w, *norm_ffn_w, *norm_out_w, *ada_w, *ada_b, *w_in_ab, *w_out_ab, *mu_a, *w0, *w2, *a0, *a2,
      *g2, *k_k, *k_a, *r_k, *lnx_w, *lnx_b, *conv_w, *conv_b, *dt_bias, *a_log, *d_skip, *norm_b_w, *w_in_c,
      *w_out_c, *lb_param, *norm_c_w, *w_gate, *w_up, *w_down;
  float* out;
  float *mod, *bonus, *dtb;
  u16 *wb_in, *wb_out, *wb_gu, *wb_dn, *hm, *pbuf, *rw, *cv;
  float* scr;
  u16* ub;
  u16 *w2t, *a2t, *g2t;
  unsigned* bar;
  int p0, p1;
};

typedef const __attribute__((address_space(4))) Params& CP;
typedef const __attribute__((address_space(4))) Params* CPP;
__device__ __forceinline__ CPP getp() {
  CPP pp = (CPP)__builtin_amdgcn_kernarg_segment_ptr();
  asm volatile("" : "+s"(pp) : : "memory");
  return pp;
}
__device__ __forceinline__ int otid() {
  int t = threadIdx.x;
  asm volatile("" : "+v"(t));
  return t;
}
__device__ __forceinline__ float bf2f(u16 u) { return __uint_as_float(((unsigned)u) << 16); }
typedef float f32x2_t __attribute__((ext_vector_type(2)));
typedef __bf16 bf16x2_t __attribute__((ext_vector_type(2)));
__device__ __forceinline__ unsigned pack2(float a, float b) {
  f32x2_t v = {a, b};
  bf16x2_t r = __builtin_convertvector(v, bf16x2_t);
  return __builtin_bit_cast(unsigned, r);
}
__device__ __forceinline__ u16 f2bf(float f) { return (u16)(pack2(f, f) & 0xffffu); }
__device__ __forceinline__ float lo16(unsigned v) { return __uint_as_float(v << 16); }
__device__ __forceinline__ float hi16(unsigned v) { return __uint_as_float(v & 0xffff0000u); }
__device__ __forceinline__ float sigm(float x) { return __builtin_amdgcn_rcpf(1.f + __expf(-x)); }
__device__ __forceinline__ float silu_(float x) { return x * __builtin_amdgcn_rcpf(1.f + __expf(-x)); }
__device__ __forceinline__ float softplus_(float x) {
  const float e = __expf(x);
  return x > 20.f ? x : (e < 1e-4f ? e * (1.f - 0.5f * e) : __logf(1.f + e));
}
__device__ __forceinline__ float tanh_(float x) { return 1.f - 2.f * __builtin_amdgcn_rcpf(1.f + __expf(2.f * x)); }

__device__ __forceinline__ int row_seq(int m) { return m < 16384 ? (m >> 13) : 2 + ((m - 16384) >> 4); }
__device__ __forceinline__ int seq_row0(int s) { return s < 2 ? s * 8192 : 16384 + (s - 2) * 16; }
__device__ __forceinline__ int seq_len(int s) { return s < 2 ? 8192 : 16; }
__device__ __forceinline__ float* out_state(float* out, int s, int j, size_t baseP, size_t baseS, size_t sz) {
  return s < 2 ? out + baseP + (size_t)(s * 2 + j) * sz : out + baseS + (size_t)((s - 2) * 2 + j) * sz;
}

template <int CTRL>
__device__ __forceinline__ float dpp_f(float x) {
  return __int_as_float(__builtin_amdgcn_update_dpp(0, __float_as_int(x), CTRL, 0xf, 0xf, false));
}
__device__ __forceinline__ float red16(float x) {
  x += dpp_f<0xB1>(x);
  x += dpp_f<0x4E>(x);
  x += dpp_f<0x124>(x);
  x += dpp_f<0x128>(x);
  return x;
}
__device__ __forceinline__ float red32_hi(float x) {
  x = red16(x);
  float y = __int_as_float(__builtin_amdgcn_update_dpp(0, __float_as_int(x), 0x142, 0xA, 0xf, false));
  return x + y;
}
__device__ __forceinline__ float wave_sum(float x) {
  x = red16(x);
  x += __int_as_float(__builtin_amdgcn_update_dpp(0, __float_as_int(x), 0x142, 0xA, 0xf, false));
  x += __int_as_float(__builtin_amdgcn_update_dpp(0, __float_as_int(x), 0x143, 0xC, 0xf, false));
  return __int_as_float(__builtin_amdgcn_readlane(__float_as_int(x), 63));
}

__device__ void phase_mod(CP p, char* smem, int bid, int nb) {
  if (bid >= 384) return;
  float* sc = (float*)smem;
  float* red = sc + 10 * 1024;
  const int tid = otid(), lane = tid & 63, wv = tid >> 6;
  for (int i = tid; i < 10 * 1024; i += 256) {
    int s = i >> 10, k = i & 1023;
    float c = s < 2 ? p.c_prompt[s * 1024 + k] : p.c_sample[(s - 2) * 1024 + k];
    sc[i] = silu_(c);
  }
  __syncthreads();
  for (int u = bid; u < 384; u += nb) {
    int L = u / 96, cgp = u % 96;
    int col = cgp * 64 + lane;
    const float* W = p.ada_w + (size_t)L * 1024 * 6144 + col;
    float acc[10];
#pragma unroll
    for (int s = 0; s < 10; s++) acc[s] = 0.f;
    int k0 = wv * 256;
#pragma unroll 4
    for (int k = k0; k < k0 + 256; k += 4) {
      float w0 = W[(size_t)k * 6144], w1 = W[(size_t)(k + 1) * 6144], w2 = W[(size_t)(k + 2) * 6144],
            w3 = W[(size_t)(k + 3) * 6144];
#pragma unroll
      for (int s = 0; s < 10; s++) {
        float4 c4 = *(const float4*)&sc[s * 1024 + k];
        acc[s] += c4.x * w0 + c4.y * w1 + c4.z * w2 + c4.w * w3;
      }
    }
#pragma unroll
    for (int s = 0; s < 10; s++) red[(wv * 10 + s) * 64 + lane] = acc[s];
    __syncthreads();
    for (int i = tid; i < 640; i += 256) {
      int s = i >> 6, l = i & 63;
      float v = red[(0 * 10 + s) * 64 + l] + red[(1 * 10 + s) * 64 + l] + red[(2 * 10 + s) * 64 + l] +
                red[(3 * 10 + s) * 64 + l];
      int c = cgp * 64 + l;
      p.mod[((size_t)L * 10 + s) * 6144 + c] = v + p.ada_b[L * 6144 + c];
    }
    __syncthreads();
  }
}

__device__ __forceinline__ void wconv_tile(const float* __restrict__ src, int K, int N, u16* __restrict__ dst, int k0,
                                           int n0, int mode, float* tile) {
  const int tid = otid();
#pragma unroll
  for (int i = 0; i < 4; i++) {
    int r = i * 16 + (tid >> 4), c = (tid & 15) * 4;
    int n = n0 + c;
    float4 v4 = n < N ? *(const float4*)(src + (size_t)(k0 + r) * N + n) : make_float4(0.f, 0.f, 0.f, 0.f);
    tile[r * 65 + c] = v4.x; tile[r * 65 + c + 1] = v4.y; tile[r * 65 + c + 2] = v4.z; tile[r * 65 + c + 3] = v4.w;
  }
  __syncthreads();
  int n = tid >> 2, kc = (tid & 3) * 16;
  unsigned pk[8];
#pragma unroll
  for (int i = 0; i < 8; i++) pk[i] = pack2(tile[(kc + 2 * i) * 65 + n], tile[(kc + 2 * i + 1) * 65 + n]);
  int gn = n0 + n;
  int row = mode == 0 ? gn : ((gn >> 4) * 32 + (gn & 15) + (mode == 2 ? 16 : 0));
  uint4* d = (uint4*)(dst + (size_t)row * K + k0 + kc);
  d[0] = make_uint4(pk[0], pk[1], pk[2], pk[3]);
  d[1] = make_uint4(pk[4], pk[5], pk[6], pk[7]);
  __syncthreads();
}

__device__ void phase_wconv(CP p, int L, char* smem, int bid, int nb) {
  float* tile = (float*)smem;
  const int j = L >> 1;
  const bool even = (L & 1) == 0;
  const int ntn_in = even ? 70 : 64;
  const int n_in = 16 * ntn_in;
  const int n_out = even ? 24 * 16 : 16 * 16;
  const int n_g = 16 * 44;
  const int n_lora = even ? 32 : 0;
  const int total = n_in + n_out + 3 * n_g + n_lora;
  for (int u = bid; u < total; u += nb) {
    int li = u;
    if (li < n_in) {
      int kt = li / ntn_in, nt = li % ntn_in;
      if (even)
        wconv_tile(p.w_in_ab + (size_t)j * 1024 * 4368, 1024, 4368, p.wb_in, kt * 64, nt * 64, 0, tile);
      else
        wconv_tile(p.w_in_c + (size_t)j * 1024 * 4096, 1024, 4096, p.wb_in, kt * 64, nt * 64, 0, tile);
      continue;
    }
    li -= n_in;
    if (li < n_out) {
      int kt = li / 16, nt = li % 16;
      if (even)
        wconv_tile(p.w_out_ab + (size_t)j * 1536 * 1024, 1536, 1024, p.wb_out, kt * 64, nt * 64, 0, tile);
      else
        wconv_tile(p.w_out_c + (size_t)j * 1024 * 1024, 1024, 1024, p.wb_out, kt * 64, nt * 64, 0, tile);
      continue;
    }
    li -= n_out;
    if (li < n_g) {
      int kt = li / 44, nt = li % 44;
      wconv_tile(p.w_gate + (size_t)L * 1024 * 2816, 1024, 2816, p.wb_gu, kt * 64, nt * 64, 1, tile);
      continue;
    }
    li -= n_g;
    if (li < n_g) {
      int kt = li / 44, nt = li % 44;
      wconv_tile(p.w_up + (size_t)L * 1024 * 2816, 1024, 2816, p.wb_gu, kt * 64, nt * 64, 2, tile);
      continue;
    }
    li -= n_g;
    if (li < n_g) {
      int kt = li / 16, nt = li % 16;
      wconv_tile(p.w_down + (size_t)L * 2816 * 1024, 2816, 1024, p.wb_dn, kt * 64, nt * 64, 0, tile);
      continue;
    }
    li -= n_g;
    if (li < 8) wconv_tile(p.w2 + (size_t)j * 64 * 512, 64, 512, p.w2t, 0, li * 64, 0, tile);
    else if (li < 16) wconv_tile(p.a2 + (size_t)j * 64 * 512, 64, 512, p.a2t, 0, (li - 8) * 64, 0, tile);
    else wconv_tile(p.g2 + (size_t)j * 128 * 512, 128, 512, p.g2t, ((li - 16) >> 3) * 64, ((li - 16) & 7) * 64, 0, tile);
  }
}

__device__ void phase_norm(CP p, int L, int which, int bid, int nb) {
  const int tid = otid(), lane = tid & 63, wv = tid >> 6;
  const bool first = (L == 0 && which == 0);
  const float* nw = (which ? p.norm_ffn_w : p.norm_mix_w) + L * 1024;
  float* X = p.out;
  for (int row = bid * 4 + wv; row < NT; row += nb * 4) {
    const float* x = first ? (row < 16384 ? p.x_prompt + (size_t)row * 1024 : p.x_sample + (size_t)(row - 16384) * 1024)
                           : X + (size_t)row * 1024;
    float4 v[4];
    float ss = 0.f;
#pragma unroll
    for (int i = 0; i < 4; i++) {
      v[i] = *(const float4*)(x + i * 256 + lane * 4);
      ss += v[i].x * v[i].x + v[i].y * v[i].y + v[i].z * v[i].z + v[i].w * v[i].w;
    }
    ss = wave_sum(ss);
    float rstd = rsqrtf(ss * (1.f / 1024.f) + 1e-6f);
    int s = row_seq(row);
    const float* md = p.mod + ((size_t)L * 10 + s) * 6144 + (which ? 3072 : 0);
#pragma unroll
    for (int i = 0; i < 4; i++) {
      int c = i * 256 + lane * 4;
      float4 w4 = *(const float4*)(nw + c);
      float4 sh = *(const float4*)(md + c);
      float4 sc = *(const float4*)(md + 1024 + c);
      float h0 = v[i].x * rstd * w4.x * (1.f + sc.x) + sh.x;
      float h1 = v[i].y * rstd * w4.y * (1.f + sc.y) + sh.y;
      float h2 = v[i].z * rstd * w4.z * (1.f + sc.z) + sh.z;
      float h3 = v[i].w * rstd * w4.w * (1.f + sc.w) + sh.w;
      *(uint2*)(p.hm + (size_t)row * 1024 + c) = make_uint2(pack2(h0, h1), pack2(h2, h3));
      if (first) *(float4*)(X + (size_t)row * 1024 + c) = v[i];
    }
  }
}

__device__ void phase_final(CP p, int bid, int nb) {
  const int tid = otid(), lane = tid & 63, wv = tid >> 6;
  float* X = p.out;
  for (int row = bid * 4 + wv; row < NT; row += nb * 4) {
    float* x = X + (size_t)row * 1024;
    float4 v[4];
    float ss = 0.f;
#pragma unroll
    for (int i = 0; i < 4; i++) {
      v[i] = *(const float4*)(x + i * 256 + lane * 4);
      ss += v[i].x * v[i].x + v[i].y * v[i].y + v[i].z * v[i].z + v[i].w * v[i].w;
    }
    ss = wave_sum(ss);
    float rstd = rsqrtf(ss * (1.f / 1024.f) + 1e-6f);
#pragma unroll
    for (int i = 0; i < 4; i++) {
      int c = i * 256 + lane * 4;
      float4 w4 = *(const float4*)(p.norm_out_w + c);
      float4 o;
      o.x = v[i].x * rstd * w4.x;
      o.y = v[i].y * rstd * w4.y;
      o.z = v[i].z * rstd * w4.z;
      o.w = v[i].w * rstd * w4.w;
      *(float4*)(x + c) = o;
    }
  }
}

__device__ void gemm_phase(CP p, const u16* __restrict__ A, int lda, const u16* __restrict__ Bt, int K,
                           int ntn, int epi, u16* __restrict__ outb, int ldo, int ncols, const float* __restrict__ gate,
                           char* smem, int bid, int nb) {
  u16* As = (u16*)smem;
  u16* Bs = As + 128 * 64;
  const int tid = otid(), lane = tid & 63, wv = tid >> 6;
  const int wm = wv >> 1, wn = wv & 1;
  const int lr = tid >> 3, lc = tid & 7;
  const int l15 = lane & 15, lq = lane >> 4;
  const int nk = K >> 6;
  const int nitems = (epi == 2) ? 128 * ntn + 8 * ntn : 129 * ntn;
#define G_DECODE(tile_, mt_, nt_, kt0_, kt1_, split_) { \
    kt0_ = 0; kt1_ = nk; split_ = false; \
    if (epi == 2 && (tile_) >= 128 * ntn) { \
      const int r_ = (tile_) - 128 * ntn; \
      mt_ = 128; nt_ = r_ >> 3; split_ = true; \
      kt0_ = ((r_ & 7) * nk) >> 3; kt1_ = (((r_ & 7) + 1) * nk) >> 3; \
    } else if (epi == 2 && nb == 512 && ntn == 4) { \
        \
      const int slot_ = (tile_) >> 3; \
      mt_ = ((tile_) & 7) * 16 + (slot_ >> 2); nt_ = slot_ & 3; \
    } else { mt_ = (tile_) / ntn; nt_ = (tile_) % ntn; } }
  uint4 ra0, ra1, ra2, ra3, rb0, rb1, rb2, rb3, rb4, rb5, rb6, rb7;
  const int voA = lr * lda + lc * 8, voB = lr * K + lc * 8;
  const int sA = 32 * lda, sB = 32 * K;
#define G_BL(rs_, vo_, so_) __builtin_bit_cast(uint4, __builtin_amdgcn_raw_buffer_load_b128(rs_, vo_, so_, 0))
#define G_LOADP(ab_, bb_, kt_) { \
    __amdgpu_buffer_rsrc_t ra_ = __builtin_amdgcn_make_buffer_rsrc((void*)(ab_), 0, 0x7ffffff0, 0x00020000); \
    __amdgpu_buffer_rsrc_t rb_ = __builtin_amdgcn_make_buffer_rsrc((void*)(bb_), 0, 0x7ffffff0, 0x00020000); \
    const int ka_ = (kt_) * 128; \
    ra0 = G_BL(ra_, voA * 2, ka_); ra1 = G_BL(ra_, voA * 2, ka_ + 2 * sA); ra2 = G_BL(ra_, voA * 2, ka_ + 4 * sA); ra3 = G_BL(ra_, voA * 2, ka_ + 6 * sA); \
    rb0 = G_BL(rb_, voB * 2, ka_); rb1 = G_BL(rb_, voB * 2, ka_ + 2 * sB); rb2 = G_BL(rb_, voB * 2, ka_ + 4 * sB); rb3 = G_BL(rb_, voB * 2, ka_ + 6 * sB); \
    rb4 = G_BL(rb_, voB * 2, ka_ + 8 * sB); rb5 = G_BL(rb_, voB * 2, ka_ + 10 * sB); rb6 = G_BL(rb_, voB * 2, ka_ + 12 * sB); rb7 = G_BL(rb_, voB * 2, ka_ + 14 * sB); }
  bool have = false;
  for (int tile = bid; tile < nitems; tile += nb) {
    int mt, nt, kt0, kt1;
    bool split;
    G_DECODE(tile, mt, nt, kt0, kt1, split)
    const int m0 = mt * 128, n0 = nt * 256;
    f32x4 acc0[4][4], acc1[4][4];
#pragma unroll
    for (int a = 0; a < 4; a++)
#pragma unroll
      for (int b = 0; b < 4; b++) { acc0[a][b] = (f32x4){0.f, 0.f, 0.f, 0.f}; acc1[a][b] = (f32x4){0.f, 0.f, 0.f, 0.f}; }
    const u16* Ab = A + (size_t)m0 * lda;
    const u16* Bb = Bt + (size_t)n0 * K;
    u16* Aw = As + lr * 64 + ((lc ^ (lr & 7)) * 8);
    u16* Bw = Bs + lr * 64 + ((lc ^ (lr & 7)) * 8);
    if (!have) G_LOADP(Ab, Bb, kt0)
    for (int kt = kt0; kt < kt1; kt++) {
      __syncthreads();
      *(uint4*)(Aw) = ra0; *(uint4*)(Aw + 32 * 64) = ra1; *(uint4*)(Aw + 64 * 64) = ra2; *(uint4*)(Aw + 96 * 64) = ra3;
      *(uint4*)(Bw) = rb0; *(uint4*)(Bw + 32 * 64) = rb1; *(uint4*)(Bw + 64 * 64) = rb2; *(uint4*)(Bw + 96 * 64) = rb3;
      *(uint4*)(Bw + 128 * 64) = rb4; *(uint4*)(Bw + 160 * 64) = rb5; *(uint4*)(Bw + 192 * 64) = rb6; *(uint4*)(Bw + 224 * 64) = rb7;
      __syncthreads();
      if (kt + 1 < kt1) G_LOADP(Ab, Bb, kt + 1)
      {
        const int sw0 = (lq ^ (l15 & 7)) * 8, sw1 = ((lq + 4) ^ (l15 & 7)) * 8;
        __builtin_amdgcn_s_setprio(1);
        const u16* Ar = As + (wm * 64 + l15) * 64;
        const u16* Br = Bs + (wn * 128 + l15) * 64;
        bf16x8 af0[4];
#pragma unroll
        for (int mi = 0; mi < 4; mi++) af0[mi] = *(const bf16x8*)(Ar + mi * 16 * 64 + sw0);
        bf16x8 bq0 = *(const bf16x8*)(Br + sw0);
        bf16x8 bq1 = *(const bf16x8*)(Br + 16 * 64 + sw0);
        __builtin_amdgcn_sched_barrier(0);
#define G_STEP(ACC, nidx, bcur, nextni, nextsw, donext) { \
          bf16x8 bn_ = bcur; \
          if (donext) bcur = *(const bf16x8*)(Br + (nextni) * 16 * 64 + (nextsw)); \
          _Pragma("unroll") for (int mi = 0; mi < 4; mi++) \
            ACC[mi][nidx] = __builtin_amdgcn_mfma_f32_16x16x32_bf16(af0[mi], bn_, ACC[mi][nidx], 0, 0, 0); \
          __builtin_amdgcn_sched_barrier(0); }
        G_STEP(acc0, 0, bq0, 2, sw0, true)
        G_STEP(acc0, 1, bq1, 3, sw0, true)
        G_STEP(acc0, 2, bq0, 4, sw0, true)
        G_STEP(acc0, 3, bq1, 5, sw0, true)
        G_STEP(acc1, 0, bq0, 6, sw0, true)
        G_STEP(acc1, 1, bq1, 7, sw0, true)
        G_STEP(acc1, 2, bq0, 0, sw1, true)
        G_STEP(acc1, 3, bq1, 1, sw1, true)
#pragma unroll
        for (int mi = 0; mi < 4; mi++) af0[mi] = *(const bf16x8*)(Ar + mi * 16 * 64 + sw1);
        __builtin_amdgcn_sched_barrier(0);
        G_STEP(acc0, 0, bq0, 2, sw1, true)
        G_STEP(acc0, 1, bq1, 3, sw1, true)
        G_STEP(acc0, 2, bq0, 4, sw1, true)
        G_STEP(acc0, 3, bq1, 5, sw1, true)
        G_STEP(acc1, 0, bq0, 6, sw1, true)
        G_STEP(acc1, 1, bq1, 7, sw1, true)
        G_STEP(acc1, 2, bq0, 0, 0, false)
        G_STEP(acc1, 3, bq1, 0, 0, false)
        __builtin_amdgcn_s_setprio(0);
      }
    }
    {
      const int ntile = tile + nb;
      have = ntile < nitems;
      if (have) {
        int mt2, nt2, k0n, k1n; bool sp2;
        G_DECODE(ntile, mt2, nt2, k0n, k1n, sp2)
        (void)k1n; (void)sp2;
        G_LOADP(A + (size_t)(mt2 * 128) * lda, Bt + (size_t)(nt2 * 256) * K, k0n)
      }
    }
    if (epi == 2) {
#pragma unroll
      for (int mi = 0; mi < 4; mi++)
#pragma unroll
        for (int jj = 0; jj < 4; jj++) {
          int row = m0 + wm * 64 + mi * 16 + lq * 4 + jj;
          int s = row_seq(row);
          const float* g = gate + (size_t)s * 6144;
          float* xr = p.out + (size_t)row * 1024;
#pragma unroll
          for (int ni = 0; ni < 4; ni++) {
            int col = n0 + wn * 128 + ni * 16 + l15;
            if (split) { atomicAdd(&xr[col], g[col] * acc0[mi][ni][jj]); atomicAdd(&xr[col + 64], g[col + 64] * acc1[mi][ni][jj]); }
            else { xr[col] += g[col] * acc0[mi][ni][jj]; xr[col + 64] += g[col + 64] * acc1[mi][ni][jj]; }
          }
        }
    } else if (epi == 0) {
      u16* Cs = (u16*)smem;
#define EPI0_HALF(hp, ACC) { \
        __syncthreads(); \
        _Pragma("unroll") for (int mi = 0; mi < 4; mi++) \
          _Pragma("unroll") for (int n4 = 0; n4 < 4; n4++) \
            _Pragma("unroll") for (int jj = 0; jj < 4; jj++) { \
              int r = wm * 64 + mi * 16 + lq * 4 + jj, c = wn * 64 + n4 * 16 + l15; \
              Cs[r * 136 + c] = f2bf(ACC[mi][n4][jj]); } \
        __syncthreads(); \
        _Pragma("unroll") for (int i = 0; i < 8; i++) { \
          int q = tid + 256 * i; \
          int r = q >> 4, ch = q & 15; \
          int gcol = n0 + (ch >> 3) * 128 + (hp) * 64 + (ch & 7) * 8; \
          if (gcol < ncols) *(uint4*)(outb + (size_t)(m0 + r) * ldo + gcol) = *(const uint4*)(Cs + r * 136 + ch * 8); } }
      EPI0_HALF(0, acc0)
      EPI0_HALF(1, acc1)
    } else {
      __syncthreads();
      u16* Cs = (u16*)smem;
#pragma unroll
      for (int mi = 0; mi < 4; mi++)
#pragma unroll
        for (int i2 = 0; i2 < 2; i2++)
#pragma unroll
          for (int jj = 0; jj < 4; jj++) {
            int r = wm * 64 + mi * 16 + lq * 4 + jj, c = wn * 64 + i2 * 16 + l15;
            float g0 = acc0[mi][2 * i2][jj], u0 = acc0[mi][2 * i2 + 1][jj];
            float g1 = acc1[mi][2 * i2][jj], u1 = acc1[mi][2 * i2 + 1][jj];
            Cs[r * 136 + c] = f2bf(silu_(g0) * u0);
            Cs[r * 136 + c + 32] = f2bf(silu_(g1) * u1);
          }
      __syncthreads();
#pragma unroll
      for (int i = 0; i < 8; i++) {
        int q = tid + 256 * i;
        int r = q >> 4, ch = q & 15;
        *(uint4*)(outb + (size_t)(m0 + r) * ldo + nt * 128 + ch * 8) = *(const uint4*)(Cs + r * 136 + ch * 8);
      }
    }
  }
}

__device__ void phase_prep_even(CP p, int j, char* smem, int bid, int nb) {
  const int tid = otid();
  const u16* P = p.pbuf;
  {
    u16* txb = (u16*)smem;
    u16* xab = txb + 16 * 72;
    float* resw = (float*)(xab + 16 * 72);
    float* resa = resw + 8 * 512;
    for (int i = tid; i < 2 * 16 * 72; i += 256) txb[i] = 0;
    const int half = tid >> 7, hk = tid & 127, h = hk >> 4, kq = hk & 15;
    const int c4 = h * 64 + kq * 4;
    const float* mu = p.mu_a + j * 1792;
    for (int u = bid; u < NT / 8; u += nb) {
      const int m0 = u * 8;
      const int s = row_seq(m0);
      const int r0 = seq_row0(s);
      __syncthreads();
#pragma unroll
      for (int i = 0; i < 4; i++) {
        int idx = tid + 256 * i;
        int tok = idx >> 7, cc = idx & 127;
        int m = m0 + tok;
        int col = 1536 + cc;
        float pc = bf2f(P[(size_t)m * PSTR + col]);
        float pp = (m > r0) ? bf2f(P[(size_t)(m - 1) * PSTR + col])
                            : (s >= 2 ? p.st_shift[((size_t)(s - 2) * 2 + j) * 1792 + col] : 0.f);
        float pm = pc + (pp - pc) * mu[col];
        if (cc < 64)
          txb[tok * 72 + cc] = f2bf(tanh_(pm));
        else
          xab[tok * 72 + cc - 64] = f2bf(pm);
      }
      __syncthreads();
      {
        const int lane = tid & 63, wv = tid >> 6, l15 = lane & 15, lq = lane >> 4;
        bf16x8 aw[2], aa[2];
#pragma unroll
        for (int ks = 0; ks < 2; ks++) {
          aw[ks] = *(const bf16x8*)(txb + l15 * 72 + ks * 32 + lq * 8);
          aa[ks] = *(const bf16x8*)(xab + l15 * 72 + ks * 32 + lq * 8);
        }
#pragma unroll
        for (int nt = 0; nt < 8; nt++) {
          const int n = wv * 128 + nt * 16 + l15;
          f32x4 cw = (f32x4){0.f, 0.f, 0.f, 0.f}, ca = (f32x4){0.f, 0.f, 0.f, 0.f};
#pragma unroll
          for (int ks = 0; ks < 2; ks++) {
            bf16x8 bw = *(const bf16x8*)(p.w2t + (size_t)n * 64 + ks * 32 + lq * 8);
            bf16x8 ba = *(const bf16x8*)(p.a2t + (size_t)n * 64 + ks * 32 + lq * 8);
            cw = __builtin_amdgcn_mfma_f32_16x16x32_bf16(aw[ks], bw, cw, 0, 0, 0);
            ca = __builtin_amdgcn_mfma_f32_16x16x32_bf16(aa[ks], ba, ca, 0, 0, 0);
          }
          if (lq < 2) {
#pragma unroll
            for (int jj = 0; jj < 4; jj++) {
              resw[(lq * 4 + jj) * 512 + n] = cw[jj];
              resa[(lq * 4 + jj) * 512 + n] = ca[jj];
            }
          }
        }
      }
      __syncthreads();
      float accw[4][4], acca[4][4];
#pragma unroll
      for (int tk = 0; tk < 4; tk++) {
        float4 rw4 = *(const float4*)(resw + (half * 4 + tk) * 512 + c4);
        float4 ra4 = *(const float4*)(resa + (half * 4 + tk) * 512 + c4);
        accw[tk][0] = rw4.x; accw[tk][1] = rw4.y; accw[tk][2] = rw4.z; accw[tk][3] = rw4.w;
        acca[tk][0] = ra4.x; acca[tk][1] = ra4.y; acca[tk][2] = ra4.z; acca[tk][3] = ra4.w;
      }
      float4 w0v = *(const float4*)(p.w0 + j * 512 + c4);
      float4 a0v = *(const float4*)(p.a0 + j * 512 + c4);
      float4 kkv = *(const float4*)(p.k_k + j * 512 + c4);
      float4 kav = *(const float4*)(p.k_a + j * 512 + c4);
      float4 rkv = *(const float4*)(p.r_k + j * 512 + c4);
      float4 mur = *(const float4*)(mu + c4);
      float4 muk = *(const float4*)(mu + 512 + c4);
      float4 muv = *(const float4*)(mu + 1024 + c4);
      const float w0a[4] = {w0v.x, w0v.y, w0v.z, w0v.w};
      const float a0a[4] = {a0v.x, a0v.y, a0v.z, a0v.w};
      const float kka[4] = {kkv.x, kkv.y, kkv.z, kkv.w};
      const float kaa[4] = {kav.x, kav.y, kav.z, kav.w};
      const float rka[4] = {rkv.x, rkv.y, rkv.z, rkv.w};
      const float mura[4] = {mur.x, mur.y, mur.z, mur.w};
      const float muka[4] = {muk.x, muk.y, muk.z, muk.w};
      const float muva[4] = {muv.x, muv.y, muv.z, muv.w};
#pragma unroll
      for (int tk = 0; tk < 4; tk++) {
        const int m = m0 + half * 4 + tk;
        uint2 pr = *(const uint2*)(P + (size_t)m * PSTR + c4);
        uint2 pk = *(const uint2*)(P + (size_t)m * PSTR + 512 + c4);
        uint2 pv = *(const uint2*)(P + (size_t)m * PSTR + 1024 + c4);
        float rc[4] = {lo16(pr.x), hi16(pr.x), lo16(pr.y), hi16(pr.y)};
        float kc[4] = {lo16(pk.x), hi16(pk.x), lo16(pk.y), hi16(pk.y)};
        float vc[4] = {lo16(pv.x), hi16(pv.x), lo16(pv.y), hi16(pv.y)};
        float rp[4], kp[4], vp[4];
        if (m > r0) {
          uint2 qr = *(const uint2*)(P + (size_t)(m - 1) * PSTR + c4);
          uint2 qk = *(const uint2*)(P + (size_t)(m - 1) * PSTR + 512 + c4);
          uint2 qv = *(const uint2*)(P + (size_t)(m - 1) * PSTR + 1024 + c4);
          rp[0] = lo16(qr.x); rp[1] = hi16(qr.x); rp[2] = lo16(qr.y); rp[3] = hi16(qr.y);
          kp[0] = lo16(qk.x); kp[1] = hi16(qk.x); kp[2] = lo16(qk.y); kp[3] = hi16(qk.y);
          vp[0] = lo16(qv.x); vp[1] = hi16(qv.x); vp[2] = lo16(qv.y); vp[3] = hi16(qv.y);
        } else if (s >= 2) {
          const float* sp = p.st_shift + ((size_t)(s - 2) * 2 + j) * 1792;
#pragma unroll
          for (int e = 0; e < 4; e++) { rp[e] = sp[c4 + e]; kp[e] = sp[512 + c4 + e]; vp[e] = sp[1024 + c4 + e]; }
        } else {
#pragma unroll
          for (int e = 0; e < 4; e++) { rp[e] = 0.f; kp[e] = 0.f; vp[e] = 0.f; }
        }
        float r[4], k[4], v[4], kk[4], kn[4], bb[4], ee[4];
        float ssq = 0.f, bsum = 0.f;
#pragma unroll
        for (int e = 0; e < 4; e++) {
          r[e] = rc[e] + (rp[e] - rc[e]) * mura[e];
          k[e] = kc[e] + (kp[e] - kc[e]) * muka[e];
          v[e] = vc[e] + (vp[e] - vc[e]) * muva[e];
          float wpre = w0a[e] + accw[tk][e];
          float w = -softplus_(-wpre) - 0.5f;
          { const float ew = __expf(w); ee[e] = ew < 1e-3f ? ew * (1.f - 0.5f * ew) : 1.f - __expf(-ew); }
          float a = sigm(a0a[e] + acca[tk][e]);
          kk[e] = k[e] * kka[e];
          ssq += kk[e] * kk[e];
          kn[e] = k[e] * (1.f + (a - 1.f) * kaa[e]);
          bb[e] = a;
          bsum += r[e] * kn[e] * rka[e];
        }
        ssq = red16(ssq);
        bsum = red16(bsum);
        float inv = rsqrtf(fmaxf(ssq, 1e-24f));
#pragma unroll
        for (int e = 0; e < 4; e++) { kk[e] *= inv; bb[e] = kk[e] * bb[e]; }
        if (kq == 0) p.bonus[(size_t)m * 8 + h] = bsum;
        uint4* dst = (uint4*)(p.rw + (((size_t)m * 8 + h) * 16 + kq) * 24);
        dst[0] = make_uint4(pack2(r[0], r[1]), pack2(r[2], r[3]), pack2(kn[0], kn[1]), pack2(kn[2], kn[3]));
        dst[1] = make_uint4(pack2(kk[0], kk[1]), pack2(kk[2], kk[3]), pack2(bb[0], bb[1]), pack2(bb[2], bb[3]));
        dst[2] = make_uint4(pack2(ee[0], ee[1]), pack2(ee[2], ee[3]), pack2(v[0], v[1]), pack2(v[2], v[3]));
      }
    }
  }
  for (int idx = bid * 256 + tid; idx < 10 * 1792; idx += nb * 256) {
    int s = idx / 1792, c = idx % 1792;
    int m = seq_row0(s) + seq_len(s) - 1;
    float* o = out_state(p.out, s, j, O_SHIFT_P, O_SHIFT_S, 1792);
    o[c] = bf2f(P[(size_t)m * PSTR + c]);
  }
  for (int u = bid; u < NT / 16; u += nb) {
    const int mb = u * 16;
    const int s = row_seq(mb);
    const int r0 = seq_row0(s);
    if (tid < 192) {
      const int c0 = tid * 8;
      const int t0 = mb - r0;
      float wgt[4][8], bia[8];
      {
        float4 b0 = *(const float4*)(p.conv_b + j * 1536 + c0), b1 = *(const float4*)(p.conv_b + j * 1536 + c0 + 4);
        bia[0] = b0.x; bia[1] = b0.y; bia[2] = b0.z; bia[3] = b0.w; bia[4] = b1.x; bia[5] = b1.y; bia[6] = b1.z; bia[7] = b1.w;
#pragma unroll
        for (int tap = 0; tap < 4; tap++) {
          const float* cw = p.conv_w + ((size_t)j * 4 + tap) * 1536 + c0;
          float4 w0 = *(const float4*)cw, w1 = *(const float4*)(cw + 4);
          wgt[tap][0] = w0.x; wgt[tap][1] = w0.y; wgt[tap][2] = w0.z; wgt[tap][3] = w0.w;
          wgt[tap][4] = w1.x; wgt[tap][5] = w1.y; wgt[tap][6] = w1.z; wgt[tap][7] = w1.w;
        }
      }
#pragma unroll 1
      for (int hf = 0; hf < 2; hf++) {
      uint4 rows[11];
#pragma unroll
      for (int i = 0; i < 11; i++) {
        const int tt = t0 + hf * 8 - 3 + i;
        if (tt >= 0) {
          rows[i] = *(const uint4*)(P + (size_t)(r0 + tt) * PSTR + 2816 + c0);
        } else if (s >= 2) {
          const float* cs = p.st_conv + (((size_t)(s - 2) * 2 + j) * 3 + (tt + 3)) * 1536 + c0;
          float4 q0 = *(const float4*)cs, q1 = *(const float4*)(cs + 4);
          rows[i] = make_uint4(pack2(q0.x, q0.y), pack2(q0.z, q0.w), pack2(q1.x, q1.y), pack2(q1.z, q1.w));
        } else {
          rows[i] = make_uint4(0, 0, 0, 0);
        }
      }
#pragma unroll
      for (int t = 0; t < 8; t++) {
        float acc[8];
#pragma unroll
        for (int e = 0; e < 8; e++) acc[e] = bia[e];
#pragma unroll
        for (int tap = 0; tap < 4; tap++) {
          const uint4 q = rows[t + tap];
          acc[0] += wgt[tap][0] * lo16(q.x); acc[1] += wgt[tap][1] * hi16(q.x);
          acc[2] += wgt[tap][2] * lo16(q.y); acc[3] += wgt[tap][3] * hi16(q.y);
          acc[4] += wgt[tap][4] * lo16(q.z); acc[5] += wgt[tap][5] * hi16(q.z);
          acc[6] += wgt[tap][6] * lo16(q.w); acc[7] += wgt[tap][7] * hi16(q.w);
        }
        *(uint4*)(p.cv + (size_t)(mb + hf * 8 + t) * 1536 + c0) =
            make_uint4(pack2(silu_(acc[0]), silu_(acc[1])), pack2(silu_(acc[2]), silu_(acc[3])),
                       pack2(silu_(acc[4]), silu_(acc[5])), pack2(silu_(acc[6]), silu_(acc[7])));
      }
      }
    }
    {
      int tok = tid >> 4, hh = tid & 15;
      int m = mb + tok;
      float dtv = softplus_(bf2f(P[(size_t)m * PSTR + 4352 + hh]) + p.dt_bias[j * 16 + hh]);
      float* cs = (float*)smem;
      __syncthreads();
      cs[tid] = -dtv * __expf(p.a_log[j * 16 + hh]);
      __syncthreads();
      float G = 0.f;
      for (int i = 0; i <= tok; i++) G += cs[i * 16 + hh];
      p.dtb[(size_t)m * 32 + hh] = dtv;
      p.dtb[(size_t)m * 32 + 16 + hh] = G;
    }
  }
  for (int idx = bid * 256 + tid; idx < 10 * 3 * 1536; idx += nb * 256) {
    int s = idx / 4608, rem = idx % 4608;
    int r = rem / 1536, c = rem % 1536;
    int m = seq_row0(s) + seq_len(s) - 3 + r;
    float* o = out_state(p.out, s, j, O_CONV_P, O_CONV_S, 4608);
    o[rem] = bf2f(P[(size_t)m * PSTR + 2816 + c]);
  }
}

__device__ __forceinline__ void cvt8_store(float* d, uint4 v) {
  *(float4*)d = make_float4(lo16(v.x), hi16(v.x), lo16(v.y), hi16(v.y));
  *(float4*)(d + 4) = make_float4(lo16(v.z), hi16(v.z), lo16(v.w), hi16(v.w));
}

#define RK_NOC 4
#define RK_BASE(p) ((p).scr + 2100000)
#define RK_LS(p) (RK_BASE(p))
#define RK_PS(p) (RK_BASE(p) + 262144)
#define RK_SI(p) (RK_BASE(p) + 524288)
template <int PART>
__device__ __forceinline__ void rwkv_scan_item(CP p, int j, int s, int h, int rg, int oc, int noc, char* smem) {
  float* Lb = (float*)smem;
  float* ob = Lb + 2 * 16 * 16 * 28;
  const int tid = otid(), lane = tid & 63, wv = tid >> 6;
  const int rl = lane >> 4, kq = lane & 15;
  const int R = rg * 16 + wv * 4 + rl;
  const int T = seq_len(s) / noc, m0 = seq_row0(s) + oc * T;
  float S[4];
  if (PART == 1) {
#pragma unroll
    for (int e = 0; e < 4; e++) S[e] = (R == kq * 4 + e) ? 1.f : 0.f;
  } else if (s >= 2) {
    float4 q = *(const float4*)(p.st_rwkv + ((((size_t)(s - 2) * 2 + j) * 8 + h) * 64 + R) * 64 + kq * 4);
    S[0] = q.x; S[1] = q.y; S[2] = q.z; S[3] = q.w;
  } else {
    S[0] = S[1] = S[2] = S[3] = 0.f;
  }
  const u16* src = p.rw + ((size_t)m0 * 8 + h) * 16 * 24;
  const int q0 = tid, q1 = tid + 256, q2 = tid + 512;
  const int so0 = (q0 / 48) * 3072 + (q0 % 48) * 8, so1 = (q1 / 48) * 3072 + (q1 % 48) * 8,
            so2 = (q2 / 48) * 3072 + (q2 % 48) * 8;
  const int do0 = ((q0 / 48) * 16 + (q0 % 48) / 3) * 28 + ((q0 % 48) % 3) * 8,
            do1 = ((q1 / 48) * 16 + (q1 % 48) / 3) * 28 + ((q1 % 48) % 3) * 8,
            do2 = ((q2 / 48) * 16 + (q2 % 48) / 3) * 28 + ((q2 % 48) % 3) * 8;
  u16* outp = PART ? p.ub + (size_t)(m0 + (tid >> 4)) * 512 + h * 64 + rg * 16 + (tid & 15)
                   : p.hm + (size_t)(m0 + (tid >> 4)) * 1536 + h * 64 + rg * 16 + (tid & 15);
  const int ostr = PART ? 16 * 512 : 16 * 1536;
  const int nbat = T >> 4;
  uint4 a0, a1, a2, c0, c1, c2;
#define RW_ISSUE(r0, r1, r2, bt) { const u16* sp_ = src + (size_t)(bt) * 16 * 3072; \
    r0 = *(const uint4*)(sp_ + so0); r1 = *(const uint4*)(sp_ + so1); r2 = *(const uint4*)(sp_ + so2); }
#define RW_STASH(r0, r1, r2, bi) { float* d_ = Lb + (bi) * (16 * 16 * 28); \
    cvt8_store(d_ + do0, r0); cvt8_store(d_ + do1, r1); cvt8_store(d_ + do2, r2); }
#define RW_COMPUTE(bt) { \
    const float* cur = Lb + ((bt) & 1) * (16 * 16 * 28); \
    float* obc = ob + ((bt) & 1) * 256; \
    float op[16]; \
    f32x2_t Sa = {S[0], S[1]}, Sb = {S[2], S[3]}; \
    _Pragma("unroll") for (int st = 0; st < 16; st++) { \
      const float* sl = cur + (st * 16 + kq) * 28; \
      float4 r4 = *(const float4*)(sl), k4 = *(const float4*)(sl + 4), kk4 = *(const float4*)(sl + 8), \
             b4 = *(const float4*)(sl + 12), e4 = *(const float4*)(sl + 16); \
      float v = PART ? 0.f : cur[(st * 16 + (R >> 2)) * 28 + 20 + (R & 3)]; \
      f32x2_t t_ = Sa * (f32x2_t){kk4.x, kk4.y}; \
      t_ = Sb * (f32x2_t){kk4.z, kk4.w} + t_; \
      const float sa = -red16(t_.x + t_.y); \
      Sa = Sa - Sa * (f32x2_t){e4.x, e4.y}; Sb = Sb - Sb * (f32x2_t){e4.z, e4.w}; \
      if (!PART) { Sa = (f32x2_t){v, v} * (f32x2_t){k4.x, k4.y} + Sa; Sb = (f32x2_t){v, v} * (f32x2_t){k4.z, k4.w} + Sb; } \
      Sa = (f32x2_t){sa, sa} * (f32x2_t){b4.x, b4.y} + Sa; Sb = (f32x2_t){sa, sa} * (f32x2_t){b4.z, b4.w} + Sb; \
      f32x2_t u_ = Sa * (f32x2_t){r4.x, r4.y}; \
      u_ = Sb * (f32x2_t){r4.z, r4.w} + u_; \
      op[st] = u_.x + u_.y; \
      if ((st & 3) == 3) __builtin_amdgcn_sched_barrier(0); \
    } \
    S[0] = Sa.x; S[1] = Sa.y; S[2] = Sb.x; S[3] = Sb.y; \
    _Pragma("unroll") for (int st = 0; st < 16; st++) op[st] = red16(op[st]); \
    if (kq == 0) { _Pragma("unroll") for (int st = 0; st < 16; st++) obc[st * 16 + wv * 4 + rl] = op[st]; } }
#define RW_OUT(bt) { outp[(size_t)(bt) * ostr] = f2bf(ob[((bt) & 1) * 256 + tid]); }
  __syncthreads();
  RW_ISSUE(a0, a1, a2, 0)
  RW_STASH(a0, a1, a2, 0)
  if (1 < nbat) RW_ISSUE(a0, a1, a2, 1)
  if (2 < nbat) RW_ISSUE(c0, c1, c2, 2)
  __syncthreads();
  for (int b = 0; b < nbat; b += 2) {
    RW_COMPUTE(b)
    if (b + 1 < nbat) RW_STASH(a0, a1, a2, 1)
    __syncthreads();
    RW_OUT(b)
    if (b + 1 >= nbat) break;
    if (b + 3 < nbat) RW_ISSUE(a0, a1, a2, b + 3)
    RW_COMPUTE(b + 1)
    if (b + 2 < nbat) RW_STASH(c0, c1, c2, 0)
    __syncthreads();
    RW_OUT(b + 1)
    if (b + 4 < nbat) RW_ISSUE(c0, c1, c2, b + 4)
  }
  if (noc == 1) {
    float* o = out_state(p.out, s, j, O_RWKV_P, O_RWKV_S, 32768);
    *(float4*)(o + ((size_t)h * 64 + R) * 64 + kq * 4) = make_float4(S[0], S[1], S[2], S[3]);
  } else {
    float* o = (PART ? RK_PS(p) : RK_LS(p)) + (size_t)((s * 8 + h) * 4 + oc) * 4096;
    *(float4*)(o + (size_t)R * 64 + kq * 4) = make_float4(S[0], S[1], S[2], S[3]);
  }
  __syncthreads();
}

__device__ __forceinline__ void rwkv_combine_item(CP p, int j, int s, int h, char* smem) {
  float* Sl = (float*)smem;
  const int tid = otid();
  const int r = tid >> 2, jq = tid & 3;
  const size_t idx0 = (size_t)(s * 8 + h) * 4;
  float cur[16];
  {
    const float* l0 = RK_LS(p) + idx0 * 4096 + r * 64 + jq * 16;
#pragma unroll
    for (int c = 0; c < 16; c++) cur[c] = l0[c];
  }
  for (int oc = 1; oc < RK_NOC; oc++) {
    float* si = RK_SI(p) + (idx0 + oc) * 4096 + r * 64 + jq * 16;
    __syncthreads();
#pragma unroll
    for (int c = 0; c < 16; c++) { si[c] = cur[c]; Sl[r * 65 + jq * 16 + c] = cur[c]; }
    __syncthreads();
    float nx[16];
    {
      const float* lo = RK_LS(p) + (idx0 + oc) * 4096 + r * 64 + jq * 16;
#pragma unroll
      for (int c = 0; c < 16; c++) nx[c] = lo[c];
    }
    const float* pm = RK_PS(p) + (idx0 + oc) * 4096 + jq * 16;
    for (int i = 0; i < 64; i++) {
      const float sv = Sl[r * 65 + i];
      const float4 p0 = *(const float4*)(pm + i * 64), p1 = *(const float4*)(pm + i * 64 + 4),
                   p2 = *(const float4*)(pm + i * 64 + 8), p3 = *(const float4*)(pm + i * 64 + 12);
      nx[0] += sv * p0.x; nx[1] += sv * p0.y; nx[2] += sv * p0.z; nx[3] += sv * p0.w;
      nx[4] += sv * p1.x; nx[5] += sv * p1.y; nx[6] += sv * p1.z; nx[7] += sv * p1.w;
      nx[8] += sv * p2.x; nx[9] += sv * p2.y; nx[10] += sv * p2.z; nx[11] += sv * p2.w;
      nx[12] += sv * p3.x; nx[13] += sv * p3.y; nx[14] += sv * p3.z; nx[15] += sv * p3.w;
    }
#pragma unroll
    for (int c = 0; c < 16; c++) cur[c] = nx[c];
  }
  float* o = out_state(p.out, s, j, O_RWKV_P, O_RWKV_S, 32768) + ((size_t)h * 64 + r) * 64 + jq * 16;
#pragma unroll
  for (int c = 0; c < 16; c++) o[c] = cur[c];
  __syncthreads();
}

typedef __attribute__((ext_vector_type(4))) short bf16x4;
#define MB_SL(p) ((p).scr)
#define MB_DD(p) ((p).scr + 256 * 8192)
#define MB_NOC 8
template <int MODE>
__device__ __forceinline__ void mamba_scan_item(CP p, int j, int s, int h, int oc, int noc, char* smem) {
  u16* Bs = (u16*)smem;
  u16* Cs = Bs + 2 * 16 * 136;
  u16* BTs = Cs + 2 * 16 * 136;
  u16* XTs = BTs + 2 * 128 * 24;
  u16* XBs = XTs + 2 * 64 * 24;
  u16* SsT = XBs + 2 * 64 * 24;
  float* Gs = (float*)(SsT + 64 * 136);
  const int tid = otid(), lane = tid & 63, wv = tid >> 6;
  const int l15 = lane & 15, lq = lane >> 4;
  const int g = h >> 3;
  const int T = seq_len(s);
  const int nch = (T >> 4) / noc;
  const int m0 = seq_row0(s) + oc * nch * 16;
  f32x4 acc[8];
#pragma unroll
  for (int nt = 0; nt < 8; nt++) acc[nt] = (f32x4){0.f, 0.f, 0.f, 0.f};
  float prodD = 1.f;
  if (MODE == 1) {
    if (s >= 2) {
      const float* sp = p.st_ssm + (((size_t)(s - 2) * 2 + j) * 16 + h) * 8192 + (size_t)(wv * 16 + lq * 4) * 128 + l15;
#pragma unroll
      for (int nt = 0; nt < 8; nt++)
        acc[nt] = (f32x4){sp[nt * 16], sp[128 + nt * 16], sp[256 + nt * 16], sp[384 + nt * 16]};
    } else {
      for (int cp = 0; cp < oc; cp++) {
        const size_t idx = (size_t)((s * 16 + h) * 8 + cp);
        const float dd = MB_DD(p)[idx];
        const float* sp = MB_SL(p) + idx * 8192 + (size_t)(wv * 16 + lq * 4) * 128 + l15;
#pragma unroll
        for (int nt = 0; nt < 8; nt++)
          acc[nt] = (f32x4){acc[nt][0] * dd + sp[nt * 16], acc[nt][1] * dd + sp[128 + nt * 16],
                            acc[nt][2] * dd + sp[256 + nt * 16], acc[nt][3] * dd + sp[384 + nt * 16]};
      }
    }
  }
  const u16* Pb = p.cv + (size_t)(m0 + (tid >> 4)) * 1536 + 1024 + g * 128 + (tid & 15) * 8;
  const u16* Px = p.cv + (size_t)(m0 + ((tid >> 3) & 15)) * 1536 + h * 64 + (tid & 7) * 8;
  const float* Pdt = p.dtb + (size_t)(m0 + ((tid >> 3) & 15)) * 32 + h;
  const float* PgL = p.dtb + (size_t)(m0 + 15) * 32 + 16 + h;
  const float* PG = p.dtb + (size_t)(m0 + (tid & 15)) * 32 + 16 + h;
  uint4 ab, ac, ax, cb, cc, cx;
  float adt = 0.f, ag = 0.f, agl = 0.f, aG = 0.f, cdt = 0.f, cg = 0.f, cgl = 0.f, cG = 0.f;
  ab = make_uint4(0, 0, 0, 0); ac = ab; ax = ab; cb = ab; cc = ab; cx = ab;
#define MM_ISSUE(rb, rc, rx, rdt, rg, rgl, rG, c) { \
    rb = *(const uint4*)(Pb + (size_t)(c) * 16 * 1536); \
    if (MODE == 1) rc = *(const uint4*)(Pb + (size_t)(c) * 16 * 1536 + 256); \
    if (tid < 128) { rx = *(const uint4*)(Px + (size_t)(c) * 16 * 1536); rdt = Pdt[(size_t)(c) * 16 * 32]; \
      rg = Pdt[(size_t)(c) * 16 * 32 + 16]; rgl = PgL[(size_t)(c) * 16 * 32]; } \
    if (tid < 16) rG = PG[(size_t)(c) * 16 * 32]; }
#define MM_T8(dst, rv, sc) { \
      dst[0 * 24] = f2bf(lo16(rv.x) * (sc)); dst[1 * 24] = f2bf(hi16(rv.x) * (sc)); dst[2 * 24] = f2bf(lo16(rv.y) * (sc)); dst[3 * 24] = f2bf(hi16(rv.y) * (sc)); \
      dst[4 * 24] = f2bf(lo16(rv.z) * (sc)); dst[5 * 24] = f2bf(hi16(rv.z) * (sc)); dst[6 * 24] = f2bf(lo16(rv.w) * (sc)); dst[7 * 24] = f2bf(hi16(rv.w) * (sc)); }
#define MM_STASH(rb, rc, rx, rdt, rg, rgl, rG, bi) { \
    if (MODE == 1) { *(uint4*)(Bs + (bi) * (16 * 136) + (tid >> 4) * 136 + (tid & 15) * 8) = rb; \
                     *(uint4*)(Cs + (bi) * (16 * 136) + (tid >> 4) * 136 + (tid & 15) * 8) = rc; } \
    { u16* bd_ = BTs + (bi) * (128 * 24) + ((tid & 15) * 8) * 24 + (tid >> 4); \
      bd_[0 * 24] = (u16)(rb.x & 0xffff); bd_[1 * 24] = (u16)(rb.x >> 16); bd_[2 * 24] = (u16)(rb.y & 0xffff); bd_[3 * 24] = (u16)(rb.y >> 16); \
      bd_[4 * 24] = (u16)(rb.z & 0xffff); bd_[5 * 24] = (u16)(rb.z >> 16); bd_[6 * 24] = (u16)(rb.w & 0xffff); bd_[7 * 24] = (u16)(rb.w >> 16); } \
    if (tid < 128) { const float sb_ = rdt * __expf(rgl - rg); \
      u16* xb_ = XBs + (bi) * (64 * 24) + ((tid & 7) * 8) * 24 + (tid >> 3); MM_T8(xb_, rx, sb_) \
      if (MODE == 1) { u16* xt_ = XTs + (bi) * (64 * 24) + ((tid & 7) * 8) * 24 + (tid >> 3); MM_T8(xt_, rx, rdt) } } \
    if (tid < 16) { Gs[(bi) * 32 + tid] = rG; if (tid == 15) Gs[(bi) * 32 + 16] = __expf(rG); } }
  __syncthreads();
  MM_ISSUE(ab, ac, ax, adt, ag, agl, aG, 0)
  MM_STASH(ab, ac, ax, adt, ag, agl, aG, 0)
  if (1 < nch) MM_ISSUE(ab, ac, ax, adt, ag, agl, aG, 1)
  if (2 < nch) MM_ISSUE(cb, cc, cx, cdt, cg, cgl, cG, 2)
  for (int c = 0; c < nch; c++) {
    const int bi = c & 1;
    if (MODE == 1) {
#pragma unroll
      for (int nt = 0; nt < 8; nt++)
#pragma unroll
        for (int jj = 0; jj < 4; jj++)
          SsT[(wv * 16 + lq * 4 + jj) * 136 + nt * 16 + l15] = f2bf(acc[nt][jj]);
    }
    __syncthreads();
    if (c + 1 < nch) {
      if (bi == 0) { MM_STASH(ab, ac, ax, adt, ag, agl, aG, 1) if (c + 3 < nch) MM_ISSUE(ab, ac, ax, adt, ag, agl, aG, c + 3) }
      else { MM_STASH(cb, cc, cx, cdt, cg, cgl, cG, 0) if (c + 3 < nch) MM_ISSUE(cb, cc, cx, cdt, cg, cgl, cG, c + 3) }
    }
    const u16* Bc = Bs + bi * (16 * 136);
    const u16* Cc = Cs + bi * (16 * 136);
    const u16* BTc = BTs + bi * (128 * 24);
    const u16* XTc = XTs + bi * (64 * 24);
    const u16* XBc = XBs + bi * (64 * 24);
    const float* Gc = Gs + bi * 32;
    if (MODE == 1) {
      f32x4 at = (f32x4){0.f, 0.f, 0.f, 0.f};
      bf16x8 cf[4];
#pragma unroll
      for (int ks = 0; ks < 4; ks++) {
        bf16x8 bfv = *(const bf16x8*)(Bc + l15 * 136 + ks * 32 + lq * 8);
        cf[ks] = *(const bf16x8*)(Cc + l15 * 136 + ks * 32 + lq * 8);
        at = __builtin_amdgcn_mfma_f32_16x16x32_bf16(bfv, cf[ks], at, 0, 0, 0);
      }
      const float Gt = Gc[l15];
      bf16x4 bat;
#pragma unroll
      for (int jj = 0; jj < 4; jj++) {
        const int sidx = lq * 4 + jj;
        bat[jj] = (short)f2bf(sidx <= l15 ? at[jj] * __expf(Gt - Gc[sidx]) : 0.f);
      }
      bf16x4 xt = *(const bf16x4*)(XTc + (wv * 16 + l15) * 24 + lq * 4);
      f32x4 ao1 = (f32x4){0.f, 0.f, 0.f, 0.f};
      ao1 = __builtin_amdgcn_mfma_f32_16x16x16bf16_1k(xt, bat, ao1, 0, 0, 0);
      f32x4 ao2 = (f32x4){0.f, 0.f, 0.f, 0.f};
#pragma unroll
      for (int ks = 0; ks < 4; ks++) {
        bf16x8 sf = *(const bf16x8*)(SsT + (wv * 16 + l15) * 136 + ks * 32 + lq * 8);
        ao2 = __builtin_amdgcn_mfma_f32_16x16x32_bf16(sf, cf[ks], ao2, 0, 0, 0);
      }
      const float eg = __expf(Gt);
      *(uint2*)(p.hm + (size_t)(m0 + c * 16 + l15) * 1536 + 512 + h * 64 + wv * 16 + lq * 4) =
          make_uint2(pack2(ao1[0] + ao2[0] * eg, ao1[1] + ao2[1] * eg), pack2(ao1[2] + ao2[2] * eg, ao1[3] + ao2[3] * eg));
    }
    {
      const float eGL = Gc[16];
      if (MODE == 0) prodD *= eGL;
      bf16x4 xb = *(const bf16x4*)(XBc + (wv * 16 + l15) * 24 + lq * 4);
#pragma unroll
      for (int nt = 0; nt < 8; nt++) {
        bf16x4 bt = *(const bf16x4*)(BTc + (nt * 16 + l15) * 24 + lq * 4);
        f32x4 cin = (f32x4){acc[nt][0] * eGL, acc[nt][1] * eGL, acc[nt][2] * eGL, acc[nt][3] * eGL};
        acc[nt] = __builtin_amdgcn_mfma_f32_16x16x16bf16_1k(xb, bt, cin, 0, 0, 0);
      }
    }
  }
  if (MODE == 0) {
    const size_t idx = (size_t)((s * 16 + h) * 8 + oc);
    float* sp = MB_SL(p) + idx * 8192 + (size_t)(wv * 16 + lq * 4) * 128 + l15;
#pragma unroll
    for (int nt = 0; nt < 8; nt++) {
      sp[nt * 16] = acc[nt][0]; sp[128 + nt * 16] = acc[nt][1]; sp[256 + nt * 16] = acc[nt][2]; sp[384 + nt * 16] = acc[nt][3];
    }
    if (tid == 0) MB_DD(p)[idx] = prodD;
  } else if (oc == noc - 1) {
    float* sp = out_state(p.out, s, j, O_SSM_P, O_SSM_S, 131072) + (size_t)h * 8192 + (size_t)(wv * 16 + lq * 4) * 128 + l15;
#pragma unroll
    for (int nt = 0; nt < 8; nt++) {
      sp[nt * 16] = acc[nt][0]; sp[128 + nt * 16] = acc[nt][1]; sp[256 + nt * 16] = acc[nt][2]; sp[384 + nt * 16] = acc[nt][3];
    }
  }
  __syncthreads();
}

__device__ void phase_scan_even_a(CP p, int j, char* smem, int bid, int nb) {
  const int nA = 32 * (MB_NOC - 1);
  for (int it = bid; it < 448 + nA + 256; it += nb) {
    int kind, q, oc = 0, noc = RK_NOC;
    if (it < 256) { kind = 0; q = it >> 2; oc = it & 3; }
    else if (it < 448) { kind = 1; q = (it - 256) / 3; oc = 1 + (it - 256) % 3; }
    else if (it < 448 + nA) { kind = 2; q = (it - 448) / (MB_NOC - 1); oc = (it - 448) % (MB_NOC - 1); }
    else { kind = 0; q = 64 + (it - 448 - nA); noc = 1; }
    if (kind == 2) mamba_scan_item<0>(p, j, q >> 4, q & 15, oc, MB_NOC, smem);
    else {
      const int s = q < 64 ? (q >> 5) : 2 + ((q - 64) >> 5);
      if (kind == 0) rwkv_scan_item<0>(p, j, s, (q >> 2) & 7, q & 3, oc, noc, smem);
      else rwkv_scan_item<1>(p, j, s, (q >> 2) & 7, q & 3, oc, noc, smem);
    }
  }
}
__device__ void phase_scan_even(CP p, int j, char* smem, int bid, int nb) {
  for (int it = bid; it < 16 + 32 * MB_NOC + 128; it += nb) {
    if (it < 16) { rwkv_combine_item(p, j, it >> 3, it & 7, smem); continue; }
    const int i2 = it - 16;
    int q, s, oc, noc;
    if (i2 < 32 * MB_NOC) { q = i2 / MB_NOC; oc = i2 % MB_NOC; noc = MB_NOC; s = q >> 4; }
    else { q = i2 - 32 * MB_NOC; oc = 0; noc = 1; s = 2 + (q >> 4); }
    mamba_scan_item<1>(p, j, s, q & 15, oc, noc, smem);
  }
}

__device__ void phase_post_even(CP p, int j, char* smem, int bid, int nb) {
  const int tid = otid(), lane = tid & 63, wv = tid >> 6;
  const u16* P = p.pbuf;
  {
    u16* sgb = (u16*)smem;
    float* ul = (float*)(sgb + 16 * 136) ;
    float* resg = ul + 8 * 512;
    for (int i = tid; i < 16 * 136; i += 256) sgb[i] = 0;
    const int half = tid >> 7, hk = tid & 127, h = hk >> 4, kq = hk & 15;
    const int c4 = h * 64 + kq * 4;
    const float* mu = p.mu_a + j * 1792;
    for (int u = bid; u < NT / 8; u += nb) {
      const int m0 = u * 8;
      const int s = row_seq(m0);
      const int r0 = seq_row0(s);
      __syncthreads();
#pragma unroll
      for (int i = 0; i < 4; i++) {
        int idx = tid + 256 * i;
        int tok = idx >> 7, cc = idx & 127;
        int m = m0 + tok;
        int col = 1664 + cc;
        float pc = bf2f(P[(size_t)m * PSTR + col]);
        float pp = (m > r0) ? bf2f(P[(size_t)(m - 1) * PSTR + col])
                            : (s >= 2 ? p.st_shift[((size_t)(s - 2) * 2 + j) * 1792 + col] : 0.f);
        float pm = pc + (pp - pc) * mu[col];
        sgb[tok * 136 + cc] = f2bf(sigm(pm));
      }
      const int ocu = (s < 2) ? ((m0 - r0) >> 11) : 0;
      if (ocu > 0) {
#pragma unroll
        for (int i = 0; i < 2; i++) {
          int idx = tid + 256 * i;
          uint4 uv = *(const uint4*)(p.ub + (size_t)m0 * 512 + idx * 8);
          cvt8_store(ul + idx * 8, uv);
        }
      }
      __syncthreads();
      float corr[4][4];
#pragma unroll
      for (int a = 0; a < 4; a++)
#pragma unroll
        for (int b = 0; b < 4; b++) corr[a][b] = 0.f;
      if (ocu > 0) {
        const float* sip = RK_SI(p) + (size_t)((s * 8 + h) * 4 + ocu) * 4096 + (size_t)(kq * 4) * 64;
#pragma unroll 2
        for (int i = 0; i < 64; i += 4) {
          float4 u4[4];
#pragma unroll
          for (int tk = 0; tk < 4; tk++) u4[tk] = *(const float4*)(ul + (half * 4 + tk) * 512 + h * 64 + i);
#pragma unroll
          for (int rr = 0; rr < 4; rr++) {
            float4 s4 = *(const float4*)(sip + rr * 64 + i);
#pragma unroll
            for (int tk = 0; tk < 4; tk++)
              corr[tk][rr] += s4.x * u4[tk].x + s4.y * u4[tk].y + s4.z * u4[tk].z + s4.w * u4[tk].w;
          }
        }
      }
      {
        const int lane = tid & 63, wv = tid >> 6, l15 = lane & 15, lq = lane >> 4;
        bf16x8 ag[4];
#pragma unroll
        for (int ks = 0; ks < 4; ks++) ag[ks] = *(const bf16x8*)(sgb + l15 * 136 + ks * 32 + lq * 8);
#pragma unroll
        for (int nt = 0; nt < 8; nt++) {
          const int n = wv * 128 + nt * 16 + l15;
          f32x4 cgv = (f32x4){0.f, 0.f, 0.f, 0.f};
#pragma unroll
          for (int ks = 0; ks < 4; ks++) {
            bf16x8 bg = *(const bf16x8*)(p.g2t + (size_t)n * 128 + ks * 32 + lq * 8);
            cgv = __builtin_amdgcn_mfma_f32_16x16x32_bf16(ag[ks], bg, cgv, 0, 0, 0);
          }
          if (lq < 2) {
#pragma unroll
            for (int jj = 0; jj < 4; jj++) resg[(lq * 4 + jj) * 512 + n] = cgv[jj];
          }
        }
      }
      __syncthreads();
      float accg[4][4];
#pragma unroll
      for (int tk = 0; tk < 4; tk++) {
        float4 rg4 = *(const float4*)(resg + (half * 4 + tk) * 512 + c4);
        accg[tk][0] = rg4.x; accg[tk][1] = rg4.y; accg[tk][2] = rg4.z; accg[tk][3] = rg4.w;
      }
      float4 lw = *(const float4*)(p.lnx_w + j * 512 + c4);
      float4 lb = *(const float4*)(p.lnx_b + j * 512 + c4);
      const float lwa[4] = {lw.x, lw.y, lw.z, lw.w};
      const float lba[4] = {lb.x, lb.y, lb.z, lb.w};
#pragma unroll
      for (int tk = 0; tk < 4; tk++) {
        const int m = m0 + half * 4 + tk;
        u16* op = p.hm + (size_t)m * 1536 + c4;
        uint2 oraw = *(const uint2*)op;
        float o[4] = {lo16(oraw.x) + corr[tk][0], hi16(oraw.x) + corr[tk][1], lo16(oraw.y) + corr[tk][2], hi16(oraw.y) + corr[tk][3]};
        float sm = red16(o[0] + o[1] + o[2] + o[3]);
        float mean = sm * (1.f / 64.f);
        float d0 = o[0] - mean, d1 = o[1] - mean, d2 = o[2] - mean, d3 = o[3] - mean;
        float var = red16(d0 * d0 + d1 * d1 + d2 * d2 + d3 * d3) * (1.f / 64.f);
        float rs = rsqrtf(var + 64e-5f);
        float bon = p.bonus[(size_t)m * 8 + h];
        uint4 sl2 = *(const uint4*)(p.rw + (((size_t)m * 8 + h) * 16 + kq) * 24 + 16);
        float v[4] = {lo16(sl2.z), hi16(sl2.z), lo16(sl2.w), hi16(sl2.w)};
        float dd[4] = {d0, d1, d2, d3};
        float res[4];
#pragma unroll
        for (int e = 0; e < 4; e++) res[e] = (dd[e] * rs * lwa[e] + lba[e] + bon * v[e]) * accg[tk][e];
        *(uint2*)op = make_uint2(pack2(res[0], res[1]), pack2(res[2], res[3]));
      }
    }
  }
  for (int w = bid * 4 + wv; w < NT * 2; w += nb * 4) {
    int m = w >> 1, g = w & 1;
    u16* yp = p.hm + (size_t)m * 1536 + 512 + g * 512 + lane * 8;
    uint4 yr = *(const uint4*)yp;
    uint4 zr = *(const uint4*)(P + (size_t)m * PSTR + 1792 + g * 512 + lane * 8);
    float y[8] = {lo16(yr.x), hi16(yr.x), lo16(yr.y), hi16(yr.y), lo16(yr.z), hi16(yr.z), lo16(yr.w), hi16(yr.w)};
    float z[8] = {lo16(zr.x), hi16(zr.x), lo16(zr.y), hi16(zr.y), lo16(zr.z), hi16(zr.z), lo16(zr.w), hi16(zr.w)};
    uint4 xr = *(const uint4*)(p.cv + (size_t)m * 1536 + g * 512 + lane * 8);
    float x[8] = {lo16(xr.x), hi16(xr.x), lo16(xr.y), hi16(xr.y), lo16(xr.z), hi16(xr.z), lo16(xr.w), hi16(xr.w)};
    const float dsk = p.d_skip[j * 16 + g * 8 + (lane >> 3)];
    float ss = 0.f;
#pragma unroll
    for (int e = 0; e < 8; e++) { y[e] = (y[e] + dsk * x[e]) * silu_(z[e]); ss += y[e] * y[e]; }
    ss = wave_sum(ss);
    float rs = rsqrtf(ss * (1.f / 512.f) + 1e-5f);
    const float* nw = p.norm_b_w + j * 1024 + g * 512 + lane * 8;
    float4 n0 = *(const float4*)nw, n1 = *(const float4*)(nw + 4);
    *(uint4*)yp = make_uint4(pack2(y[0] * rs * n0.x, y[1] * rs * n0.y), pack2(y[2] * rs * n0.z, y[3] * rs * n0.w),
                             pack2(y[4] * rs * n1.x, y[5] * rs * n1.y), pack2(y[6] * rs * n1.z, y[7] * rs * n1.w));
  }
}

#define QK_OFF ((size_t)1032 * 1024 * 16)
__device__ void phase_prep_odd(CP p, int j, int bid, int nb) {
  const int tid = otid();
  const u16* P = p.pbuf;
  u16* KT = p.rw;
  u16* QK = p.rw + QK_OFF;
  float* DL = (float*)p.cv;
  for (int u = bid; u < (NT / 16) * 2; u += nb) {
    const int ci = u >> 1, k = ((u & 1) * 256 + tid) * 2;
    float lb0 = 0.f, lb1 = 0.f;
    if (j == 1) { lb0 = sigm(p.lb_param[1024 + k] - p.lb_param[k]); lb1 = sigm(p.lb_param[1025 + k] - p.lb_param[k + 1]); }
    const u16* base = P + (size_t)ci * 16 * PSTR + k;
    unsigned qr[16], fr[16];
#pragma unroll
    for (int t = 0; t < 16; t++) { qr[t] = *(const unsigned*)(base + (size_t)t * PSTR); fr[t] = *(const unsigned*)(base + (size_t)t * PSTR + 1024); }
    float G0 = 0.f, G1 = 0.f;
    unsigned kt0[8], kt1[8];
#pragma unroll
    for (int t = 0; t < 16; t++) {
      float q0 = lo16(qr[t]), q1 = hi16(qr[t]), f0 = lo16(fr[t]), f1 = hi16(fr[t]);
      float s0 = sigm(f0), s1 = sigm(f1);
      float ff0 = lb0 + (1.f - lb0) * s0, ff1 = lb1 + (1.f - lb1) * s1;
      float kk0 = (1.f - lb0) * (1.f - s0), kk1 = (1.f - lb1) * (1.f - s1);
      G0 += __logf(fmaxf(ff0, 1e-30f)); G1 += __logf(fmaxf(ff1, 1e-30f));
      float Q0 = silu_(q0) * __expf(G0), Q1 = silu_(q1) * __expf(G1);
      float K0 = kk0 * __expf(fminf(-G0, 80.f)), K1 = kk1 * __expf(fminf(-G1, 80.f));
      unsigned kb0 = f2bf(K0), kb1 = f2bf(K1);
      u16* qd = QK + (size_t)(ci * 16 + t) * 2048 + k;
      *(unsigned*)qd = pack2(Q0, Q1);
      *(unsigned*)(qd + 1024) = kb0 | (kb1 << 16);
      if (t & 1) { kt0[t >> 1] |= kb0 << 16; kt1[t >> 1] |= kb1 << 16; } else { kt0[t >> 1] = kb0; kt1[t >> 1] = kb1; }
    }
    *(float2*)(DL + (size_t)ci * 1024 + k) = make_float2(__expf(G0), __expf(G1));
    uint4* kd = (uint4*)(KT + ((size_t)ci * 1024 + k) * 16);
    kd[0] = make_uint4(kt0[0], kt0[1], kt0[2], kt0[3]);
    kd[1] = make_uint4(kt0[4], kt0[5], kt0[6], kt0[7]);
    kd[2] = make_uint4(kt1[0], kt1[1], kt1[2], kt1[3]);
    kd[3] = make_uint4(kt1[4], kt1[5], kt1[6], kt1[7]);
  }
}

#define HG_SL(p) ((float*)(p).cv + 2 * 1024 * 1024)
#define HG_DD(p) (HG_SL(p) + 2 * 8 * 8 * 16384)
template <int MODE>
__device__ __forceinline__ void hgrn_scan_item(CP p, int j, int s, int h, int vq, int oc, int noc, char* smem) {
  u16* Qs = (u16*)smem;
  u16* Ks = Qs + 2 * 16 * 136;
  u16* KTs = Ks + 2 * 16 * 136;
  u16* VTs = KTs + 2 * 128 * 24;
  u16* SsT = VTs + 2 * 32 * 24;
  float* dLs = (float*)(SsT + 2 * 32 * 136);
  const int tid = otid(), lane = tid & 63, wv = tid >> 6;
  const int l15 = lane & 15, lq = lane >> 4;
  const int T = seq_len(s);
  const int nch = (T >> 4) / noc;
  const int m0 = seq_row0(s) + oc * nch * 16;
  const int ci0 = m0 >> 4;
  f32x4 acc[2][2];
#pragma unroll
  for (int vt = 0; vt < 2; vt++)
#pragma unroll
    for (int kl = 0; kl < 2; kl++) acc[vt][kl] = (f32x4){0.f, 0.f, 0.f, 0.f};
  float prodD[2] = {1.f, 1.f};
  if (MODE == 1) {
    if (s >= 2) {
      const float* sp = p.st_hgrn + (((size_t)(s - 2) * 2 + j) * 8 + h) * 16384;
#pragma unroll
      for (int vt = 0; vt < 2; vt++)
#pragma unroll
        for (int kl = 0; kl < 2; kl++) {
          float4 q = *(const float4*)(sp + (size_t)((2 * wv + kl) * 16 + l15) * 128 + vq * 32 + vt * 16 + lq * 4);
          acc[vt][kl] = (f32x4){q.x, q.y, q.z, q.w};
        }
    } else {
      for (int cp = 0; cp < oc; cp++) {
        const size_t idx = (size_t)((s * 8 + h) * 8 + cp);
#pragma unroll
        for (int kl = 0; kl < 2; kl++) {
          const int k = (2 * wv + kl) * 16 + l15;
          const float dd = HG_DD(p)[idx * 128 + k];
#pragma unroll
          for (int vt = 0; vt < 2; vt++) {
            float4 L4 = *(const float4*)(HG_SL(p) + idx * 16384 + (size_t)k * 128 + vq * 32 + vt * 16 + lq * 4);
            acc[vt][kl] = (f32x4){acc[vt][kl][0] * dd + L4.x, acc[vt][kl][1] * dd + L4.y, acc[vt][kl][2] * dd + L4.z,
                                  acc[vt][kl][3] * dd + L4.w};
          }
        }
      }
    }
  }
  const u16* Pq = p.rw + QK_OFF + (size_t)(m0 + (tid >> 4)) * 2048 + h * 128 + (tid & 15) * 8;
  const u16* Pv = p.pbuf + (size_t)(m0 + ((tid >> 2) & 15)) * PSTR + 2048 + h * 128 + vq * 32 + (tid & 3) * 8;
  const u16* Pkt = p.rw + ((size_t)ci0 * 1024 + h * 128 + (tid >> 1)) * 16 + (tid & 1) * 8;
  const float* Pdl = (const float*)p.cv + (size_t)ci0 * 1024 + h * 128 + (tid & 31) * 4;
  uint4 aq, ak, akt, av, cq, ck, ckt, cvv;
  float4 ad, cd;
  aq = make_uint4(0, 0, 0, 0); ak = aq; cq = aq; ck = aq;
  av = make_uint4(0, 0, 0, 0); cvv = av; ad = make_float4(0, 0, 0, 0); cd = ad;
#define HM_ISSUE(rq, rk, rkt, rv, rd, c) { \
    if (MODE == 1) { rq = *(const uint4*)(Pq + (size_t)(c) * 16 * 2048); rk = *(const uint4*)(Pq + (size_t)(c) * 16 * 2048 + 1024); } \
    rkt = *(const uint4*)(Pkt + (size_t)(c) * 1024 * 16); \
    if (tid < 64) rv = *(const uint4*)(Pv + (size_t)(c) * 16 * PSTR); \
    if (tid < 32) rd = *(const float4*)(Pdl + (size_t)(c) * 1024); }
#define HM_STASH(rq, rk, rkt, rv, rd, bi) { \
    if (MODE == 1) { *(uint4*)(Qs + (bi) * (16 * 136) + (tid >> 4) * 136 + (tid & 15) * 8) = rq; \
    *(uint4*)(Ks + (bi) * (16 * 136) + (tid >> 4) * 136 + (tid & 15) * 8) = rk; } \
    *(uint4*)(KTs + (bi) * (128 * 24) + (tid >> 1) * 24 + (tid & 1) * 8) = rkt; \
    if (tid < 64) { u16* vd_ = VTs + (bi) * (32 * 24) + ((tid & 3) * 8) * 24 + (tid >> 2); \
      vd_[0 * 24] = (u16)(rv.x & 0xffff); vd_[1 * 24] = (u16)(rv.x >> 16); vd_[2 * 24] = (u16)(rv.y & 0xffff); vd_[3 * 24] = (u16)(rv.y >> 16); \
      vd_[4 * 24] = (u16)(rv.z & 0xffff); vd_[5 * 24] = (u16)(rv.z >> 16); vd_[6 * 24] = (u16)(rv.w & 0xffff); vd_[7 * 24] = (u16)(rv.w >> 16); } \
    if (tid < 32) *(float4*)(dLs + (bi) * 128 + tid * 4) = rd; }
  __syncthreads();
  HM_ISSUE(aq, ak, akt, av, ad, 0)
  HM_STASH(aq, ak, akt, av, ad, 0)
  if (1 < nch) HM_ISSUE(aq, ak, akt, av, ad, 1)
  if (2 < nch) HM_ISSUE(cq, ck, ckt, cvv, cd, 2)
  for (int c = 0; c < nch; c++) {
    const int bi = c & 1;
    if (MODE == 1) {
      u16* sd = SsT + bi * (32 * 136);
#pragma unroll
      for (int vt = 0; vt < 2; vt++)
#pragma unroll
        for (int kl = 0; kl < 2; kl++)
#pragma unroll
          for (int jj = 0; jj < 4; jj++)
            sd[(vt * 16 + lq * 4 + jj) * 136 + (2 * wv + kl) * 16 + l15] = f2bf(acc[vt][kl][jj]);
    }
    __syncthreads();
    if (c + 1 < nch) {
      if (bi == 0) { HM_STASH(aq, ak, akt, av, ad, 1) if (c + 3 < nch) HM_ISSUE(aq, ak, akt, av, ad, c + 3) }
      else { HM_STASH(cq, ck, ckt, cvv, cd, 0) if (c + 3 < nch) HM_ISSUE(cq, ck, ckt, cvv, cd, c + 3) }
    }
    const u16* Qc = Qs + bi * (16 * 136);
    const u16* Kc = Ks + bi * (16 * 136);
    const u16* KTc = KTs + bi * (128 * 24);
    const u16* VTc = VTs + bi * (32 * 24);
    const u16* Sc = SsT + bi * (32 * 136);
    if (MODE == 1 && wv < 2) {
      const int vt = wv;
      f32x4 at = (f32x4){0.f, 0.f, 0.f, 0.f};
      bf16x8 qf[4];
#pragma unroll
      for (int ks = 0; ks < 4; ks++) {
        bf16x8 kf = *(const bf16x8*)(Kc + l15 * 136 + ks * 32 + lq * 8);
        qf[ks] = *(const bf16x8*)(Qc + l15 * 136 + ks * 32 + lq * 8);
        at = __builtin_amdgcn_mfma_f32_16x16x32_bf16(kf, qf[ks], at, 0, 0, 0);
      }
      bf16x4 bat;
#pragma unroll
      for (int jj = 0; jj < 4; jj++) bat[jj] = (short)f2bf((lq * 4 + jj) <= l15 ? at[jj] : 0.f);
      bf16x4 vf = *(const bf16x4*)(VTc + (vt * 16 + l15) * 24 + lq * 4);
      f32x4 ao1 = (f32x4){0.f, 0.f, 0.f, 0.f};
      ao1 = __builtin_amdgcn_mfma_f32_16x16x16bf16_1k(vf, bat, ao1, 0, 0, 0);
      f32x4 ao2 = (f32x4){0.f, 0.f, 0.f, 0.f};
#pragma unroll
      for (int ks = 0; ks < 4; ks++) {
        bf16x8 sf = *(const bf16x8*)(Sc + (vt * 16 + l15) * 136 + ks * 32 + lq * 8);
        ao2 = __builtin_amdgcn_mfma_f32_16x16x32_bf16(sf, qf[ks], ao2, 0, 0, 0);
      }
      f32x4 ao = (f32x4){ao1[0] + ao2[0], ao1[1] + ao2[1], ao1[2] + ao2[2], ao1[3] + ao2[3]};
      *(uint2*)(p.hm + (size_t)(m0 + c * 16 + l15) * 1024 + h * 128 + vq * 32 + vt * 16 + lq * 4) =
          make_uint2(pack2(ao[0], ao[1]), pack2(ao[2], ao[3]));
    }
#pragma unroll
    for (int kl = 0; kl < 2; kl++) {
      const int kt = 2 * wv + kl;
      bf16x4 kb = *(const bf16x4*)(KTc + (kt * 16 + l15) * 24 + lq * 4);
      float dl = dLs[bi * 128 + kt * 16 + l15];
      if (MODE == 0) prodD[kl] *= dl;
#pragma unroll
      for (int vt = 0; vt < 2; vt++) {
        bf16x4 vf = *(const bf16x4*)(VTc + (vt * 16 + l15) * 24 + lq * 4);
        f32x4 a = __builtin_amdgcn_mfma_f32_16x16x16bf16_1k(vf, kb, acc[vt][kl], 0, 0, 0);
        acc[vt][kl] = (f32x4){a[0] * dl, a[1] * dl, a[2] * dl, a[3] * dl};
      }
    }
  }
  if (MODE == 0) {
    const size_t idx = (size_t)((s * 8 + h) * 8 + oc);
#pragma unroll
    for (int kl = 0; kl < 2; kl++) {
      const int k = (2 * wv + kl) * 16 + l15;
      if (vq == 0 && lq == 0) HG_DD(p)[idx * 128 + k] = prodD[kl];
#pragma unroll
      for (int vt = 0; vt < 2; vt++)
        *(float4*)(HG_SL(p) + idx * 16384 + (size_t)k * 128 + vq * 32 + vt * 16 + lq * 4) =
            make_float4(acc[vt][kl][0], acc[vt][kl][1], acc[vt][kl][2], acc[vt][kl][3]);
    }
  } else if (oc == noc - 1) {
    float* o = out_state(p.out, s, j, O_HGRN_P, O_HGRN_S, 131072) + (size_t)h * 16384;
#pragma unroll
    for (int vt = 0; vt < 2; vt++)
#pragma unroll
      for (int kl = 0; kl < 2; kl++)
        *(float4*)(o + (size_t)((2 * wv + kl) * 16 + l15) * 128 + vq * 32 + vt * 16 + lq * 4) =
            make_float4(acc[vt][kl][0], acc[vt][kl][1], acc[vt][kl][2], acc[vt][kl][3]);
  }
  __syncthreads();
}

#define HG_NOC 8
__device__ void phase_scan_odd_a(CP p, int j, char* smem, int bid, int nb) {
  for (int it = bid; it < 64 * (HG_NOC - 1); it += nb) {
    int q = it / (HG_NOC - 1), oc = it % (HG_NOC - 1);
    hgrn_scan_item<0>(p, j, q >> 5, (q >> 2) & 7, q & 3, oc, HG_NOC, smem);
  }
}
__device__ void phase_scan_odd(CP p, int j, char* smem, int bid, int nb) {
  for (int it = bid; it < 64 * HG_NOC + 256; it += nb) {
    int q, s, oc, noc;
    if (it < 64 * HG_NOC) { q = it / HG_NOC; oc = it % HG_NOC; noc = HG_NOC; s = q >> 5; }
    else { q = it - 64 * HG_NOC; oc = 0; noc = 1; s = 2 + (q >> 5); }
    hgrn_scan_item<1>(p, j, s, (q >> 2) & 7, q & 3, oc, noc, smem);
  }
}

__device__ void phase_post_odd(CP p, int j, int bid, int nb) {
  const int tid = otid(), lane = tid & 63, wv = tid >> 6;
  const u16* P = p.pbuf;
  for (int m = bid * 4 + wv; m < NT; m += nb * 4) {
    u16* op = p.hm + (size_t)m * 1024 + lane * 16;
    uint4 a = *(const uint4*)op, b = *(const uint4*)(op + 8);
    const u16* gp = P + (size_t)m * PSTR + 3072 + lane * 16;
    uint4 ga = *(const uint4*)gp, gb = *(const uint4*)(gp + 8);
    float o[16] = {lo16(a.x), hi16(a.x), lo16(a.y), hi16(a.y), lo16(a.z), hi16(a.z), lo16(a.w), hi16(a.w),
                   lo16(b.x), hi16(b.x), lo16(b.y), hi16(b.y), lo16(b.z), hi16(b.z), lo16(b.w), hi16(b.w)};
    float g[16] = {lo16(ga.x), hi16(ga.x), lo16(ga.y), hi16(ga.y), lo16(ga.z), hi16(ga.z), lo16(ga.w), hi16(ga.w),
                   lo16(gb.x), hi16(gb.x), lo16(gb.y), hi16(gb.y), lo16(gb.z), hi16(gb.z), lo16(gb.w), hi16(gb.w)};
    float ss = 0.f;
#pragma unroll
    for (int e = 0; e < 16; e++) ss += o[e] * o[e];
    ss += dpp_f<0xB1>(ss);
    ss += dpp_f<0x4E>(ss);
    ss += dpp_f<0x141>(ss);
    float rs = rsqrtf(ss * (1.f / 128.f) + 1e-5f);
    const float* nw = p.norm_c_w + j * 1024 + lane * 16;
    float r[16];
#pragma unroll
    for (int e = 0; e < 16; e++) r[e] = o[e] * rs * nw[e] * silu_(g[e]);
    *(uint4*)op = make_uint4(pack2(r[0], r[1]), pack2(r[2], r[3]), pack2(r[4], r[5]), pack2(r[6], r[7]));
    *(uint4*)(op + 8) = make_uint4(pack2(r[8], r[9]), pack2(r[10], r[11]), pack2(r[12], r[13]), pack2(r[14], r[15]));
  }
}


#define XB_TMO      128
#define XB_XCNT(j)  (256  + 64 * (j))
#define XB_XSUB(j)  (1280 + 64 * (j))
#define XB_XGEN(j)  (2304 + 64 * (j))
#define XB_TOP      3328
#define XB_TOPGEN   3392
#define XCD_BAR_WORDS 3456
#define XB_SPIN_CAP (1u << 22)
#define LAS __attribute__((address_space(3)))
__device__ __forceinline__ unsigned xb_ld(unsigned* p) { return __hip_atomic_load(p, __ATOMIC_RELAXED, __HIP_MEMORY_SCOPE_AGENT); }
__device__ __forceinline__ unsigned xb_add(unsigned* p, unsigned v) { return __hip_atomic_fetch_add(p, v, __ATOMIC_RELAXED, __HIP_MEMORY_SCOPE_AGENT); }
__device__ __forceinline__ unsigned xb_xcc_id() { return (unsigned)__builtin_amdgcn_s_getreg((3 << 11) | 20) & 0xFu; }
#define XB_SPIN(cond, bar) do { unsigned _sp = 0; while (cond) { __builtin_amdgcn_s_sleep(1); \
    if ((++_sp & 255u) == 0u) { if (xb_ld(&(bar)[XB_TMO])) break; if (_sp > XB_SPIN_CAP) { atomicAdd(&(bar)[XB_TMO], 1u); break; } } } } while (0)
struct XcdBarrier { unsigned* bar; unsigned x; volatile LAS unsigned* st; };
__device__ __forceinline__ XcdBarrier xcd_barrier_post(unsigned* bar, volatile LAS unsigned* st) {
  XcdBarrier b; b.bar = bar; b.x = xb_xcc_id(); b.st = st;
  if (threadIdx.x == 0) (void)xb_add(&bar[XB_XCNT(b.x)], 1u);
  return b;
}
__device__ __forceinline__ void xcd_barrier_complete(unsigned* bar, unsigned x, unsigned& nloc, unsigned& nx) {
  const unsigned G = gridDim.x * gridDim.y * gridDim.z;
  unsigned sum, cnt, mine, sp = 0u;
  for (;;) {
    sum = 0u; cnt = 0u; mine = 0u;
#pragma unroll
    for (unsigned j = 0; j < 16; ++j) { const unsigned c = xb_ld(&bar[XB_XCNT(j)]); sum += c; cnt += (c > 0u) ? 1u : 0u; mine = (j == x) ? c : mine; }
    if (sum == G) break;
    __builtin_amdgcn_s_sleep(1);
    if ((++sp & 255u) == 0u) { if (xb_ld(&bar[XB_TMO])) break; if (sp > XB_SPIN_CAP) { atomicAdd(&bar[XB_TMO], 1u); break; } }
  }
  nloc = mine > 0u ? mine : 1u; nx = cnt > 0u ? cnt : 1u;
}
__device__ __forceinline__ void xcd_barrier(const XcdBarrier& b) {
  asm volatile("s_waitcnt vmcnt(0)" ::: "memory");
  __syncthreads();
  if (threadIdx.x == 0) {
    unsigned* bar = b.bar;
    __builtin_amdgcn_s_waitcnt(0);
    unsigned nloc = b.st[0], nx = b.st[1];
    if (nloc == 0u) { xcd_barrier_complete(bar, b.x, nloc, nx); b.st[0] = nloc; b.st[1] = nx; }
    const unsigned old = xb_add(&bar[XB_XSUB(b.x)], 1u);
    const unsigned gen = old / nloc;
    if (old + 1u == (gen + 1u) * nloc) {
      __builtin_amdgcn_fence(__ATOMIC_RELEASE, "agent");
      asm volatile("s_waitcnt vmcnt(0)" ::: "memory");
      const unsigned og = xb_add(&bar[XB_TOP], 1u);
      const unsigned tg = og / nx;
      if (og + 1u == (tg + 1u) * nx) xb_add(&bar[XB_TOPGEN], 1u);
      else XB_SPIN(xb_ld(&bar[XB_TOPGEN]) == tg, bar);
      __builtin_amdgcn_fence(__ATOMIC_ACQUIRE, "agent");
      xb_add(&bar[XB_XGEN(b.x)], 1u);
      asm volatile("s_waitcnt vmcnt(0)" ::: "memory");
    } else {
      XB_SPIN(xb_ld(&bar[XB_XGEN(b.x)]) == gen, bar);
      __builtin_amdgcn_fence(__ATOMIC_ACQUIRE, "agent");
      asm volatile("s_waitcnt vmcnt(0)" ::: "memory");
    }
  }
  __syncthreads();
}

#define NPHASE 42
__global__ void __launch_bounds__(256, 2) mega(Params kp) {
  __shared__ __attribute__((aligned(16))) char smem[65536];
  cg::grid_group grid = cg::this_grid();
  const int ph0 = kp.p0, ph1 = kp.p1;
  volatile LAS unsigned* xst = (volatile LAS unsigned*)(smem + 65520);
  if (threadIdx.x == 0) { xst[0] = 0u; xst[1] = 0u; }
  __syncthreads();
  XcdBarrier xb = xcd_barrier_post(kp.bar, xst);
  if (ph1 > 1000) grid.sync();
  const bool multi = (ph1 - ph0) > 1;
  for (int ph = ph0; ph < ph1; ph++) {
    CP p = *getp();
    int bid = blockIdx.x, nb = gridDim.x;
    asm volatile("" : "+s"(bid), "+s"(nb));
    if (ph == 0) {
      phase_mod(p, smem, bid, nb);
    } else if (ph == NPHASE - 1) {
      phase_final(p, bid, nb);
    } else {
      const int L = (ph - 1) / 10, sp = (ph - 1) % 10;
      const int j = L >> 1;
      const bool even = (L & 1) == 0;
      int reps = 1;
#ifdef PROBE_SCAN
      if (sp == 4 && !even) reps = 2;
#endif
#ifdef PROBE_GEMM
      if (sp == 1 || sp == 8) reps = 2;
#endif
#ifdef PROBE_MISC
      if (sp == 0 || sp == 7 || sp == 2) reps = 2;
#endif
      for (int rep = 0; rep < reps; rep++) {
      bool do_gemm = false;
      const u16 *A = nullptr, *Bt = nullptr;
      u16* outb = nullptr;
      const float* gate = nullptr;
      int lda = 0, K = 0, ntn = 0, epi = 0, ldo = 0, ncols = 0;
      switch (sp) {
        case 0:
          phase_wconv(p, L, smem, bid, nb);
          phase_norm(p, L, 0, bid, nb);
          break;
        case 1:
          do_gemm = true; A = p.hm; lda = 1024; Bt = p.wb_in; K = 1024; ntn = even ? 18 : 16; epi = 0;
          outb = p.pbuf; ldo = PSTR; ncols = even ? PSTR : 4096;
          break;
        case 2:
          if (even) phase_prep_even(p, j, smem, bid, nb); else phase_prep_odd(p, j, bid, nb);
          break;
        case 3:
          if (even) phase_scan_even_a(p, j, smem, bid, nb); else phase_scan_odd_a(p, j, smem, bid, nb);
          break;
        case 4:
          if (even) phase_scan_even(p, j, smem, bid, nb); else phase_scan_odd(p, j, smem, bid, nb);
          break;
        case 5:
          if (even) phase_post_even(p, j, smem, bid, nb); else phase_post_odd(p, j, bid, nb);
          break;
        case 6:
          do_gemm = true; A = p.hm; lda = even ? 1536 : 1024; Bt = p.wb_out; K = lda; ntn = 4; epi = 2;
          gate = p.mod + (size_t)L * 10 * 6144 + 2048;
          break;
        case 7:
          phase_norm(p, L, 1, bid, nb);
          break;
        case 8:
          do_gemm = true; A = p.hm; lda = 1024; Bt = p.wb_gu; K = 1024; ntn = 22; epi = 1;
          outb = p.pbuf; ldo = 2816; ncols = 2816;
          break;
        default:
          do_gemm = true; A = p.pbuf; lda = 2816; Bt = p.wb_dn; K = 2816; ntn = 4; epi = 2;
          gate = p.mod + (size_t)L * 10 * 6144 + 5120;
          break;
      }
      if (do_gemm) gemm_phase(p, A, lda, Bt, K, ntn, epi, outb, ldo, ncols, gate, smem, bid, nb);
      }
    }
    if (multi && ph + 1 < ph1) xcd_barrier(xb);
  }
}

extern "C" void kernel_launch(void* const* d_in, const int* in_sizes, int n_in, void* d_out, int out_size, void* d_ws,
                              size_t ws_size, hipStream_t stream) {
  static int grid_blocks = 0;
  if (!grid_blocks) {
    int dev = 0, cus = 0, per_cu = 0;
    hipGetDevice(&dev);
    hipDeviceGetAttribute(&cus, hipDeviceAttributeMultiprocessorCount, dev);
    hipOccupancyMaxActiveBlocksPerMultiprocessor(&per_cu, mega, 256, 0);
    if (per_cu > 2) per_cu = 2;
    if (per_cu < 1) per_cu = 1;
    grid_blocks = cus * per_cu;
  }
  Params p{};
  const float* const* in = (const float* const*)d_in;
  p.x_prompt = in[0]; p.x_sample = in[1]; p.st_rwkv = in[2]; p.st_shift = in[3]; p.st_ssm = in[4]; p.st_conv = in[5];
  p.st_hgrn = in[6]; p.c_prompt = in[7]; p.c_sample = in[8]; p.norm_mix_w = in[9]; p.norm_ffn_w = in[10];
  p.norm_out_w = in[11]; p.ada_w = in[12]; p.ada_b = in[13]; p.w_in_ab = in[14]; p.w_out_ab = in[15]; p.mu_a = in[16];
  p.w0 = in[17]; p.w2 = in[18]; p.a0 = in[19]; p.a2 = in[20]; p.g2 = in[21]; p.k_k = in[22]; p.k_a = in[23];
  p.r_k = in[24]; p.lnx_w = in[25]; p.lnx_b = in[26]; p.conv_w = in[27]; p.conv_b = in[28]; p.dt_bias = in[29];
  p.a_log = in[30]; p.d_skip = in[31]; p.norm_b_w = in[32]; p.w_in_c = in[33]; p.w_out_c = in[34]; p.lb_param = in[35];
  p.norm_c_w = in[36]; p.w_gate = in[37]; p.w_up = in[38]; p.w_down = in[39];
  p.out = (float*)d_out;
  char* ws = (char*)d_ws;
  size_t off = 0;
  auto take = [&](size_t bytes) { char* r = ws + off; off += (bytes + 255) & ~(size_t)255; return r; };
  p.bar = (unsigned*)take(16384);
  p.mod = (float*)take((size_t)4 * 10 * 6144 * 4);
  p.bonus = (float*)take((size_t)NT * 8 * 4);
  p.dtb = (float*)take((size_t)NT * 32 * 4);
  p.wb_in = (u16*)take((size_t)4480 * 1024 * 2);
  p.wb_out = (u16*)take((size_t)1024 * 1536 * 2);
  p.wb_gu = (u16*)take((size_t)5632 * 1024 * 2);
  p.wb_dn = (u16*)take((size_t)1024 * 2816 * 2);
  p.hm = (u16*)take((size_t)NT * 1536 * 2);
  p.pbuf = (u16*)take((size_t)NT * PSTR * 2);
  p.rw = (u16*)take((size_t)NT * 8 * 16 * 24 * 2);
  p.cv = (u16*)take((size_t)NT * 1536 * 2);
  p.scr = (float*)take((size_t)12 * 1024 * 1024);
  p.ub = (u16*)take((size_t)NT * 512 * 2);
  p.w2t = (u16*)take((size_t)512 * 64 * 2);
  p.a2t = (u16*)take((size_t)512 * 64 * 2);
  p.g2t = (u16*)take((size_t)512 * 128 * 2);
#if 1
  p.p0 = 0; p.p1 = NPHASE;
  hipMemsetAsync(p.bar, 0, 16384, stream);
  void* args[] = {&p};
  hipError_t e = hipLaunchCooperativeKernel((void*)mega, dim3(grid_blocks), dim3(256), args, 0, stream);
  if (e != hipSuccess) fprintf(stderr, "cooperative launch failed: %s (grid %d)\n", hipGetErrorString(e), grid_blocks);
#else
  for (int ph = 0; ph < NPHASE; ph++) {
    p.p0 = ph; p.p1 = ph + 1;
    mega<<<dim3(grid_blocks), dim3(256), 0, stream>>>(p);
  }
#endif
}
```

```cpp
#include <hip/hip_runtime.h>
#include <hip/hip_cooperative_groups.h>
#include <cstdio>
namespace cg = cooperative_groups;

typedef unsigned short u16;
typedef __attribute__((ext_vector_type(8))) short bf16x8;
typedef __attribute__((ext_vector_type(4))) float f32x4;

#define NT 16512
#define PSTR 4480

#define O_RWKV_P 16908288ull
#define O_SHIFT_P 17039360ull
#define O_SSM_P 17046528ull
#define O_CONV_P 17570816ull
#define O_HGRN_P 17589248ull
#define O_RWKV_S 18113536ull
#define O_SHIFT_S 18637824ull
#define O_SSM_S 18666496ull
#define O_CONV_S 20763648ull
#define O_HGRN_S 20837376ull

struct Params {
  const float *x_prompt, *x_sample, *st_rwkv, *st_shift, *st_ssm, *st_conv, *st_hgrn, *c_prompt, *c_sample;
  const float *norm_mix_w, *norm_ffn_w, *norm_out_w, *ada_w, *ada_b, *w_in_ab, *w_out_ab, *mu_a, *w0, *w2, *a0, *a2,
      *g2, *k_k, *k_a, *r_k, *lnx_w, *lnx_b, *conv_w, *conv_b, *dt_bias, *a_log, *d_skip, *norm_b_w, *w_in_c,
      *w_out_c, *lb_param, *norm_c_w, *w_gate, *w_up, *w_down;
  float* out;
  float *mod, *bonus, *dtb;
  u16 *wb_in, *wb_out, *wb_gu, *wb_dn, *hm, *pbuf, *rw, *cv;
  float* scr;
  u16* ub;
  u16 *w2t, *a2t, *g2t;
  unsigned* bar;
  int p0, p1;
};

typedef const __attribute__((address_space(4))) Params& CP;
typedef const __attribute__((address_space(4))) Params* CPP;
__device__ __forceinline__ CPP getp() {
  CPP pp = (CPP)__builtin_amdgcn_kernarg_segment_ptr();
  asm volatile("" : "+s"(pp) : : "memory");
  return pp;
}
__device__ __forceinline__ int otid() {
  int t = threadIdx.x;
  asm volatile("" : "+v"(t));
  return t;
}
__device__ __forceinline__ float bf2f(u16 u) { return __uint_as_float(((unsigned)u) << 16); }
typedef float f32x2_t __attribute__((ext_vector_type(2)));
typedef __bf16 bf16x2_t __attribute__((ext_vector_type(2)));
__device__ __forceinline__ unsigned pack2(float a, float b) {
  f32x2_t v = {a, b};
  bf16x2_t r = __builtin_convertvector(v, bf16x2_t);
  return __builtin_bit_cast(unsigned, r);
}
__device__ __forceinline__ u16 f2bf(float f) { return (u16)(pack2(f, f) & 0xffffu); }
__device__ __forceinline__ float lo16(unsigned v) { return __uint_as_float(v << 16); }
__device__ __forceinline__ float hi16(unsigned v) { return __uint_as_float(v & 0xffff0000u); }
__device__ __forceinline__ float sigm(float x) { return __builtin_amdgcn_rcpf(1.f + __expf(-x)); }
__device__ __forceinline__ float silu_(float x) { return x * __builtin_amdgcn_rcpf(1.f + __expf(-x)); }
__device__ __forceinline__ float softplus_(float x) {
  const float e = __expf(x);
  return x > 20.f ? x : (e < 1e-4f ? e * (1.f - 0.5f * e) : __logf(1.f + e));
}
__device__ __forceinline__ float tanh_(float x) { return 1.f - 2.f * __builtin_amdgcn_rcpf(1.f + __expf(2.f * x)); }

__device__ __forceinline__ int row_seq(int m) { return m < 16384 ? (m >> 13) : 2 + ((m - 16384) >> 4); }
__device__ __forceinline__ int seq_row0(int s) { return s < 2 ? s * 8192 : 16384 + (s - 2) * 16; }
__device__ __forceinline__ int seq_len(int s) { return s < 2 ? 8192 : 16; }
__device__ __forceinline__ float* out_state(float* out, int s, int j, size_t baseP, size_t baseS, size_t sz) {
  return s < 2 ? out + baseP + (size_t)(s * 2 + j) * sz : out + baseS + (size_t)((s - 2) * 2 + j) * sz;
}

template <int CTRL>
__device__ __forceinline__ float dpp_f(float x) {
  return __int_as_float(__builtin_amdgcn_update_dpp(0, __float_as_int(x), CTRL, 0xf, 0xf, false));
}
__device__ __forceinline__ float red16(float x) {
  x += dpp_f<0xB1>(x);
  x += dpp_f<0x4E>(x);
  x += dpp_f<0x124>(x);
  x += dpp_f<0x128>(x);
  return x;
}
__device__ __forceinline__ float red32_hi(float x) {
  x = red16(x);
  float y = __int_as_float(__builtin_amdgcn_update_dpp(0, __float_as_int(x), 0x142, 0xA, 0xf, false));
  return x + y;
}
__device__ __forceinline__ float wave_sum(float x) {
  x = red16(x);
  x += __int_as_float(__builtin_amdgcn_update_dpp(0, __float_as_int(x), 0x142, 0xA, 0xf, false));
  x += __int_as_float(__builtin_amdgcn_update_dpp(0, __float_as_int(x), 0x143, 0xC, 0xf, false));
  return __int_as_float(__builtin_amdgcn_readlane(__float_as_int(x), 63));
}

__device__ void phase_mod(CP p, char* smem, int bid, int nb) {
  if (bid >= 384) return;
  float* sc = (float*)smem;
  float* red = sc + 10 * 1024;
  const int tid = otid(), lane = tid & 63, wv = tid >> 6;
  for (int i = tid; i < 10 * 1024; i += 256) {
    int s = i >> 10, k = i & 1023;
    float c = s < 2 ? p.c_prompt[s * 1024 + k] : p.c_sample[(s - 2) * 1024 + k];
    sc[i] = silu_(c);
  }
  __syncthreads();
  for (int u = bid; u < 384; u += nb) {
    int L = u / 96, cgp = u % 96;
    int col = cgp * 64 + lane;
    const float* W = p.ada_w + (size_t)L * 1024 * 6144 + col;
    float acc[10];
#pragma unroll
    for (int s = 0; s < 10; s++) acc[s] = 0.f;
    int k0 = wv * 256;
#pragma unroll 4
    for (int k = k0; k < k0 + 256; k += 4) {
      float w0 = W[(size_t)k * 6144], w1 = W[(size_t)(k + 1) * 6144], w2 = W[(size_t)(k + 2) * 6144],
            w3 = W[(size_t)(k + 3) * 6144];
#pragma unroll
      for (int s = 0; s < 10; s++) {
        float4 c4 = *(const float4*)&sc[s * 1024 + k];
        acc[s] += c4.x * w0 + c4.y * w1 + c4.z * w2 + c4.w * w3;
      }
    }
#pragma unroll
    for (int s = 0; s < 10; s++) red[(wv * 10 + s) * 64 + lane] = acc[s];
    __syncthreads();
    for (int i = tid; i < 640; i += 256) {
      int s = i >> 6, l = i & 63;
      float v = red[(0 * 10 + s) * 64 + l] + red[(1 * 10 + s) * 64 + l] + red[(2 * 10 + s) * 64 + l] +
                red[(3 * 10 + s) * 64 + l];
      int c = cgp * 64 + l;
      p.mod[((size_t)L * 10 + s) * 6144 + c] = v + p.ada_b[L * 6144 + c];
    }
    __syncthreads();
  }
}

__device__ __forceinline__ void wconv_tile(const float* __restrict__ src, int K, int N, u16* __restrict__ dst, int k0,
                                           int n0, int mode, float* tile) {
  const int tid = otid();
#pragma unroll
  for (int i = 0; i < 4; i++) {
    int r = i * 16 + (tid >> 4), c = (tid & 15) * 4;
    int n = n0 + c;
    float4 v4 = n < N ? *(const float4*)(src + (size_t)(k0 + r) * N + n) : make_float4(0.f, 0.f, 0.f, 0.f);
    tile[r * 65 + c] = v4.x; tile[r * 65 + c + 1] = v4.y; tile[r * 65 + c + 2] = v4.z; tile[r * 65 + c + 3] = v4.w;
  }
  __syncthreads();
  int n = tid >> 2, kc = (tid & 3) * 16;
  unsigned pk[8];
#pragma unroll
  for (int i = 0; i < 8; i++) pk[i] = pack2(tile[(kc + 2 * i) * 65 + n], tile[(kc + 2 * i + 1) * 65 + n]);
  int gn = n0 + n;
  int row = mode == 0 ? gn : ((gn >> 4) * 32 + (gn & 15) + (mode == 2 ? 16 : 0));
  uint4* d = (uint4*)(dst + (size_t)row * K + k0 + kc);
  d[0] = make_uint4(pk[0], pk[1], pk[2], pk[3]);
  d[1] = make_uint4(pk[4], pk[5], pk[6], pk[7]);
  __syncthreads();
}

__device__ void phase_wconv(CP p, int L, char* smem, int bid, int nb) {
  float* tile = (float*)smem;
  const int j = L >> 1;
  const bool even = (L & 1) == 0;
  const int ntn_in = even ? 70 : 64;
  const int n_in = 16 * ntn_in;
  const int n_out = even ? 24 * 16 : 16 * 16;
  const int n_g = 16 * 44;
  const int n_lora = even ? 32 : 0;
  const int total = n_in + n_out + 3 * n_g + n_lora;
  for (int u = bid; u < total; u += nb) {
    int li = u;
    if (li < n_in) {
      int kt = li / ntn_in, nt = li % ntn_in;
      if (even)
        wconv_tile(p.w_in_ab + (size_t)j * 1024 * 4368, 1024, 4368, p.wb_in, kt * 64, nt * 64, 0, tile);
      else
        wconv_tile(p.w_in_c + (size_t)j * 1024 * 4096, 1024, 4096, p.wb_in, kt * 64, nt * 64, 0, tile);
      continue;
    }
    li -= n_in;
    if (li < n_out) {
      int kt = li / 16, nt = li % 16;
      if (even)
        wconv_tile(p.w_out_ab + (size_t)j * 1536 * 1024, 1536, 1024, p.wb_out, kt * 64, nt * 64, 0, tile);
      else
        wconv_tile(p.w_out_c + (size_t)j * 1024 * 1024, 1024, 1024, p.wb_out, kt * 64, nt * 64, 0, tile);
      continue;
    }
    li -= n_out;
    if (li < n_g) {
      int kt = li / 44, nt = li % 44;
      wconv_tile(p.w_gate + (size_t)L * 1024 * 2816, 1024, 2816, p.wb_gu, kt * 64, nt * 64, 1, tile);
      continue;
    }
    li -= n_g;
    if (li < n_g) {
      int kt = li / 44, nt = li % 44;
      wconv_tile(p.w_up + (size_t)L * 1024 * 2816, 1024, 2816, p.wb_gu, kt * 64, nt * 64, 2, tile);
      continue;
    }
    li -= n_g;
    if (li < n_g) {
      int kt = li / 16, nt = li % 16;
      wconv_tile(p.w_down + (size_t)L * 2816 * 1024, 2816, 1024, p.wb_dn, kt * 64, nt * 64, 0, tile);
      continue;
    }
    li -= n_g;
    if (li < 8) wconv_tile(p.w2 + (size_t)j * 64 * 512, 64, 512, p.w2t, 0, li * 64, 0, tile);
    else if (li < 16) wconv_tile(p.a2 + (size_t)j * 64 * 512, 64, 512, p.a2t, 0, (li - 8) * 64, 0, tile);
    else wconv_tile(p.g2 + (size_t)j * 128 * 512, 128, 512, p.g2t, ((li - 16) >> 3) * 64, ((li - 16) & 7) * 64, 0, tile);
  }
}

__device__ void phase_norm(CP p, int L, int which, int bid, int nb) {
  const int tid = otid(), lane = tid & 63, wv = tid >> 6;
  const bool first = (L == 0 && which == 0);
  const float* nw = (which ? p.norm_ffn_w : p.norm_mix_w) + L * 1024;
  float* X = p.out;
  for (int row = bid * 4 + wv; row < NT; row += nb * 4) {
    const float* x = first ? (row < 16384 ? p.x_prompt + (size_t)row * 1024 : p.x_sample + (size_t)(row - 16384) * 1024)
                           : X + (size_t)row * 1024;
    float4 v[4];
    float ss = 0.f;
#pragma unroll
    for (int i = 0; i < 4; i++) {
      v[i] = *(const float4*)(x + i * 256 + lane * 4);
      ss += v[i].x * v[i].x + v[i].y * v[i].y + v[i].z * v[i].z + v[i].w * v[i].w;
    }
    ss = wave_sum(ss);
    float rstd = rsqrtf(ss * (1.f / 1024.f) + 1e-6f);
    int s = row_seq(row);
    const float* md = p.mod + ((size_t)L * 10 + s) * 6144 + (which ? 3072 : 0);
#pragma unroll
    for (int i = 0; i < 4; i++) {
      int c = i * 256 + lane * 4;
      float4 w4 = *(const float4*)(nw + c);
      float4 sh = *(const float4*)(md + c);
      float4 sc = *(const float4*)(md + 1024 + c);
      float h0 = v[i].x * rstd * w4.x * (1.f + sc.x) + sh.x;
      float h1 = v[i].y * rstd * w4.y * (1.f + sc.y) + sh.y;
      float h2 = v[i].z * rstd * w4.z * (1.f + sc.z) + sh.z;
      float h3 = v[i].w * rstd * w4.w * (1.f + sc.w) + sh.w;
      *(uint2*)(p.hm + (size_t)row * 1024 + c) = make_uint2(pack2(h0, h1), pack2(h2, h3));
      if (first) *(float4*)(X + (size_t)row * 1024 + c) = v[i];
    }
  }
}

__device__ void phase_final(CP p, int bid, int nb) {
  const int tid = otid(), lane = tid & 63, wv = tid >> 6;
  float* X = p.out;
  for (int row = bid * 4 + wv; row < NT; row += nb * 4) {
    float* x = X + (size_t)row * 1024;
    float4 v[4];
    float ss = 0.f;
#pragma unroll
    for (int i = 0; i < 4; i++) {
      v[i] = *(const float4*)(x + i * 256 + lane * 4);
      ss += v[i].x * v[i].x + v[i].y * v[i].y + v[i].z * v[i].z + v[i].w * v[i].w;
    }
    ss = wave_sum(ss);
    float rstd = rsqrtf(ss * (1.f / 1024.f) + 1e-6f);
#pragma unroll
    for (int i = 0; i < 4; i++) {
      int c = i * 256 + lane * 4;
      float4 w4 = *(const float4*)(p.norm_out_w + c);
      float4 o;
      o.x = v[i].x * rstd * w4.x;
      o.y = v[i].y * rstd * w4.y;
      o.z = v[i].z * rstd * w4.z;
      o.w = v[i].w * rstd * w4.w;
      *(float4*)(x + c) = o;
    }
  }
}

__device__ void gemm_phase(CP p, const u16* __restrict__ A, int lda, const u16* __restrict__ Bt, int K,
                           int ntn, int epi, u16* __restrict__ outb, int ldo, int ncols, const float* __restrict__ gate,
                           char* smem, int bid, int nb) {
  u16* As = (u16*)smem;
  u16* Bs = As + 128 * 64;
  const int tid = otid(), lane = tid & 63, wv = tid >> 6;
  const int wm = wv >> 1, wn = wv & 1;
  const int lr = tid >> 3, lc = tid & 7;
  const int l15 = lane & 15, lq = lane >> 4;
  const int nk = K >> 6;
  const int nitems = (epi == 2) ? 128 * ntn + 8 * ntn : 129 * ntn;
#define G_DECODE(tile_, mt_, nt_, kt0_, kt1_, split_) { \
    kt0_ = 0; kt1_ = nk; split_ = false; \
    if (epi == 2 && (tile_) >= 128 * ntn) { \
      const int r_ = (tile_) - 128 * ntn; \
      mt_ = 128; nt_ = r_ >> 3; split_ = true; \
      kt0_ = ((r_ & 7) * nk) >> 3; kt1_ = (((r_ & 7) + 1) * nk) >> 3; \
    } else if (epi == 2 && nb == 512 && ntn == 4) { \
        \
      const int slot_ = (tile_) >> 3; \
      mt_ = ((tile_) & 7) * 16 + (slot_ >> 2); nt_ = slot_ & 3; \
    } else { mt_ = (tile_) / ntn; nt_ = (tile_) % ntn; } }
  uint4 ra0, ra1, ra2, ra3, rb0, rb1, rb2, rb3, rb4, rb5, rb6, rb7;
  const int voA = lr * lda + lc * 8, voB = lr * K + lc * 8;
  const int sA = 32 * lda, sB = 32 * K;
#define G_BL(rs_, vo_, so_) __builtin_bit_cast(uint4, __builtin_amdgcn_raw_buffer_load_b128(rs_, vo_, so_, 0))
#define G_LOADP(ab_, bb_, kt_) { \
    __amdgpu_buffer_rsrc_t ra_ = __builtin_amdgcn_make_buffer_rsrc((void*)(ab_), 0, 0x7ffffff0, 0x00020000); \
    __amdgpu_buffer_rsrc_t rb_ = __builtin_amdgcn_make_buffer_rsrc((void*)(bb_), 0, 0x7ffffff0, 0x00020000); \
    const int ka_ = (kt_) * 128; \
    ra0 = G_BL(ra_, voA * 2, ka_); ra1 = G_BL(ra_, voA * 2, ka_ + 2 * sA); ra2 = G_BL(ra_, voA * 2, ka_ + 4 * sA); ra3 = G_BL(ra_, voA * 2, ka_ + 6 * sA); \
    rb0 = G_BL(rb_, voB * 2, ka_); rb1 = G_BL(rb_, voB * 2, ka_ + 2 * sB); rb2 = G_BL(rb_, voB * 2, ka_ + 4 * sB); rb3 = G_BL(rb_, voB * 2, ka_ + 6 * sB); \
    rb4 = G_BL(rb_, voB * 2, ka_ + 8 * sB); rb5 = G_BL(rb_, voB * 2, ka_ + 10 * sB); rb6 = G_BL(rb_, voB * 2, ka_ + 12 * sB); rb7 = G_BL(rb_, voB * 2, ka_ + 14 * sB); }
  bool have = false;
  for (int tile = bid; tile < nitems; tile += nb) {
    int mt, nt, kt0, kt1;
    bool split;
    G_DECODE(tile, mt, nt, kt0, kt1, split)
    const int m0 = mt * 128, n0 = nt * 256;
    f32x4 acc0[4][4], acc1[4][4];
#pragma unroll
    for (int a = 0; a < 4; a++)
#pragma unroll
      for (int b = 0; b < 4; b++) { acc0[a][b] = (f32x4){0.f, 0.f, 0.f, 0.f}; acc1[a][b] = (f32x4){0.f, 0.f, 0.f, 0.f}; }
    const u16* Ab = A + (size_t)m0 * lda;
    const u16* Bb = Bt + (size_t)n0 * K;
    u16* Aw = As + lr * 64 + ((lc ^ (lr & 7)) * 8);
    u16* Bw = Bs + lr * 64 + ((lc ^ (lr & 7)) * 8);
    if (!have) G_LOADP(Ab, Bb, kt0)
    for (int kt = kt0; kt < kt1; kt++) {
      __syncthreads();
      *(uint4*)(Aw) = ra0; *(uint4*)(Aw + 32 * 64) = ra1; *(uint4*)(Aw + 64 * 64) = ra2; *(uint4*)(Aw + 96 * 64) = ra3;
      *(uint4*)(Bw) = rb0; *(uint4*)(Bw + 32 * 64) = rb1; *(uint4*)(Bw + 64 * 64) = rb2; *(uint4*)(Bw + 96 * 64) = rb3;
      *(uint4*)(Bw + 128 * 64) = rb4; *(uint4*)(Bw + 160 * 64) = rb5; *(uint4*)(Bw + 192 * 64) = rb6; *(uint4*)(Bw + 224 * 64) = rb7;
      __syncthreads();
      if (kt + 1 < kt1) G_LOADP(Ab, Bb, kt + 1)
      {
        const int sw0 = (lq ^ (l15 & 7)) * 8, sw1 = ((lq + 4) ^ (l15 & 7)) * 8;
        __builtin_amdgcn_s_setprio(1);
        const u16* Ar = As + (wm * 64 + l15) * 64;
        const u16* Br = Bs + (wn * 128 + l15) * 64;
        bf16x8 af0[4];
#pragma unroll
        for (int mi = 0; mi < 4; mi++) af0[mi] = *(const bf16x8*)(Ar + mi * 16 * 64 + sw0);
        bf16x8 bq0 = *(const bf16x8*)(Br + sw0);
        bf16x8 bq1 = *(const bf16x8*)(Br + 16 * 64 + sw0);
        __builtin_amdgcn_sched_barrier(0);
#define G_STEP(ACC, nidx, bcur, nextni, nextsw, donext) { \
          bf16x8 bn_ = bcur; \
          if (donext) bcur = *(const bf16x8*)(Br + (nextni) * 16 * 64 + (nextsw)); \
          _Pragma("unroll") for (int mi = 0; mi < 4; mi++) \
            ACC[mi][nidx] = __builtin_amdgcn_mfma_f32_16x16x32_bf16(af0[mi], bn_, ACC[mi][nidx], 0, 0, 0); \
          __builtin_amdgcn_sched_barrier(0); }
        G_STEP(acc0, 0, bq0, 2, sw0, true)
        G_STEP(acc0, 1, bq1, 3, sw0, true)
        G_STEP(acc0, 2, bq0, 4, sw0, true)
        G_STEP(acc0, 3, bq1, 5, sw0, true)
        G_STEP(acc1, 0, bq0, 6, sw0, true)
        G_STEP(acc1, 1, bq1, 7, sw0, true)
        G_STEP(acc1, 2, bq0, 0, sw1, true)
        G_STEP(acc1, 3, bq1, 1, sw1, true)
#pragma unroll
        for (int mi = 0; mi < 4; mi++) af0[mi] = *(const bf16x8*)(Ar + mi * 16 * 64 + sw1);
        __builtin_amdgcn_sched_barrier(0);
        G_STEP(acc0, 0, bq0, 2, sw1, true)
        G_STEP(acc0, 1, bq1, 3, sw1, true)
        G_STEP(acc0, 2, bq0, 4, sw1, true)
        G_STEP(acc0, 3, bq1, 5, sw1, true)
        G_STEP(acc1, 0, bq0, 6, sw1, true)
        G_STEP(acc1, 1, bq1, 7, sw1, true)
        G_STEP(acc1, 2, bq0, 0, 0, false)
        G_STEP(acc1, 3, bq1, 0, 0, false)
        __builtin_amdgcn_s_setprio(0);
      }
    }
    {
      const int ntile = tile + nb;
      have = ntile < nitems;
      if (have) {
        int mt2, nt2, k0n, k1n; bool sp2;
        G_DECODE(ntile, mt2, nt2, k0n, k1n, sp2)
        (void)k1n; (void)sp2;
        G_LOADP(A + (size_t)(mt2 * 128) * lda, Bt + (size_t)(nt2 * 256) * K, k0n)
      }
    }
    if (epi == 2) {
#pragma unroll
      for (int mi = 0; mi < 4; mi++)
#pragma unroll
        for (int jj = 0; jj < 4; jj++) {
          int row = m0 + wm * 64 + mi * 16 + lq * 4 + jj;
          int s = row_seq(row);
          const float* g = gate + (size_t)s * 6144;
          float* xr = p.out + (size_t)row * 1024;
#pragma unroll
          for (int ni = 0; ni < 4; ni++) {
            int col = n0 + wn * 128 + ni * 16 + l15;
            if (split) { atomicAdd(&xr[col], g[col] * acc0[mi][ni][jj]); atomicAdd(&xr[col + 64], g[col + 64] * acc1[mi][ni][jj]); }
            else { xr[col] += g[col] * acc0[mi][ni][jj]; xr[col + 64] += g[col + 64] * acc1[mi][ni][jj]; }
          }
        }
    } else if (epi == 0) {
      u16* Cs = (u16*)smem;
#define EPI0_HALF(hp, ACC) { \
        __syncthreads(); \
        _Pragma("unroll") for (int mi = 0; mi < 4; mi++) \
          _Pragma("unroll") for (int n4 = 0; n4 < 4; n4++) \
            _Pragma("unroll") for (int jj = 0; jj < 4; jj++) { \
              int r = wm * 64 + mi * 16 + lq * 4 + jj, c = wn * 64 + n4 * 16 + l15; \
              Cs[r * 136 + c] = f2bf(ACC[mi][n4][jj]); } \
        __syncthreads(); \
        _Pragma("unroll") for (int i = 0; i < 8; i++) { \
          int q = tid + 256 * i; \
          int r = q >> 4, ch = q & 15; \
          int gcol = n0 + (ch >> 3) * 128 + (hp) * 64 + (ch & 7) * 8; \
          if (gcol < ncols) *(uint4*)(outb + (size_t)(m0 + r) * ldo + gcol) = *(const uint4*)(Cs + r * 136 + ch * 8); } }
      EPI0_HALF(0, acc0)
      EPI0_HALF(1, acc1)
    } else {
      __syncthreads();
      u16* Cs = (u16*)smem;
#pragma unroll
      for (int mi = 0; mi < 4; mi++)
#pragma unroll
        for (int i2 = 0; i2 < 2; i2++)
#pragma unroll
          for (int jj = 0; jj < 4; jj++) {
            int r = wm * 64 + mi * 16 + lq * 4 + jj, c = wn * 64 + i2 * 16 + l15;
            float g0 = acc0[mi][2 * i2][jj], u0 = acc0[mi][2 * i2 + 1][jj];
            float g1 = acc1[mi][2 * i2][jj], u1 = acc1[mi][2 * i2 + 1][jj];
            Cs[r * 136 + c] = f2bf(silu_(g0) * u0);
            Cs[r * 136 + c + 32] = f2bf(silu_(g1) * u1);
          }
      __syncthreads();
#pragma unroll
      for (int i = 0; i < 8; i++) {
        int q = tid + 256 * i;
        int r = q >> 4, ch = q & 15;
        *(uint4*)(outb + (size_t)(m0 + r) * ldo + nt * 128 + ch * 8) = *(const uint4*)(Cs + r * 136 + ch * 8);
      }
    }
  }
}

__device__ void phase_prep_even(CP p, int j, char* smem, int bid, int nb) {
  const int tid = otid();
  const u16* P = p.pbuf;
  {
    u16* txb = (u16*)smem;
    u16* xab = txb + 16 * 72;
    float* resw = (float*)(xab + 16 * 72);
    float* resa = resw + 8 * 512;
    for (int i = tid; i < 2 * 16 * 72; i += 256) txb[i] = 0;
    const int half = tid >> 7, hk = tid & 127, h = hk >> 4, kq = hk & 15;
    const int c4 = h * 64 + kq * 4;
    const float* mu = p.mu_a + j * 1792;
    for (int u = bid; u < NT / 8; u += nb) {
      const int m0 = u * 8;
      const int s = row_seq(m0);
      const int r0 = seq_row0(s);
      __syncthreads();
#pragma unroll
      for (int i = 0; i < 4; i++) {
        int idx = tid + 256 * i;
        int tok = idx >> 7, cc = idx & 127;
        int m = m0 + tok;
        int col = 1536 + cc;
        float pc = bf2f(P[(size_t)m * PSTR + col]);
        float pp = (m > r0) ? bf2f(P[(size_t)(m - 1) * PSTR + col])
                            : (s >= 2 ? p.st_shift[((size_t)(s - 2) * 2 + j) * 1792 + col] : 0.f);
        float pm = pc + (pp - pc) * mu[col];
        if (cc < 64)
          txb[tok * 72 + cc] = f2bf(tanh_(pm));
        else
          xab[tok * 72 + cc - 64] = f2bf(pm);
      }
      __syncthreads();
      {
        const int lane = tid & 63, wv = tid >> 6, l15 = lane & 15, lq = lane >> 4;
        bf16x8 aw[2], aa[2];
#pragma unroll
        for (int ks = 0; ks < 2; ks++) {
          aw[ks] = *(const bf16x8*)(txb + l15 * 72 + ks * 32 + lq * 8);
          aa[ks] = *(const bf16x8*)(xab + l15 * 72 + ks * 32 + lq * 8);
        }
#pragma unroll
        for (int nt = 0; nt < 8; nt++) {
          const int n = wv * 128 + nt * 16 + l15;
          f32x4 cw = (f32x4){0.f, 0.f, 0.f, 0.f}, ca = (f32x4){0.f, 0.f, 0.f, 0.f};
#pragma unroll
          for (int ks = 0; ks < 2; ks++) {
            bf16x8 bw = *(const bf16x8*)(p.w2t + (size_t)n * 64 + ks * 32 + lq * 8);
            bf16x8 ba = *(const bf16x8*)(p.a2t + (size_t)n * 64 + ks * 32 + lq * 8);
            cw = __builtin_amdgcn_mfma_f32_16x16x32_bf16(aw[ks], bw, cw, 0, 0, 0);
            ca = __builtin_amdgcn_mfma_f32_16x16x32_bf16(aa[ks], ba, ca, 0, 0, 0);
          }
          if (lq < 2) {
#pragma unroll
            for (int jj = 0; jj < 4; jj++) {
              resw[(lq * 4 + jj) * 512 + n] = cw[jj];
              resa[(lq * 4 + jj) * 512 + n] = ca[jj];
            }
          }
        }
      }
      __syncthreads();
      float accw[4][4], acca[4][4];
#pragma unroll
      for (int tk = 0; tk < 4; tk++) {
        float4 rw4 = *(const float4*)(resw + (half * 4 + tk) * 512 + c4);
        float4 ra4 = *(const float4*)(resa + (half * 4 + tk) * 512 + c4);
        accw[tk][0] = rw4.x; accw[tk][1] = rw4.y; accw[tk][2] = rw4.z; accw[tk][3] = rw4.w;
        acca[tk][0] = ra4.x; acca[tk][1] = ra4.y; acca[tk][2] = ra4.z; acca[tk][3] = ra4.w;
      }
      float4 w0v = *(const float4*)(p.w0 + j * 512 + c4);
      float4 a0v = *(const float4*)(p.a0 + j * 512 + c4);
      float4 kkv = *(const float4*)(p.k_k + j * 512 + c4);
      float4 kav = *(const float4*)(p.k_a + j * 512 + c4);
      float4 rkv = *(const float4*)(p.r_k + j * 512 + c4);
      float4 mur = *(const float4*)(mu + c4);
      float4 muk = *(const float4*)(mu + 512 + c4);
      float4 muv = *(const float4*)(mu + 1024 + c4);
      const float w0a[4] = {w0v.x, w0v.y, w0v.z, w0v.w};
      const float a0a[4] = {a0v.x, a0v.y, a0v.z, a0v.w};
      const float kka[4] = {kkv.x, kkv.y, kkv.z, kkv.w};
      const float kaa[4] = {kav.x, kav.y, kav.z, kav.w};
      const float rka[4] = {rkv.x, rkv.y, rkv.z, rkv.w};
      const float mura[4] = {mur.x, mur.y, mur.z, mur.w};
      const float muka[4] = {muk.x, muk.y, muk.z, muk.w};
      const float muva[4] = {muv.x, muv.y, muv.z, muv.w};
#pragma unroll
      for (int tk = 0; tk < 4; tk++) {
        const int m = m0 + half * 4 + tk;
        uint2 pr = *(const uint2*)(P + (size_t)m * PSTR + c4);
        uint2 pk = *(const uint2*)(P + (size_t)m * PSTR + 512 + c4);
        uint2 pv = *(const uint2*)(P + (size_t)m * PSTR + 1024 + c4);
        float rc[4] = {lo16(pr.x), hi16(pr.x), lo16(pr.y), hi16(pr.y)};
        float kc[4] = {lo16(pk.x), hi16(pk.x), lo16(pk.y), hi16(pk.y)};
        float vc[4] = {lo16(pv.x), hi16(pv.x), lo16(pv.y), hi16(pv.y)};
        float rp[4], kp[4], vp[4];
        if (m > r0) {
          uint2 qr = *(const uint2*)(P + (size_t)(m - 1) * PSTR + c4);
          uint2 qk = *(const uint2*)(P + (size_t)(m - 1) * PSTR + 512 + c4);
          uint2 qv = *(const uint2*)(P + (size_t)(m - 1) * PSTR + 1024 + c4);
          rp[0] = lo16(qr.x); rp[1] = hi16(qr.x); rp[2] = lo16(qr.y); rp[3] = hi16(qr.y);
          kp[0] = lo16(qk.x); kp[1] = hi16(qk.x); kp[2] = lo16(qk.y); kp[3] = hi16(qk.y);
          vp[0] = lo16(qv.x); vp[1] = hi16(qv.x); vp[2] = lo16(qv.y); vp[3] = hi16(qv.y);
        } else if (s >= 2) {
          const float* sp = p.st_shift + ((size_t)(s - 2) * 2 + j) * 1792;
#pragma unroll
          for (int e = 0; e < 4; e++) { rp[e] = sp[c4 + e]; kp[e] = sp[512 + c4 + e]; vp[e] = sp[1024 + c4 + e]; }
        } else {
#pragma unroll
          for (int e = 0; e < 4; e++) { rp[e] = 0.f; kp[e] = 0.f; vp[e] = 0.f; }
        }
        float r[4], k[4], v[4], kk[4], kn[4], bb[4], ee[4];
        float ssq = 0.f, bsum = 0.f;
#pragma unroll
        for (int e = 0; e < 4; e++) {
          r[e] = rc[e] + (rp[e] - rc[e]) * mura[e];
          k[e] = kc[e] + (kp[e] - kc[e]) * muka[e];
          v[e] = vc[e] + (vp[e] - vc[e]) * muva[e];
          float wpre = w0a[e] + accw[tk][e];
          float w = -softplus_(-wpre) - 0.5f;
          { const float ew = __expf(w); ee[e] = ew < 1e-3f ? ew * (1.f - 0.5f * ew) : 1.f - __expf(-ew); }
          float a = sigm(a0a[e] + acca[tk][e]);
          kk[e] = k[e] * kka[e];
          ssq += kk[e] * kk[e];
          kn[e] = k[e] * (1.f + (a - 1.f) * kaa[e]);
          bb[e] = a;
          bsum += r[e] * kn[e] * rka[e];
        }
        ssq = red16(ssq);
        bsum = red16(bsum);
        float inv = rsqrtf(fmaxf(ssq, 1e-24f));
#pragma unroll
        for (int e = 0; e < 4; e++) { kk[e] *= inv; bb[e] = kk[e] * bb[e]; }
        if (kq == 0) p.bonus[(size_t)m * 8 + h] = bsum;
        uint4* dst = (uint4*)(p.rw + (((size_t)m * 8 + h) * 16 + kq) * 24);
        dst[0] = make_uint4(pack2(r[0], r[1]), pack2(r[2], r[3]), pack2(kn[0], kn[1]), pack2(kn[2], kn[3]));
        dst[1] = make_uint4(pack2(kk[0], kk[1]), pack2(kk[2], kk[3]), pack2(bb[0], bb[1]), pack2(bb[2], bb[3]));
        dst[2] = make_uint4(pack2(ee[0], ee[1]), pack2(ee[2], ee[3]), pack2(v[0], v[1]), pack2(v[2], v[3]));
      }
    }
  }
  for (int idx = bid * 256 + tid; idx < 10 * 1792; idx += nb * 256) {
    int s = idx / 1792, c = idx % 1792;
    int m = seq_row0(s) + seq_len(s) - 1;
    float* o = out_state(p.out, s, j, O_SHIFT_P, O_SHIFT_S, 1792);
    o[c] = bf2f(P[(size_t)m * PSTR + c]);
  }
  for (int u = bid; u < NT / 16; u += nb) {
    const int mb = u * 16;
    const int s = row_seq(mb);
    const int r0 = seq_row0(s);
    if (tid < 192) {
      const int c0 = tid * 8;
      const int t0 = mb - r0;
      float wgt[4][8], bia[8];
      {
        float4 b0 = *(const float4*)(p.conv_b + j * 1536 + c0), b1 = *(const float4*)(p.conv_b + j * 1536 + c0 + 4);
        bia[0] = b0.x; bia[1] = b0.y; bia[2] = b0.z; bia[3] = b0.w; bia[4] = b1.x; bia[5] = b1.y; bia[6] = b1.z; bia[7] = b1.w;
#pragma unroll
        for (int tap = 0; tap < 4; tap++) {
          const float* cw = p.conv_w + ((size_t)j * 4 + tap) * 1536 + c0;
          float4 w0 = *(const float4*)cw, w1 = *(const float4*)(cw + 4);
          wgt[tap][0] = w0.x; wgt[tap][1] = w0.y; wgt[tap][2] = w0.z; wgt[tap][3] = w0.w;
          wgt[tap][4] = w1.x; wgt[tap][5] = w1.y; wgt[tap][6] = w1.z; wgt[tap][7] = w1.w;
        }
      }
#pragma unroll 1
      for (int hf = 0; hf < 2; hf++) {
      uint4 rows[11];
#pragma unroll
      for (int i = 0; i < 11; i++) {
        const int tt = t0 + hf * 8 - 3 + i;
        if (tt >= 0) {
          rows[i] = *(const uint4*)(P + (size_t)(r0 + tt) * PSTR + 2816 + c0);
        } else if (s >= 2) {
          const float* cs = p.st_conv + (((size_t)(s - 2) * 2 + j) * 3 + (tt + 3)) * 1536 + c0;
          float4 q0 = *(const float4*)cs, q1 = *(const float4*)(cs + 4);
          rows[i] = make_uint4(pack2(q0.x, q0.y), pack2(q0.z, q0.w), pack2(q1.x, q1.y), pack2(q1.z, q1.w));
        } else {
          rows[i] = make_uint4(0, 0, 0, 0);
        }
      }
#pragma unroll
      for (int t = 0; t < 8; t++) {
        float acc[8];
#pragma unroll
        for (int e = 0; e < 8; e++) acc[e] = bia[e];
#pragma unroll
        for (int tap = 0; tap < 4; tap++) {
          const uint4 q = rows[t + tap];
          acc[0] += wgt[tap][0] * lo16(q.x); acc[1] += wgt[tap][1] * hi16(q.x);
          acc[2] += wgt[tap][2] * lo16(q.y); acc[3] += wgt[tap][3] * hi16(q.y);
          acc[4] += wgt[tap][4] * lo16(q.z); acc[5] += wgt[tap][5] * hi16(q.z);
          acc[6] += wgt[tap][6] * lo16(q.w); acc[7] += wgt[tap][7] * hi16(q.w);
        }
        *(uint4*)(p.cv + (size_t)(mb + hf * 8 + t) * 1536 + c0) =
            make_uint4(pack2(silu_(acc[0]), silu_(acc[1])), pack2(silu_(acc[2]), silu_(acc[3])),
                       pack2(silu_(acc[4]), silu_(acc[5])), pack2(silu_(acc[6]), silu_(acc[7])));
      }
      }
    }
    {
      int tok = tid >> 4, hh = tid & 15;
      int m = mb + tok;
      float dtv = softplus_(bf2f(P[(size_t)m * PSTR + 4352 + hh]) + p.dt_bias[j * 16 + hh]);
      float* cs = (float*)smem;
      __syncthreads();
      cs[tid] = -dtv * __expf(p.a_log[j * 16 + hh]);
      __syncthreads();
      float G = 0.f;
      for (int i = 0; i <= tok; i++) G += cs[i * 16 + hh];
      p.dtb[(size_t)m * 32 + hh] = dtv;
      p.dtb[(size_t)m * 32 + 16 + hh] = G;
    }
  }
  for (int idx = bid * 256 + tid; idx < 10 * 3 * 1536; idx += nb * 256) {
    int s = idx / 4608, rem = idx % 4608;
    int r = rem / 1536, c = rem % 1536;
    int m = seq_row0(s) + seq_len(s) - 3 + r;
    float* o = out_state(p.out, s, j, O_CONV_P, O_CONV_S, 4608);
    o[rem] = bf2f(P[(size_t)m * PSTR + 2816 + c]);
  }
}

__device__ __forceinline__ void cvt8_store(float* d, uint4 v) {
  *(float4*)d = make_float4(lo16(v.x), hi16(v.x), lo16(v.y), hi16(v.y));
  *(float4*)(d + 4) = make_float4(lo16(v.z), hi16(v.z), lo16(v.w), hi16(v.w));
}

#define RK_NOC 4
#define RK_BASE(p) ((p).scr + 2100000)
#define RK_LS(p) (RK_BASE(p))
#define RK_PS(p) (RK_BASE(p) + 262144)
#define RK_SI(p) (RK_BASE(p) + 524288)
template <int PART>
__device__ __forceinline__ void rwkv_scan_item(CP p, int j, int s, int h, int rg, int oc, int noc, char* smem) {
  float* Lb = (float*)smem;
  float* ob = Lb + 2 * 16 * 16 * 28;
  const int tid = otid(), lane = tid & 63, wv = tid >> 6;
  const int rl = lane >> 4, kq = lane & 15;
  const int R = rg * 16 + wv * 4 + rl;
  const int T = seq_len(s) / noc, m0 = seq_row0(s) + oc * T;
  float S[4];
  if (PART == 1) {
#pragma unroll
    for (int e = 0; e < 4; e++) S[e] = (R == kq * 4 + e) ? 1.f : 0.f;
  } else if (s >= 2) {
    float4 q = *(const float4*)(p.st_rwkv + ((((size_t)(s - 2) * 2 + j) * 8 + h) * 64 + R) * 64 + kq * 4);
    S[0] = q.x; S[1] = q.y; S[2] = q.z; S[3] = q.w;
  } else {
    S[0] = S[1] = S[2] = S[3] = 0.f;
  }
  const u16* src = p.rw + ((size_t)m0 * 8 + h) * 16 * 24;
  const int q0 = tid, q1 = tid + 256, q2 = tid + 512;
  const int so0 = (q0 / 48) * 3072 + (q0 % 48) * 8, so1 = (q1 / 48) * 3072 + (q1 % 48) * 8,
            so2 = (q2 / 48) * 3072 + (q2 % 48) * 8;
  const int do0 = ((q0 / 48) * 16 + (q0 % 48) / 3) * 28 + ((q0 % 48) % 3) * 8,
            do1 = ((q1 / 48) * 16 + (q1 % 48) / 3) * 28 + ((q1 % 48) % 3) * 8,
            do2 = ((q2 / 48) * 16 + (q2 % 48) / 3) * 28 + ((q2 % 48) % 3) * 8;
  u16* outp = PART ? p.ub + (size_t)(m0 + (tid >> 4)) * 512 + h * 64 + rg * 16 + (tid & 15)
                   : p.hm + (size_t)(m0 + (tid >> 4)) * 1536 + h * 64 + rg * 16 + (tid & 15);
  const int ostr = PART ? 16 * 512 : 16 * 1536;
  const int nbat = T >> 4;
  uint4 a0, a1, a2, c0, c1, c2;
#define RW_ISSUE(r0, r1, r2, bt) { const u16* sp_ = src + (size_t)(bt) * 16 * 3072; \
    r0 = *(const uint4*)(sp_ + so0); r1 = *(const uint4*)(sp_ + so1); r2 = *(const uint4*)(sp_ + so2); }
#define RW_STASH(r0, r1, r2, bi) { float* d_ = Lb + (bi) * (16 * 16 * 28); \
    cvt8_store(d_ + do0, r0); cvt8_store(d_ + do1, r1); cvt8_store(d_ + do2, r2); }
#define RW_COMPUTE(bt) { \
    const float* cur = Lb + ((bt) & 1) * (16 * 16 * 28); \
    float* obc = ob + ((bt) & 1) * 256; \
    float op[16]; \
    f32x2_t Sa = {S[0], S[1]}, Sb = {S[2], S[3]}; \
    _Pragma("unroll") for (int st = 0; st < 16; st++) { \
      const float* sl = cur + (st * 16 + kq) * 28; \
      float4 r4 = *(const float4*)(sl), k4 = *(const float4*)(sl + 4), kk4 = *(const float4*)(sl + 8), \
             b4 = *(const float4*)(sl + 12), e4 = *(const float4*)(sl + 16); \
      float v = PART ? 0.f : cur[(st * 16 + (R >> 2)) * 28 + 20 + (R & 3)]; \
      f32x2_t t_ = Sa * (f32x2_t){kk4.x, kk4.y}; \
      t_ = Sb * (f32x2_t){kk4.z, kk4.w} + t_; \
      const float sa = -red16(t_.x + t_.y); \
      Sa = Sa - Sa * (f32x2_t){e4.x, e4.y}; Sb = Sb - Sb * (f32x2_t){e4.z, e4.w}; \
      if (!PART) { Sa = (f32x2_t){v, v} * (f32x2_t){k4.x, k4.y} + Sa; Sb = (f32x2_t){v, v} * (f32x2_t){k4.z, k4.w} + Sb; } \
      Sa = (f32x2_t){sa, sa} * (f32x2_t){b4.x, b4.y} + Sa; Sb = (f32x2_t){sa, sa} * (f32x2_t){b4.z, b4.w} + Sb; \
      f32x2_t u_ = Sa * (f32x2_t){r4.x, r4.y}; \
      u_ = Sb * (f32x2_t){r4.z, r4.w} + u_; \
      op[st] = u_.x + u_.y; \
      if ((st & 3) == 3) __builtin_amdgcn_sched_barrier(0); \
    } \
    S[0] = Sa.x; S[1] = Sa.y; S[2] = Sb.x; S[3] = Sb.y; \
      \
    { const bool b3_ = (kq & 8) != 0, b2_ = (kq & 4) != 0, b1_ = (kq & 2) != 0, b0_ = (kq & 1) != 0; \
      float s1_[8], s2_[4], s3_[2]; \
      _Pragma("unroll") for (int i = 0; i < 8; i++) s1_[i] = (b3_ ? op[i + 8] : op[i]) + dpp_f<0x140>(b3_ ? op[i] : op[i + 8]); \
      _Pragma("unroll") for (int i = 0; i < 4; i++) s2_[i] = (b2_ ? s1_[i + 4] : s1_[i]) + dpp_f<0x141>(b2_ ? s1_[i] : s1_[i + 4]); \
      _Pragma("unroll") for (int i = 0; i < 2; i++) s3_[i] = (b1_ ? s2_[i + 2] : s2_[i]) + dpp_f<0x1B>(b1_ ? s2_[i] : s2_[i + 2]); \
      const float tot_ = (b0_ ? s3_[1] : s3_[0]) + dpp_f<0xB1>(b0_ ? s3_[0] : s3_[1]); \
      obc[kq * 16 + wv * 4 + rl] = tot_; } }
#define RW_OUT(bt) { outp[(size_t)(bt) * ostr] = f2bf(ob[((bt) & 1) * 256 + tid]); }
  __syncthreads();
  RW_ISSUE(a0, a1, a2, 0)
  RW_STASH(a0, a1, a2, 0)
  if (1 < nbat) RW_ISSUE(a0, a1, a2, 1)
  if (2 < nbat) RW_ISSUE(c0, c1, c2, 2)
  __syncthreads();
  for (int b = 0; b < nbat; b += 2) {
    RW_COMPUTE(b)
    if (b + 1 < nbat) RW_STASH(a0, a1, a2, 1)
    __syncthreads();
    RW_OUT(b)
    if (b + 1 >= nbat) break;
    if (b + 3 < nbat) RW_ISSUE(a0, a1, a2, b + 3)
    RW_COMPUTE(b + 1)
    if (b + 2 < nbat) RW_STASH(c0, c1, c2, 0)
    __syncthreads();
    RW_OUT(b + 1)
    if (b + 4 < nbat) RW_ISSUE(c0, c1, c2, b + 4)
  }
  if (noc == 1) {
    float* o = out_state(p.out, s, j, O_RWKV_P, O_RWKV_S, 32768);
    *(float4*)(o + ((size_t)h * 64 + R) * 64 + kq * 4) = make_float4(S[0], S[1], S[2], S[3]);
  } else {
    float* o = (PART ? RK_PS(p) : RK_LS(p)) + (size_t)((s * 8 + h) * 4 + oc) * 4096;
    *(float4*)(o + (size_t)R * 64 + kq * 4) = make_float4(S[0], S[1], S[2], S[3]);
  }
  __syncthreads();
}

__device__ __forceinline__ void rwkv_combine_item(CP p, int j, int s, int h, char* smem) {
  float* Sl = (float*)smem;
  const int tid = otid();
  const int r = tid >> 2, jq = tid & 3;
  const size_t idx0 = (size_t)(s * 8 + h) * 4;
  float cur[16];
  {
    const float* l0 = RK_LS(p) + idx0 * 4096 + r * 64 + jq * 16;
#pragma unroll
    for (int c = 0; c < 16; c++) cur[c] = l0[c];
  }
  for (int oc = 1; oc < RK_NOC; oc++) {
    float* si = RK_SI(p) + (idx0 + oc) * 4096 + r * 64 + jq * 16;
    __syncthreads();
#pragma unroll
    for (int c = 0; c < 16; c++) { si[c] = cur[c]; Sl[r * 65 + jq * 16 + c] = cur[c]; }
    __syncthreads();
    float nx[16];
    {
      const float* lo = RK_LS(p) + (idx0 + oc) * 4096 + r * 64 + jq * 16;
#pragma unroll
      for (int c = 0; c < 16; c++) nx[c] = lo[c];
    }
    const float* pm = RK_PS(p) + (idx0 + oc) * 4096 + jq * 16;
    for (int i = 0; i < 64; i++) {
      const float sv = Sl[r * 65 + i];
      const float4 p0 = *(const float4*)(pm + i * 64), p1 = *(const float4*)(pm + i * 64 + 4),
                   p2 = *(const float4*)(pm + i * 64 + 8), p3 = *(const float4*)(pm + i * 64 + 12);
      nx[0] += sv * p0.x; nx[1] += sv * p0.y; nx[2] += sv * p0.z; nx[3] += sv * p0.w;
      nx[4] += sv * p1.x; nx[5] += sv * p1.y; nx[6] += sv * p1.z; nx[7] += sv * p1.w;
      nx[8] += sv * p2.x; nx[9] += sv * p2.y; nx[10] += sv * p2.z; nx[11] += sv * p2.w;
      nx[12] += sv * p3.x; nx[13] += sv * p3.y; nx[14] += sv * p3.z; nx[15] += sv * p3.w;
    }
#pragma unroll
    for (int c = 0; c < 16; c++) cur[c] = nx[c];
  }
  float* o = out_state(p.out, s, j, O_RWKV_P, O_RWKV_S, 32768) + ((size_t)h * 64 + r) * 64 + jq * 16;
#pragma unroll
  for (int c = 0; c < 16; c++) o[c] = cur[c];
  __syncthreads();
}

typedef __attribute__((ext_vector_type(4))) short bf16x4;
#define MB_SL(p) ((p).scr)
#define MB_DD(p) ((p).scr + 256 * 8192)
#define MB_NOC 8
template <int MODE>
__device__ __forceinline__ void mamba_scan_item(CP p, int j, int s, int h, int oc, int noc, char* smem) {
  u16* Bs = (u16*)smem;
  u16* Cs = Bs + 2 * 16 * 136;
  u16* BTs = Cs + 2 * 16 * 136;
  u16* XTs = BTs + 2 * 128 * 24;
  u16* XBs = XTs + 2 * 64 * 24;
  u16* SsT = XBs + 2 * 64 * 24;
  float* Gs = (float*)(SsT + 64 * 136);
  const int tid = otid(), lane = tid & 63, wv = tid >> 6;
  const int l15 = lane & 15, lq = lane >> 4;
  const int g = h >> 3;
  const int T = seq_len(s);
  const int nch = (T >> 4) / noc;
  const int m0 = seq_row0(s) + oc * nch * 16;
  f32x4 acc[8];
#pragma unroll
  for (int nt = 0; nt < 8; nt++) acc[nt] = (f32x4){0.f, 0.f, 0.f, 0.f};
  float prodD = 1.f;
  if (MODE == 1) {
    if (s >= 2) {
      const float* sp = p.st_ssm + (((size_t)(s - 2) * 2 + j) * 16 + h) * 8192 + (size_t)(wv * 16 + lq * 4) * 128 + l15;
#pragma unroll
      for (int nt = 0; nt < 8; nt++)
        acc[nt] = (f32x4){sp[nt * 16], sp[128 + nt * 16], sp[256 + nt * 16], sp[384 + nt * 16]};
    } else {
      for (int cp = 0; cp < oc; cp++) {
        const size_t idx = (size_t)((s * 16 + h) * 8 + cp);
        const float dd = MB_DD(p)[idx];
        const float* sp = MB_SL(p) + idx * 8192 + (size_t)(wv * 16 + lq * 4) * 128 + l15;
#pragma unroll
        for (int nt = 0; nt < 8; nt++)
          acc[nt] = (f32x4){acc[nt][0] * dd + sp[nt * 16], acc[nt][1] * dd + sp[128 + nt * 16],
                            acc[nt][2] * dd + sp[256 + nt * 16], acc[nt][3] * dd + sp[384 + nt * 16]};
      }
    }
  }
  const u16* Pb = p.cv + (size_t)(m0 + (tid >> 4)) * 1536 + 1024 + g * 128 + (tid & 15) * 8;
  const u16* Px = p.cv + (size_t)(m0 + ((tid >> 3) & 15)) * 1536 + h * 64 + (tid & 7) * 8;
  const float* Pdt = p.dtb + (size_t)(m0 + ((tid >> 3) & 15)) * 32 + h;
  const float* PgL = p.dtb + (size_t)(m0 + 15) * 32 + 16 + h;
  const float* PG = p.dtb + (size_t)(m0 + (tid & 15)) * 32 + 16 + h;
  uint4 ab, ac, ax, cb, cc, cx;
  float adt = 0.f, ag = 0.f, agl = 0.f, aG = 0.f, cdt = 0.f, cg = 0.f, cgl = 0.f, cG = 0.f;
  ab = make_uint4(0, 0, 0, 0); ac = ab; ax = ab; cb = ab; cc = ab; cx = ab;
#define MM_ISSUE(rb, rc, rx, rdt, rg, rgl, rG, c) { \
    rb = *(const uint4*)(Pb + (size_t)(c) * 16 * 1536); \
    if (MODE == 1) rc = *(const uint4*)(Pb + (size_t)(c) * 16 * 1536 + 256); \
    if (tid < 128) { rx = *(const uint4*)(Px + (size_t)(c) * 16 * 1536); rdt = Pdt[(size_t)(c) * 16 * 32]; \
      rg = Pdt[(size_t)(c) * 16 * 32 + 16]; rgl = PgL[(size_t)(c) * 16 * 32]; } \
    if (tid < 16) rG = PG[(size_t)(c) * 16 * 32]; }
#define MM_T8(dst, rv, sc) { \
      dst[0 * 24] = f2bf(lo16(rv.x) * (sc)); dst[1 * 24] = f2bf(hi16(rv.x) * (sc)); dst[2 * 24] = f2bf(lo16(rv.y) * (sc)); dst[3 * 24] = f2bf(hi16(rv.y) * (sc)); \
      dst[4 * 24] = f2bf(lo16(rv.z) * (sc)); dst[5 * 24] = f2bf(hi16(rv.z) * (sc)); dst[6 * 24] = f2bf(lo16(rv.w) * (sc)); dst[7 * 24] = f2bf(hi16(rv.w) * (sc)); }
#define MM_STASH(rb, rc, rx, rdt, rg, rgl, rG, bi) { \
    if (MODE == 1) { *(uint4*)(Bs + (bi) * (16 * 136) + (tid >> 4) * 136 + (tid & 15) * 8) = rb; \
                     *(uint4*)(Cs + (bi) * (16 * 136) + (tid >> 4) * 136 + (tid & 15) * 8) = rc; } \
    { u16* bd_ = BTs + (bi) * (128 * 24) + ((tid & 15) * 8) * 24 + (tid >> 4); \
      bd_[0 * 24] = (u16)(rb.x & 0xffff); bd_[1 * 24] = (u16)(rb.x >> 16); bd_[2 * 24] = (u16)(rb.y & 0xffff); bd_[3 * 24] = (u16)(rb.y >> 16); \
      bd_[4 * 24] = (u16)(rb.z & 0xffff); bd_[5 * 24] = (u16)(rb.z >> 16); bd_[6 * 24] = (u16)(rb.w & 0xffff); bd_[7 * 24] = (u16)(rb.w >> 16); } \
    if (tid < 128) { const float sb_ = rdt * __expf(rgl - rg); \
      u16* xb_ = XBs + (bi) * (64 * 24) + ((tid & 7) * 8) * 24 + (tid >> 3); MM_T8(xb_, rx, sb_) \
      if (MODE == 1) { u16* xt_ = XTs + (bi) * (64 * 24) + ((tid & 7) * 8) * 24 + (tid >> 3); MM_T8(xt_, rx, rdt) } } \
    if (tid < 16) { Gs[(bi) * 32 + tid] = rG; if (tid == 15) Gs[(bi) * 32 + 16] = __expf(rG); } }
  __syncthreads();
  MM_ISSUE(ab, ac, ax, adt, ag, agl, aG, 0)
  MM_STASH(ab, ac, ax, adt, ag, agl, aG, 0)
  if (1 < nch) MM_ISSUE(ab, ac, ax, adt, ag, agl, aG, 1)
  if (2 < nch) MM_ISSUE(cb, cc, cx, cdt, cg, cgl, cG, 2)
  for (int c = 0; c < nch; c++) {
    const int bi = c & 1;
    if (MODE == 1) {
#pragma unroll
      for (int nt = 0; nt < 8; nt++)
#pragma unroll
        for (int jj = 0; jj < 4; jj++)
          SsT[(wv * 16 + lq * 4 + jj) * 136 + nt * 16 + l15] = f2bf(acc[nt][jj]);
    }
    __syncthreads();
    if (c + 1 < nch) {
      if (bi == 0) { MM_STASH(ab, ac, ax, adt, ag, agl, aG, 1) if (c + 3 < nch) MM_ISSUE(ab, ac, ax, adt, ag, agl, aG, c + 3) }
      else { MM_STASH(cb, cc, cx, cdt, cg, cgl, cG, 0) if (c + 3 < nch) MM_ISSUE(cb, cc, cx, cdt, cg, cgl, cG, c + 3) }
    }
    const u16* Bc = Bs + bi * (16 * 136);
    const u16* Cc = Cs + bi * (16 * 136);
    const u16* BTc = BTs + bi * (128 * 24);
    const u16* XTc = XTs + bi * (64 * 24);
    const u16* XBc = XBs + bi * (64 * 24);
    const float* Gc = Gs + bi * 32;
    if (MODE == 1) {
      f32x4 at = (f32x4){0.f, 0.f, 0.f, 0.f};
      bf16x8 cf[4];
#pragma unroll
      for (int ks = 0; ks < 4; ks++) {
        bf16x8 bfv = *(const bf16x8*)(Bc + l15 * 136 + ks * 32 + lq * 8);
        cf[ks] = *(const bf16x8*)(Cc + l15 * 136 + ks * 32 + lq * 8);
        at = __builtin_amdgcn_mfma_f32_16x16x32_bf16(bfv, cf[ks], at, 0, 0, 0);
      }
      const float Gt = Gc[l15];
      bf16x4 bat;
#pragma unroll
      for (int jj = 0; jj < 4; jj++) {
        const int sidx = lq * 4 + jj;
        bat[jj] = (short)f2bf(sidx <= l15 ? at[jj] * __expf(Gt - Gc[sidx]) : 0.f);
      }
      bf16x4 xt = *(const bf16x4*)(XTc + (wv * 16 + l15) * 24 + lq * 4);
      f32x4 ao1 = (f32x4){0.f, 0.f, 0.f, 0.f};
      ao1 = __builtin_amdgcn_mfma_f32_16x16x16bf16_1k(xt, bat, ao1, 0, 0, 0);
      f32x4 ao2 = (f32x4){0.f, 0.f, 0.f, 0.f};
#pragma unroll
      for (int ks = 0; ks < 4; ks++) {
        bf16x8 sf = *(const bf16x8*)(SsT + (wv * 16 + l15) * 136 + ks * 32 + lq * 8);
        ao2 = __builtin_amdgcn_mfma_f32_16x16x32_bf16(sf, cf[ks], ao2, 0, 0, 0);
      }
      const float eg = __expf(Gt);
      *(uint2*)(p.hm + (size_t)(m0 + c * 16 + l15) * 1536 + 512 + h * 64 + wv * 16 + lq * 4) =
          make_uint2(pack2(ao1[0] + ao2[0] * eg, ao1[1] + ao2[1] * eg), pack2(ao1[2] + ao2[2] * eg, ao1[3] + ao2[3] * eg));
    }
    {
      const float eGL = Gc[16];
      if (MODE == 0) prodD *= eGL;
      bf16x4 xb = *(const bf16x4*)(XBc + (wv * 16 + l15) * 24 + lq * 4);
#pragma unroll
      for (int nt = 0; nt < 8; nt++) {
        bf16x4 bt = *(const bf16x4*)(BTc + (nt * 16 + l15) * 24 + lq * 4);
        f32x4 cin = (f32x4){acc[nt][0] * eGL, acc[nt][1] * eGL, acc[nt][2] * eGL, acc[nt][3] * eGL};
        acc[nt] = __builtin_amdgcn_mfma_f32_16x16x16bf16_1k(xb, bt, cin, 0, 0, 0);
      }
    }
  }
  if (MODE == 0) {
    const size_t idx = (size_t)((s * 16 + h) * 8 + oc);
    float* sp = MB_SL(p) + idx * 8192 + (size_t)(wv * 16 + lq * 4) * 128 + l15;
#pragma unroll
    for (int nt = 0; nt < 8; nt++) {
      sp[nt * 16] = acc[nt][0]; sp[128 + nt * 16] = acc[nt][1]; sp[256 + nt * 16] = acc[nt][2]; sp[384 + nt * 16] = acc[nt][3];
    }
    if (tid == 0) MB_DD(p)[idx] = prodD;
  } else if (oc == noc - 1) {
    float* sp = out_state(p.out, s, j, O_SSM_P, O_SSM_S, 131072) + (size_t)h * 8192 + (size_t)(wv * 16 + lq * 4) * 128 + l15;
#pragma unroll
    for (int nt = 0; nt < 8; nt++) {
      sp[nt * 16] = acc[nt][0]; sp[128 + nt * 16] = acc[nt][1]; sp[256 + nt * 16] = acc[nt][2]; sp[384 + nt * 16] = acc[nt][3];
    }
  }
  __syncthreads();
}

__device__ void phase_scan_even_a(CP p, int j, char* smem, int bid, int nb) {
  const int nA = 32 * (MB_NOC - 1);
  for (int it = bid; it < 448 + nA + 256; it += nb) {
    int kind, q, oc = 0, noc = RK_NOC;
    if (it < 256) { kind = 0; q = it >> 2; oc = it & 3; }
    else if (it < 448) { kind = 1; q = (it - 256) / 3; oc = 1 + (it - 256) % 3; }
    else if (it < 448 + nA) { kind = 2; q = (it - 448) / (MB_NOC - 1); oc = (it - 448) % (MB_NOC - 1); }
    else { kind = 0; q = 64 + (it - 448 - nA); noc = 1; }
    if (kind == 2) mamba_scan_item<0>(p, j, q >> 4, q & 15, oc, MB_NOC, smem);
    else {
      const int s = q < 64 ? (q >> 5) : 2 + ((q - 64) >> 5);
      if (kind == 0) rwkv_scan_item<0>(p, j, s, (q >> 2) & 7, q & 3, oc, noc, smem);
      else rwkv_scan_item<1>(p, j, s, (q >> 2) & 7, q & 3, oc, noc, smem);
    }
  }
}
__device__ void phase_scan_even(CP p, int j, char* smem, int bid, int nb) {
  for (int it = bid; it < 16 + 32 * MB_NOC + 128; it += nb) {
    if (it < 16) { rwkv_combine_item(p, j, it >> 3, it & 7, smem); continue; }
    const int i2 = it - 16;
    int q, s, oc, noc;
    if (i2 < 32 * MB_NOC) { q = i2 / MB_NOC; oc = i2 % MB_NOC; noc = MB_NOC; s = q >> 4; }
    else { q = i2 - 32 * MB_NOC; oc = 0; noc = 1; s = 2 + (q >> 4); }
    mamba_scan_item<1>(p, j, s, q & 15, oc, noc, smem);
  }
}

__device__ void phase_post_even(CP p, int j, char* smem, int bid, int nb) {
  const int tid = otid(), lane = tid & 63, wv = tid >> 6;
  const u16* P = p.pbuf;
  {
    u16* sgb = (u16*)smem;
    float* ul = (float*)(sgb + 16 * 136) ;
    float* resg = ul + 8 * 512;
    for (int i = tid; i < 16 * 136; i += 256) sgb[i] = 0;
    const int half = tid >> 7, hk = tid & 127, h = hk >> 4, kq = hk & 15;
    const int c4 = h * 64 + kq * 4;
    const float* mu = p.mu_a + j * 1792;
    for (int u = bid; u < NT / 8; u += nb) {
      const int m0 = u * 8;
      const int s = row_seq(m0);
      const int r0 = seq_row0(s);
      __syncthreads();
#pragma unroll
      for (int i = 0; i < 4; i++) {
        int idx = tid + 256 * i;
        int tok = idx >> 7, cc = idx & 127;
        int m = m0 + tok;
        int col = 1664 + cc;
        float pc = bf2f(P[(size_t)m * PSTR + col]);
        float pp = (m > r0) ? bf2f(P[(size_t)(m - 1) * PSTR + col])
                            : (s >= 2 ? p.st_shift[((size_t)(s - 2) * 2 + j) * 1792 + col] : 0.f);
        float pm = pc + (pp - pc) * mu[col];
        sgb[tok * 136 + cc] = f2bf(sigm(pm));
      }
      const int ocu = (s < 2) ? ((m0 - r0) >> 11) : 0;
      if (ocu > 0) {
#pragma unroll
        for (int i = 0; i < 2; i++) {
          int idx = tid + 256 * i;
          uint4 uv = *(const uint4*)(p.ub + (size_t)m0 * 512 + idx * 8);
          cvt8_store(ul + idx * 8, uv);
        }
      }
      __syncthreads();
      float corr[4][4];
#pragma unroll
      for (int a = 0; a < 4; a++)
#pragma unroll
        for (int b = 0; b < 4; b++) corr[a][b] = 0.f;
      if (ocu > 0) {
        const float* sip = RK_SI(p) + (size_t)((s * 8 + h) * 4 + ocu) * 4096 + (size_t)(kq * 4) * 64;
#pragma unroll 2
        for (int i = 0; i < 64; i += 4) {
          float4 u4[4];
#pragma unroll
          for (int tk = 0; tk < 4; tk++) u4[tk] = *(const float4*)(ul + (half * 4 + tk) * 512 + h * 64 + i);
#pragma unroll
          for (int rr = 0; rr < 4; rr++) {
            float4 s4 = *(const float4*)(sip + rr * 64 + i);
#pragma unroll
            for (int tk = 0; tk < 4; tk++)
              corr[tk][rr] += s4.x * u4[tk].x + s4.y * u4[tk].y + s4.z * u4[tk].z + s4.w * u4[tk].w;
          }
        }
      }
      {
        const int lane = tid & 63, wv = tid >> 6, l15 = lane & 15, lq = lane >> 4;
        bf16x8 ag[4];
#pragma unroll
        for (int ks = 0; ks < 4; ks++) ag[ks] = *(const bf16x8*)(sgb + l15 * 136 + ks * 32 + lq * 8);
#pragma unroll
        for (int nt = 0; nt < 8; nt++) {
          const int n = wv * 128 + nt * 16 + l15;
          f32x4 cgv = (f32x4){0.f, 0.f, 0.f, 0.f};
#pragma unroll
          for (int ks = 0; ks < 4; ks++) {
            bf16x8 bg = *(const bf16x8*)(p.g2t + (size_t)n * 128 + ks * 32 + lq * 8);
            cgv = __builtin_amdgcn_mfma_f32_16x16x32_bf16(ag[ks], bg, cgv, 0, 0, 0);
          }
          if (lq < 2) {
#pragma unroll
            for (int jj = 0; jj < 4; jj++) resg[(lq * 4 + jj) * 512 + n] = cgv[jj];
          }
        }
      }
      __syncthreads();
      float accg[4][4];
#pragma unroll
      for (int tk = 0; tk < 4; tk++) {
        float4 rg4 = *(const float4*)(resg + (half * 4 + tk) * 512 + c4);
        accg[tk][0] = rg4.x; accg[tk][1] = rg4.y; accg[tk][2] = rg4.z; accg[tk][3] = rg4.w;
      }
      float4 lw = *(const float4*)(p.lnx_w + j * 512 + c4);
      float4 lb = *(const float4*)(p.lnx_b + j * 512 + c4);
      const float lwa[4] = {lw.x, lw.y, lw.z, lw.w};
      const float lba[4] = {lb.x, lb.y, lb.z, lb.w};
#pragma unroll
      for (int tk = 0; tk < 4; tk++) {
        const int m = m0 + half * 4 + tk;
        u16* op = p.hm + (size_t)m * 1536 + c4;
        uint2 oraw = *(const uint2*)op;
        float o[4] = {lo16(oraw.x) + corr[tk][0], hi16(oraw.x) + corr[tk][1], lo16(oraw.y) + corr[tk][2], hi16(oraw.y) + corr[tk][3]};
        float sm = red16(o[0] + o[1] + o[2] + o[3]);
        float mean = sm * (1.f / 64.f);
        float d0 = o[0] - mean, d1 = o[1] - mean, d2 = o[2] - mean, d3 = o[3] - mean;
        float var = red16(d0 * d0 + d1 * d1 + d2 * d2 + d3 * d3) * (1.f / 64.f);
        float rs = rsqrtf(var + 64e-5f);
        float bon = p.bonus[(size_t)m * 8 + h];
        uint4 sl2 = *(const uint4*)(p.rw + (((size_t)m * 8 + h) * 16 + kq) * 24 + 16);
        float v[4] = {lo16(sl2.z), hi16(sl2.z), lo16(sl2.w), hi16(sl2.w)};
        float dd[4] = {d0, d1, d2, d3};
        float res[4];
#pragma unroll
        for (int e = 0; e < 4; e++) res[e] = (dd[e] * rs * lwa[e] + lba[e] + bon * v[e]) * accg[tk][e];
        *(uint2*)op = make_uint2(pack2(res[0], res[1]), pack2(res[2], res[3]));
      }
    }
  }
  for (int w = bid * 4 + wv; w < NT * 2; w += nb * 4) {
    int m = w >> 1, g = w & 1;
    u16* yp = p.hm + (size_t)m * 1536 + 512 + g * 512 + lane * 8;
    uint4 yr = *(const uint4*)yp;
    uint4 zr = *(const uint4*)(P + (size_t)m * PSTR + 1792 + g * 512 + lane * 8);
    float y[8] = {lo16(yr.x), hi16(yr.x), lo16(yr.y), hi16(yr.y), lo16(yr.z), hi16(yr.z), lo16(yr.w), hi16(yr.w)};
    float z[8] = {lo16(zr.x), hi16(zr.x), lo16(zr.y), hi16(zr.y), lo16(zr.z), hi16(zr.z), lo16(zr.w), hi16(zr.w)};
    uint4 xr = *(const uint4*)(p.cv + (size_t)m * 1536 + g * 512 + lane * 8);
    float x[8] = {lo16(xr.x), hi16(xr.x), lo16(xr.y), hi16(xr.y), lo16(xr.z), hi16(xr.z), lo16(xr.w), hi16(xr.w)};
    const float dsk = p.d_skip[j * 16 + g * 8 + (lane >> 3)];
    float ss = 0.f;
#pragma unroll
    for (int e = 0; e < 8; e++) { y[e] = (y[e] + dsk * x[e]) * silu_(z[e]); ss += y[e] * y[e]; }
    ss = wave_sum(ss);
    float rs = rsqrtf(ss * (1.f / 512.f) + 1e-5f);
    const float* nw = p.norm_b_w + j * 1024 + g * 512 + lane * 8;
    float4 n0 = *(const float4*)nw, n1 = *(const float4*)(nw + 4);
    *(uint4*)yp = make_uint4(pack2(y[0] * rs * n0.x, y[1] * rs * n0.y), pack2(y[2] * rs * n0.z, y[3] * rs * n0.w),
                             pack2(y[4] * rs * n1.x, y[5] * rs * n1.y), pack2(y[6] * rs * n1.z, y[7] * rs * n1.w));
  }
}

#define QK_OFF ((size_t)1032 * 1024 * 16)
__device__ void phase_prep_odd(CP p, int j, int bid, int nb) {
  const int tid = otid();
  const u16* P = p.pbuf;
  u16* KT = p.rw;
  u16* QK = p.rw + QK_OFF;
  float* DL = (float*)p.cv;
  for (int u = bid; u < (NT / 16) * 2; u += nb) {
    const int ci = u >> 1, k = ((u & 1) * 256 + tid) * 2;
    float lb0 = 0.f, lb1 = 0.f;
    if (j == 1) { lb0 = sigm(p.lb_param[1024 + k] - p.lb_param[k]); lb1 = sigm(p.lb_param[1025 + k] - p.lb_param[k + 1]); }
    const u16* base = P + (size_t)ci * 16 * PSTR + k;
    unsigned qr[16], fr[16];
#pragma unroll
    for (int t = 0; t < 16; t++) { qr[t] = *(const unsigned*)(base + (size_t)t * PSTR); fr[t] = *(const unsigned*)(base + (size_t)t * PSTR + 1024); }
    float G0 = 0.f, G1 = 0.f;
    unsigned kt0[8], kt1[8];
#pragma unroll
    for (int t = 0; t < 16; t++) {
      float q0 = lo16(qr[t]), q1 = hi16(qr[t]), f0 = lo16(fr[t]), f1 = hi16(fr[t]);
      float s0 = sigm(f0), s1 = sigm(f1);
      float ff0 = lb0 + (1.f - lb0) * s0, ff1 = lb1 + (1.f - lb1) * s1;
      float kk0 = (1.f - lb0) * (1.f - s0), kk1 = (1.f - lb1) * (1.f - s1);
      G0 += __logf(fmaxf(ff0, 1e-30f)); G1 += __logf(fmaxf(ff1, 1e-30f));
      float Q0 = silu_(q0) * __expf(G0), Q1 = silu_(q1) * __expf(G1);
      float K0 = kk0 * __expf(fminf(-G0, 80.f)), K1 = kk1 * __expf(fminf(-G1, 80.f));
      unsigned kb0 = f2bf(K0), kb1 = f2bf(K1);
      u16* qd = QK + (size_t)(ci * 16 + t) * 2048 + k;
      *(unsigned*)qd = pack2(Q0, Q1);
      *(unsigned*)(qd + 1024) = kb0 | (kb1 << 16);
      if (t & 1) { kt0[t >> 1] |= kb0 << 16; kt1[t >> 1] |= kb1 << 16; } else { kt0[t >> 1] = kb0; kt1[t >> 1] = kb1; }
    }
    *(float2*)(DL + (size_t)ci * 1024 + k) = make_float2(__expf(G0), __expf(G1));
    uint4* kd = (uint4*)(KT + ((size_t)ci * 1024 + k) * 16);
    kd[0] = make_uint4(kt0[0], kt0[1], kt0[2], kt0[3]);
    kd[1] = make_uint4(kt0[4], kt0[5], kt0[6], kt0[7]);
    kd[2] = make_uint4(kt1[0], kt1[1], kt1[2], kt1[3]);
    kd[3] = make_uint4(kt1[4], kt1[5], kt1[6], kt1[7]);
  }
}

#define HG_SL(p) ((float*)(p).cv + 2 * 1024 * 1024)
#define HG_DD(p) (HG_SL(p) + 2 * 8 * 8 * 16384)
template <int MODE>
__device__ __forceinline__ void hgrn_scan_item(CP p, int j, int s, int h, int vq, int oc, int noc, char* smem) {
  u16* Qs = (u16*)smem;
  u16* Ks = Qs + 2 * 16 * 136;
  u16* KTs = Ks + 2 * 16 * 136;
  u16* VTs = KTs + 2 * 128 * 24;
  u16* SsT = VTs + 2 * 32 * 24;
  float* dLs = (float*)(SsT + 2 * 32 * 136);
  const int tid = otid(), lane = tid & 63, wv = tid >> 6;
  const int l15 = lane & 15, lq = lane >> 4;
  const int T = seq_len(s);
  const int nch = (T >> 4) / noc;
  const int m0 = seq_row0(s) + oc * nch * 16;
  const int ci0 = m0 >> 4;
  f32x4 acc[2][2];
#pragma unroll
  for (int vt = 0; vt < 2; vt++)
#pragma unroll
    for (int kl = 0; kl < 2; kl++) acc[vt][kl] = (f32x4){0.f, 0.f, 0.f, 0.f};
  float prodD[2] = {1.f, 1.f};
  if (MODE == 1) {
    if (s >= 2) {
      const float* sp = p.st_hgrn + (((size_t)(s - 2) * 2 + j) * 8 + h) * 16384;
#pragma unroll
      for (int vt = 0; vt < 2; vt++)
#pragma unroll
        for (int kl = 0; kl < 2; kl++) {
          float4 q = *(const float4*)(sp + (size_t)((2 * wv + kl) * 16 + l15) * 128 + vq * 32 + vt * 16 + lq * 4);
          acc[vt][kl] = (f32x4){q.x, q.y, q.z, q.w};
        }
    } else {
      for (int cp = 0; cp < oc; cp++) {
        const size_t idx = (size_t)((s * 8 + h) * 8 + cp);
#pragma unroll
        for (int kl = 0; kl < 2; kl++) {
          const int k = (2 * wv + kl) * 16 + l15;
          const float dd = HG_DD(p)[idx * 128 + k];
#pragma unroll
          for (int vt = 0; vt < 2; vt++) {
            float4 L4 = *(const float4*)(HG_SL(p) + idx * 16384 + (size_t)k * 128 + vq * 32 + vt * 16 + lq * 4);
            acc[vt][kl] = (f32x4){acc[vt][kl][0] * dd + L4.x, acc[vt][kl][1] * dd + L4.y, acc[vt][kl][2] * dd + L4.z,
                                  acc[vt][kl][3] * dd + L4.w};
          }
        }
      }
    }
  }
  const u16* Pq = p.rw + QK_OFF + (size_t)(m0 + (tid >> 4)) * 2048 + h * 128 + (tid & 15) * 8;
  const u16* Pv = p.pbuf + (size_t)(m0 + ((tid >> 2) & 15)) * PSTR + 2048 + h * 128 + vq * 32 + (tid & 3) * 8;
  const u16* Pkt = p.rw + ((size_t)ci0 * 1024 + h * 128 + (tid >> 1)) * 16 + (tid & 1) * 8;
  const float* Pdl = (const float*)p.cv + (size_t)ci0 * 1024 + h * 128 + (tid & 31) * 4;
  uint4 aq, ak, akt, av, cq, ck, ckt, cvv;
  float4 ad, cd;
  aq = make_uint4(0, 0, 0, 0); ak = aq; cq = aq; ck = aq;
  av = make_uint4(0, 0, 0, 0); cvv = av; ad = make_float4(0, 0, 0, 0); cd = ad;
#define HM_ISSUE(rq, rk, rkt, rv, rd, c) { \
    if (MODE == 1) { rq = *(const uint4*)(Pq + (size_t)(c) * 16 * 2048); rk = *(const uint4*)(Pq + (size_t)(c) * 16 * 2048 + 1024); } \
    rkt = *(const uint4*)(Pkt + (size_t)(c) * 1024 * 16); \
    if (tid < 64) rv = *(const uint4*)(Pv + (size_t)(c) * 16 * PSTR); \
    if (tid < 32) rd = *(const float4*)(Pdl + (size_t)(c) * 1024); }
#define HM_STASH(rq, rk, rkt, rv, rd, bi) { \
    if (MODE == 1) { *(uint4*)(Qs + (bi) * (16 * 136) + (tid >> 4) * 136 + (tid & 15) * 8) = rq; \
    *(uint4*)(Ks + (bi) * (16 * 136) + (tid >> 4) * 136 + (tid & 15) * 8) = rk; } \
    *(uint4*)(KTs + (bi) * (128 * 24) + (tid >> 1) * 24 + (tid & 1) * 8) = rkt; \
    if (tid < 64) { u16* vd_ = VTs + (bi) * (32 * 24) + ((tid & 3) * 8) * 24 + (tid >> 2); \
      vd_[0 * 24] = (u16)(rv.x & 0xffff); vd_[1 * 24] = (u16)(rv.x >> 16); vd_[2 * 24] = (u16)(rv.y & 0xffff); vd_[3 * 24] = (u16)(rv.y >> 16); \
      vd_[4 * 24] = (u16)(rv.z & 0xffff); vd_[5 * 24] = (u16)(rv.z >> 16); vd_[6 * 24] = (u16)(rv.w & 0xffff); vd_[7 * 24] = (u16)(rv.w >> 16); } \
    if (tid < 32) *(float4*)(dLs + (bi) * 128 + tid * 4) = rd; }
  __syncthreads();
  HM_ISSUE(aq, ak, akt, av, ad, 0)
  HM_STASH(aq, ak, akt, av, ad, 0)
  if (1 < nch) HM_ISSUE(aq, ak, akt, av, ad, 1)
  if (2 < nch) HM_ISSUE(cq, ck, ckt, cvv, cd, 2)
  for (int c = 0; c < nch; c++) {
    const int bi = c & 1;
    if (MODE == 1) {
      u16* sd = SsT + bi * (32 * 136);
#pragma unroll
      for (int vt = 0; vt < 2; vt++)
#pragma unroll
        for (int kl = 0; kl < 2; kl++)
#pragma unroll
          for (int jj = 0; jj < 4; jj++)
            sd[(vt * 16 + lq * 4 + jj) * 136 + (2 * wv + kl) * 16 + l15] = f2bf(acc[vt][kl][jj]);
    }
    __syncthreads();
    if (c + 1 < nch) {
      if (bi == 0) { HM_STASH(aq, ak, akt, av, ad, 1) if (c + 3 < nch) HM_ISSUE(aq, ak, akt, av, ad, c + 3) }
      else { HM_STASH(cq, ck, ckt, cvv, cd, 0) if (c + 3 < nch) HM_ISSUE(cq, ck, ckt, cvv, cd, c + 3) }
    }
    const u16* Qc = Qs + bi * (16 * 136);
    const u16* Kc = Ks + bi * (16 * 136);
    const u16* KTc = KTs + bi * (128 * 24);
    const u16* VTc = VTs + bi * (32 * 24);
    const u16* Sc = SsT + bi * (32 * 136);
    if (MODE == 1 && wv < 2) {
      const int vt = wv;
      f32x4 at = (f32x4){0.f, 0.f, 0.f, 0.f};
      bf16x8 qf[4];
#pragma unroll
      for (int ks = 0; ks < 4; ks++) {
        bf16x8 kf = *(const bf16x8*)(Kc + l15 * 136 + ks * 32 + lq * 8);
        qf[ks] = *(const bf16x8*)(Qc + l15 * 136 + ks * 32 + lq * 8);
        at = __builtin_amdgcn_mfma_f32_16x16x32_bf16(kf, qf[ks], at, 0, 0, 0);
      }
      bf16x4 bat;
#pragma unroll
      for (int jj = 0; jj < 4; jj++) bat[jj] = (short)f2bf((lq * 4 + jj) <= l15 ? at[jj] : 0.f);
      bf16x4 vf = *(const bf16x4*)(VTc + (vt * 16 + l15) * 24 + lq * 4);
      f32x4 ao1 = (f32x4){0.f, 0.f, 0.f, 0.f};
      ao1 = __builtin_amdgcn_mfma_f32_16x16x16bf16_1k(vf, bat, ao1, 0, 0, 0);
      f32x4 ao2 = (f32x4){0.f, 0.f, 0.f, 0.f};
#pragma unroll
      for (int ks = 0; ks < 4; ks++) {
        bf16x8 sf = *(const bf16x8*)(Sc + (vt * 16 + l15) * 136 + ks * 32 + lq * 8);
        ao2 = __builtin_amdgcn_mfma_f32_16x16x32_bf16(sf, qf[ks], ao2, 0, 0, 0);
      }
      f32x4 ao = (f32x4){ao1[0] + ao2[0], ao1[1] + ao2[1], ao1[2] + ao2[2], ao1[3] + ao2[3]};
      *(uint2*)(p.hm + (size_t)(m0 + c * 16 + l15) * 1024 + h * 128 + vq * 32 + vt * 16 + lq * 4) =
          make_uint2(pack2(ao[0], ao[1]), pack2(ao[2], ao[3]));
    }
#pragma unroll
    for (int kl = 0; kl < 2; kl++) {
      const int kt = 2 * wv + kl;
      bf16x4 kb = *(const bf16x4*)(KTc + (kt * 16 + l15) * 24 + lq * 4);
      float dl = dLs[bi * 128 + kt * 16 + l15];
      if (MODE == 0) prodD[kl] *= dl;
#pragma unroll
      for (int vt = 0; vt < 2; vt++) {
        bf16x4 vf = *(const bf16x4*)(VTc + (vt * 16 + l15) * 24 + lq * 4);
        f32x4 a = __builtin_amdgcn_mfma_f32_16x16x16bf16_1k(vf, kb, acc[vt][kl], 0, 0, 0);
        acc[vt][kl] = (f32x4){a[0] * dl, a[1] * dl, a[2] * dl, a[3] * dl};
      }
    }
  }
  if (MODE == 0) {
    const size_t idx = (size_t)((s * 8 + h) * 8 + oc);
#pragma unroll
    for (int kl = 0; kl < 2; kl++) {
      const int k = (2 * wv + kl) * 16 + l15;
      if (vq == 0 && lq == 0) HG_DD(p)[idx * 128 + k] = prodD[kl];
#pragma unroll
      for (int vt = 0; vt < 2; vt++)
        *(float4*)(HG_SL(p) + idx * 16384 + (size_t)k * 128 + vq * 32 + vt * 16 + lq * 4) =
            make_float4(acc[vt][kl][0], acc[vt][kl][1], acc[vt][kl][2], acc[vt][kl][3]);
    }
  } else if (oc == noc - 1) {
    float* o = out_state(p.out, s, j, O_HGRN_P, O_HGRN_S, 131072) + (size_t)h * 16384;
#pragma unroll
    for (int vt = 0; vt < 2; vt++)
#pragma unroll
      for (int kl = 0; kl < 2; kl++)
        *(float4*)(o + (size_t)((2 * wv + kl) * 16 + l15) * 128 + vq * 32 + vt * 16 + lq * 4) =
            make_float4(acc[vt][kl][0], acc[vt][kl][1], acc[vt][kl][2], acc[vt][kl][3]);
  }
  __syncthreads();
}

#define HG_NOC 8
__device__ void phase_scan_odd_a(CP p, int j, char* smem, int bid, int nb) {
  for (int it = bid; it < 64 * (HG_NOC - 1); it += nb) {
    int q = it / (HG_NOC - 1), oc = it % (HG_NOC - 1);
    hgrn_scan_item<0>(p, j, q >> 5, (q >> 2) & 7, q & 3, oc, HG_NOC, smem);
  }
}
__device__ void phase_scan_odd(CP p, int j, char* smem, int bid, int nb) {
  for (int it = bid; it < 64 * HG_NOC + 256; it += nb) {
    int q, s, oc, noc;
    if (it < 64 * HG_NOC) { q = it / HG_NOC; oc = it % HG_NOC; noc = HG_NOC; s = q >> 5; }
    else { q = it - 64 * HG_NOC; oc = 0; noc = 1; s = 2 + (q >> 5); }
    hgrn_scan_item<1>(p, j, s, (q >> 2) & 7, q & 3, oc, noc, smem);
  }
}

__device__ void phase_post_odd(CP p, int j, int bid, int nb) {
  const int tid = otid(), lane = tid & 63, wv = tid >> 6;
  const u16* P = p.pbuf;
  for (int m = bid * 4 + wv; m < NT; m += nb * 4) {
    u16* op = p.hm + (size_t)m * 1024 + lane * 16;
    uint4 a = *(const uint4*)op, b = *(const uint4*)(op + 8);
    const u16* gp = P + (size_t)m * PSTR + 3072 + lane * 16;
    uint4 ga = *(const uint4*)gp, gb = *(const uint4*)(gp + 8);
    float o[16] = {lo16(a.x), hi16(a.x), lo16(a.y), hi16(a.y), lo16(a.z), hi16(a.z), lo16(a.w), hi16(a.w),
                   lo16(b.x), hi16(b.x), lo16(b.y), hi16(b.y), lo16(b.z), hi16(b.z), lo16(b.w), hi16(b.w)};
    float g[16] = {lo16(ga.x), hi16(ga.x), lo16(ga.y), hi16(ga.y), lo16(ga.z), hi16(ga.z), lo16(ga.w), hi16(ga.w),
                   lo16(gb.x), hi16(gb.x), lo16(gb.y), hi16(gb.y), lo16(gb.z), hi16(gb.z), lo16(gb.w), hi16(gb.w)};
    float ss = 0.f;
#pragma unroll
    for (int e = 0; e < 16; e++) ss += o[e] * o[e];
    ss += dpp_f<0xB1>(ss);
    ss += dpp_f<0x4E>(ss);
    ss += dpp_f<0x141>(ss);
    float rs = rsqrtf(ss * (1.f / 128.f) + 1e-5f);
    const float* nw = p.norm_c_w + j * 1024 + lane * 16;
    float r[16];
#pragma unroll
    for (int e = 0; e < 16; e++) r[e] = o[e] * rs * nw[e] * silu_(g[e]);
    *(uint4*)op = make_uint4(pack2(r[0], r[1]), pack2(r[2], r[3]), pack2(r[4], r[5]), pack2(r[6], r[7]));
    *(uint4*)(op + 8) = make_uint4(pack2(r[8], r[9]), pack2(r[10], r[11]), pack2(r[12], r[13]), pack2(r[14], r[15]));
  }
}


#define XB_TMO      128
#define XB_XCNT(j)  (256  + 64 * (j))
#define XB_XSUB(j)  (1280 + 64 * (j))
#define XB_XGEN(j)  (2304 + 64 * (j))
#define XB_TOP      3328
#define XB_TOPGEN   3392
#define XCD_BAR_WORDS 3456
#define XB_SPIN_CAP (1u << 22)
#define LAS __attribute__((address_space(3)))
__device__ __forceinline__ unsigned xb_ld(unsigned* p) { return __hip_atomic_load(p, __ATOMIC_RELAXED, __HIP_MEMORY_SCOPE_AGENT); }
__device__ __forceinline__ unsigned xb_add(unsigned* p, unsigned v) { return __hip_atomic_fetch_add(p, v, __ATOMIC_RELAXED, __HIP_MEMORY_SCOPE_AGENT); }
__device__ __forceinline__ unsigned xb_xcc_id() { return (unsigned)__builtin_amdgcn_s_getreg((3 << 11) | 20) & 0xFu; }
#define XB_SPIN(cond, bar) do { unsigned _sp = 0; while (cond) { __builtin_amdgcn_s_sleep(1); \
    if ((++_sp & 255u) == 0u) { if (xb_ld(&(bar)[XB_TMO])) break; if (_sp > XB_SPIN_CAP) { atomicAdd(&(bar)[XB_TMO], 1u); break; } } } } while (0)
struct XcdBarrier { unsigned* bar; unsigned x; volatile LAS unsigned* st; };
__device__ __forceinline__ XcdBarrier xcd_barrier_post(unsigned* bar, volatile LAS unsigned* st) {
  XcdBarrier b; b.bar = bar; b.x = xb_xcc_id(); b.st = st;
  if (threadIdx.x == 0) (void)xb_add(&bar[XB_XCNT(b.x)], 1u);
  return b;
}
__device__ __forceinline__ void xcd_barrier_complete(unsigned* bar, unsigned x, unsigned& nloc, unsigned& nx) {
  const unsigned G = gridDim.x * gridDim.y * gridDim.z;
  unsigned sum, cnt, mine, sp = 0u;
  for (;;) {
    sum = 0u; cnt = 0u; mine = 0u;
#pragma unroll
    for (unsigned j = 0; j < 16; ++j) { const unsigned c = xb_ld(&bar[XB_XCNT(j)]); sum += c; cnt += (c > 0u) ? 1u : 0u; mine = (j == x) ? c : mine; }
    if (sum == G) break;
    __builtin_amdgcn_s_sleep(1);
    if ((++sp & 255u) == 0u) { if (xb_ld(&bar[XB_TMO])) break; if (sp > XB_SPIN_CAP) { atomicAdd(&bar[XB_TMO], 1u); break; } }
  }
  nloc = mine > 0u ? mine : 1u; nx = cnt > 0u ? cnt : 1u;
}
__device__ __forceinline__ void xcd_barrier(const XcdBarrier& b) {
  asm volatile("s_waitcnt vmcnt(0)" ::: "memory");
  __syncthreads();
  if (threadIdx.x == 0) {
    unsigned* bar = b.bar;
    __builtin_amdgcn_s_waitcnt(0);
    unsigned nloc = b.st[0], nx = b.st[1];
    if (nloc == 0u) { xcd_barrier_complete(bar, b.x, nloc, nx); b.st[0] = nloc; b.st[1] = nx; }
    const unsigned old = xb_add(&bar[XB_XSUB(b.x)], 1u);
    const unsigned gen = old / nloc;
    if (old + 1u == (gen + 1u) * nloc) {
      __builtin_amdgcn_fence(__ATOMIC_RELEASE, "agent");
      asm volatile("s_waitcnt vmcnt(0)" ::: "memory");
      const unsigned og = xb_add(&bar[XB_TOP], 1u);
      const unsigned tg = og / nx;
      if (og + 1u == (tg + 1u) * nx) xb_add(&bar[XB_TOPGEN], 1u);
      else XB_SPIN(xb_ld(&bar[XB_TOPGEN]) == tg, bar);
      __builtin_amdgcn_fence(__ATOMIC_ACQUIRE, "agent");
      xb_add(&bar[XB_XGEN(b.x)], 1u);
      asm volatile("s_waitcnt vmcnt(0)" ::: "memory");
    } else {
      XB_SPIN(xb_ld(&bar[XB_XGEN(b.x)]) == gen, bar);
      __builtin_amdgcn_fence(__ATOMIC_ACQUIRE, "agent");
      asm volatile("s_waitcnt vmcnt(0)" ::: "memory");
    }
  }
  __syncthreads();
}

#define NPHASE 42
__global__ void __launch_bounds__(256, 2) mega(Params kp) {
  __shared__ __attribute__((aligned(16))) char smem[65536];
  cg::grid_group grid = cg::this_grid();
  const int ph0 = kp.p0, ph1 = kp.p1;
  volatile LAS unsigned* xst = (volatile LAS unsigned*)(smem + 65520);
  if (threadIdx.x == 0) { xst[0] = 0u; xst[1] = 0u; }
  __syncthreads();
  XcdBarrier xb = xcd_barrier_post(kp.bar, xst);
  if (ph1 > 1000) grid.sync();
  const bool multi = (ph1 - ph0) > 1;
  for (int ph = ph0; ph < ph1; ph++) {
    CP p = *getp();
    int bid = blockIdx.x, nb = gridDim.x;
    asm volatile("" : "+s"(bid), "+s"(nb));
    if (ph == 0) {
      phase_mod(p, smem, bid, nb);
    } else if (ph == NPHASE - 1) {
      phase_final(p, bid, nb);
    } else {
      const int L = (ph - 1) / 10, sp = (ph - 1) % 10;
      const int j = L >> 1;
      const bool even = (L & 1) == 0;
      int reps = 1;
#ifdef PROBE_SCAN
      if (sp == 4 && !even) reps = 2;
#endif
#ifdef PROBE_GEMM
      if (sp == 1 || sp == 8) reps = 2;
#endif
#ifdef PROBE_MISC
      if (sp == 0 || sp == 7 || sp == 2) reps = 2;
#endif
      for (int rep = 0; rep < reps; rep++) {
      bool do_gemm = false;
      const u16 *A = nullptr, *Bt = nullptr;
      u16* outb = nullptr;
      const float* gate = nullptr;
      int lda = 0, K = 0, ntn = 0, epi = 0, ldo = 0, ncols = 0;
      switch (sp) {
        case 0:
          phase_wconv(p, L, smem, bid, nb);
          phase_norm(p, L, 0, bid, nb);
          break;
        case 1:
          do_gemm = true; A = p.hm; lda = 1024; Bt = p.wb_in; K = 1024; ntn = even ? 18 : 16; epi = 0;
          outb = p.pbuf; ldo = PSTR; ncols = even ? PSTR : 4096;
          break;
        case 2:
          if (even) phase_prep_even(p, j, smem, bid, nb); else phase_prep_odd(p, j, bid, nb);
          break;
        case 3:
          if (even) phase_scan_even_a(p, j, smem, bid, nb); else phase_scan_odd_a(p, j, smem, bid, nb);
          break;
        case 4:
          if (even) phase_scan_even(p, j, smem, bid, nb); else phase_scan_odd(p, j, smem, bid, nb);
          break;
        case 5:
          if (even) phase_post_even(p, j, smem, bid, nb); else phase_post_odd(p, j, bid, nb);
          break;
        case 6:
          do_gemm = true; A = p.hm; lda = even ? 1536 : 1024; Bt = p.wb_out; K = lda; ntn = 4; epi = 2;
          gate = p.mod + (size_t)L * 10 * 6144 + 2048;
          break;
        case 7:
          phase_norm(p, L, 1, bid, nb);
          break;
        case 8:
          do_gemm = true; A = p.hm; lda = 1024; Bt = p.wb_gu; K = 1024; ntn = 22; epi = 1;
          outb = p.pbuf; ldo = 2816; ncols = 2816;
          break;
        default:
          do_gemm = true; A = p.pbuf; lda = 2816; Bt = p.wb_dn; K = 2816; ntn = 4; epi = 2;
          gate = p.mod + (size_t)L * 10 * 6144 + 5120;
          break;
      }
      if (do_gemm) gemm_phase(p, A, lda, Bt, K, ntn, epi, outb, ldo, ncols, gate, smem, bid, nb);
      }
    }
    if (multi && ph + 1 < ph1) xcd_barrier(xb);
  }
}

extern "C" void kernel_launch(void* const* d_in, const int* in_sizes, int n_in, void* d_out, int out_size, void* d_ws,
                              size_t ws_size, hipStream_t stream) {
  static int grid_blocks = 0;
  if (!grid_blocks) {
    int dev = 0, cus = 0, per_cu = 0;
    hipGetDevice(&dev);
    hipDeviceGetAttribute(&cus, hipDeviceAttributeMultiprocessorCount, dev);
    hipOccupancyMaxActiveBlocksPerMultiprocessor(&per_cu, mega, 256, 0);
    if (per_cu > 2) per_cu = 2;
    if (per_cu < 1) per_cu = 1;
    grid_blocks = cus * per_cu;
  }
  Params p{};
  const float* const* in = (const float* const*)d_in;
  p.x_prompt = in[0]; p.x_sample = in[1]; p.st_rwkv = in[2]; p.st_shift = in[3]; p.st_ssm = in[4]; p.st_conv = in[5];
  p.st_hgrn = in[6]; p.c_prompt = in[7]; p.c_sample = in[8]; p.norm_mix_w = in[9]; p.norm_ffn_w = in[10];
  p.norm_out_w = in[11]; p.ada_w = in[12]; p.ada_b = in[13]; p.w_in_ab = in[14]; p.w_out_ab = in[15]; p.mu_a = in[16];
  p.w0 = in[17]; p.w2 = in[18]; p.a0 = in[19]; p.a2 = in[20]; p.g2 = in[21]; p.k_k = in[22]; p.k_a = in[23];
  p.r_k = in[24]; p.lnx_w = in[25]; p.lnx_b = in[26]; p.conv_w = in[27]; p.conv_b = in[28]; p.dt_bias = in[29];
  p.a_log = in[30]; p.d_skip = in[31]; p.norm_b_w = in[32]; p.w_in_c = in[33]; p.w_out_c = in[34]; p.lb_param = in[35];
  p.norm_c_w = in[36]; p.w_gate = in[37]; p.w_up = in[38]; p.w_down = in[39];
  p.out = (float*)d_out;
  char* ws = (char*)d_ws;
  size_t off = 0;
  auto take = [&](size_t bytes) { char* r = ws + off; off += (bytes + 255) & ~(size_t)255; return r; };
  p.bar = (unsigned*)take(16384);
  p.mod = (float*)take((size_t)4 * 10 * 6144 * 4);
  p.bonus = (float*)take((size_t)NT * 8 * 4);
  p.dtb = (float*)take((size_t)NT * 32 * 4);
  p.wb_in = (u16*)take((size_t)4480 * 1024 * 2);
  p.wb_out = (u16*)take((size_t)1024 * 1536 * 2);
  p.wb_gu = (u16*)take((size_t)5632 * 1024 * 2);
  p.wb_dn = (u16*)take((size_t)1024 * 2816 * 2);
  p.hm = (u16*)take((size_t)NT * 1536 * 2);
  p.pbuf = (u16*)take((size_t)NT * PSTR * 2);
  p.rw = (u16*)take((size_t)NT * 8 * 16 * 24 * 2);
  p.cv = (u16*)take((size_t)NT * 1536 * 2);
  p.scr = (float*)take((size_t)12 * 1024 * 1024);
  p.ub = (u16*)take((size_t)NT * 512 * 2);
  p.w2t = (u16*)take((size_t)512 * 64 * 2);
  p.a2t = (u16*)take((size_t)512 * 64 * 2);
  p.g2t = (u16*)take((size_t)512 * 128 * 2);
#if 1
  p.p0 = 0; p.p1 = NPHASE;
  hipMemsetAsync(p.bar, 0, 16384, stream);
  void* args[] = {&p};
  hipError_t e = hipLaunchCooperativeKernel((void*)mega, dim3(grid_blocks), dim3(256), args, 0, stream);
  if (e != hipSuccess) fprintf(stderr, "cooperative launch failed: %s (grid %d)\n", hipGetErrorString(e), grid_blocks);
#else
  for (int ph = 0; ph < NPHASE; ph++) {
    p.p0 = ph; p.p1 = ph + 1;
    mega<<<dim3(grid_blocks), dim3(256), 0, stream>>>(p);
  }
#endif
}
```

```cpp
#include <hip/hip_runtime.h>
#include <hip/hip_cooperative_groups.h>
#include <cstdio>
namespace cg = cooperative_groups;

typedef unsigned short u16;
typedef __attribute__((ext_vector_type(8))) short bf16x8;
typedef __attribute__((ext_vector_type(4))) float f32x4;

#define NT 16512
#define PSTR 4480

#define O_RWKV_P 16908288ull
#define O_SHIFT_P 17039360ull
#define O_SSM_P 17046528ull
#define O_CONV_P 17570816ull
#define O_HGRN_P 17589248ull
#define O_RWKV_S 18113536ull
#define O_SHIFT_S 18637824ull
#define O_SSM_S 18666496ull
#define O_CONV_S 20763648ull
#define O_HGRN_S 20837376ull

struct Params {
  const float *x_prompt, *x_sample, *st_rwkv, *st_shift, *st_ssm, *st_conv, *st_hgrn, *c_prompt, *c_sample;
  const float *norm_mix_w, *norm_ffn_w, *norm_out_w, *ada_w, *ada_b, *w_in_ab, *w_out_ab, *mu_a, *w0, *w2, *a0, *a2,
      *g2, *k_k, *k_a, *r_k, *lnx_w, *lnx_b, *conv_w, *conv_b, *dt_bias, *a_log, *d_skip, *norm_b_w, *w_in_c,
      *w_out_c, *lb_param, *norm_c_w, *w_gate, *w_up, *w_down;
  float* out;
  float *mod, *bonus, *dtb;
  u16 *wb_in, *wb_out, *wb_gu, *wb_dn, *hm, *pbuf, *rw, *cv;
  float* scr;
  u16* ub;
  u16 *w2t, *a2t, *g2t;
  unsigned* bar;
  int p0, p1;
};

typedef const __attribute__((address_space(4))) Params& CP;
typedef const __attribute__((address_space(4))) Params* CPP;
__device__ __forceinline__ CPP getp() {
  CPP pp = (CPP)__builtin_amdgcn_kernarg_segment_ptr();
  asm volatile("" : "+s"(pp) : : "memory");
  return pp;
}
__device__ __forceinline__ int otid() {
  int t = threadIdx.x;
  asm volatile("" : "+v"(t));
  return t;
}
__device__ __forceinline__ float bf2f(u16 u) { return __uint_as_float(((unsigned)u) << 16); }
typedef float f32x2_t __attribute__((ext_vector_type(2)));
typedef __bf16 bf16x2_t __attribute__((ext_vector_type(2)));
__device__ __forceinline__ unsigned pack2(float a, float b) {
  f32x2_t v = {a, b};
  bf16x2_t r = __builtin_convertvector(v, bf16x2_t);
  return __builtin_bit_cast(unsigned, r);
}
__device__ __forceinline__ u16 f2bf(float f) { return (u16)(pack2(f, f) & 0xffffu); }
__device__ __forceinline__ float lo16(unsigned v) { return __uint_as_float(v << 16); }
__device__ __forceinline__ float hi16(unsigned v) { return __uint_as_float(v & 0xffff0000u); }
__device__ __forceinline__ float sigm(float x) { return __builtin_amdgcn_rcpf(1.f + __expf(-x)); }
__device__ __forceinline__ float silu_(float x) { return x * __builtin_amdgcn_rcpf(1.f + __expf(-x)); }
__device__ __forceinline__ float softplus_(float x) {
  const float e = __expf(x);
  return x > 20.f ? x : (e < 1e-4f ? e * (1.f - 0.5f * e) : __logf(1.f + e));
}
__device__ __forceinline__ float tanh_(float x) { return 1.f - 2.f * __builtin_amdgcn_rcpf(1.f + __expf(2.f * x)); }

__device__ __forceinline__ int row_seq(int m) { return m < 16384 ? (m >> 13) : 2 + ((m - 16384) >> 4); }
__device__ __forceinline__ int seq_row0(int s) { return s < 2 ? s * 8192 : 16384 + (s - 2) * 16; }
__device__ __forceinline__ int seq_len(int s) { return s < 2 ? 8192 : 16; }
__device__ __forceinline__ float* out_state(float* out, int s, int j, size_t baseP, size_t baseS, size_t sz) {
  return s < 2 ? out + baseP + (size_t)(s * 2 + j) * sz : out + baseS + (size_t)((s - 2) * 2 + j) * sz;
}

template <int CTRL>
__device__ __forceinline__ float dpp_f(float x) {
  return __int_as_float(__builtin_amdgcn_update_dpp(0, __float_as_int(x), CTRL, 0xf, 0xf, false));
}
__device__ __forceinline__ float red16(float x) {
  x += dpp_f<0xB1>(x);
  x += dpp_f<0x4E>(x);
  x += dpp_f<0x124>(x);
  x += dpp_f<0x128>(x);
  return x;
}
__device__ __forceinline__ float red32_hi(float x) {
  x = red16(x);
  float y = __int_as_float(__builtin_amdgcn_update_dpp(0, __float_as_int(x), 0x142, 0xA, 0xf, false));
  return x + y;
}
__device__ __forceinline__ float wave_sum(float x) {
  x = red16(x);
  x += __int_as_float(__builtin_amdgcn_update_dpp(0, __float_as_int(x), 0x142, 0xA, 0xf, false));
  x += __int_as_float(__builtin_amdgcn_update_dpp(0, __float_as_int(x), 0x143, 0xC, 0xf, false));
  return __int_as_float(__builtin_amdgcn_readlane(__float_as_int(x), 63));
}

__device__ void phase_mod(CP p, char* smem, int bid, int nb) {
  if (bid >= 384) return;
  float* sc = (float*)smem;
  float* red = sc + 10 * 1024;
  const int tid = otid(), lane = tid & 63, wv = tid >> 6;
  for (int i = tid; i < 10 * 1024; i += 256) {
    int s = i >> 10, k = i & 1023;
    float c = s < 2 ? p.c_prompt[s * 1024 + k] : p.c_sample[(s - 2) * 1024 + k];
    sc[i] = silu_(c);
  }
  __syncthreads();
  for (int u = bid; u < 384; u += nb) {
    int L = u / 96, cgp = u % 96;
    int col = cgp * 64 + lane;
    const float* W = p.ada_w + (size_t)L * 1024 * 6144 + col;
    float acc[10];
#pragma unroll
    for (int s = 0; s < 10; s++) acc[s] = 0.f;
    int k0 = wv * 256;
#pragma unroll 4
    for (int k = k0; k < k0 + 256; k += 4) {
      float w0 = W[(size_t)k * 6144], w1 = W[(size_t)(k + 1) * 6144], w2 = W[(size_t)(k + 2) * 6144],
            w3 = W[(size_t)(k + 3) * 6144];
#pragma unroll
      for (int s = 0; s < 10; s++) {
        float4 c4 = *(const float4*)&sc[s * 1024 + k];
        acc[s] += c4.x * w0 + c4.y * w1 + c4.z * w2 + c4.w * w3;
      }
    }
#pragma unroll
    for (int s = 0; s < 10; s++) red[(wv * 10 + s) * 64 + lane] = acc[s];
    __syncthreads();
    for (int i = tid; i < 640; i += 256) {
      int s = i >> 6, l = i & 63;
      float v = red[(0 * 10 + s) * 64 + l] + red[(1 * 10 + s) * 64 + l] + red[(2 * 10 + s) * 64 + l] +
                red[(3 * 10 + s) * 64 + l];
      int c = cgp * 64 + l;
      p.mod[((size_t)L * 10 + s) * 6144 + c] = v + p.ada_b[L * 6144 + c];
    }
    __syncthreads();
  }
}

__device__ __forceinline__ void wconv_tile(const float* __restrict__ src, int K, int N, u16* __restrict__ dst, int k0,
                                           int n0, int mode, float* tile) {
  const int tid = otid();
#pragma unroll
  for (int i = 0; i < 4; i++) {
    int r = i * 16 + (tid >> 4), c = (tid & 15) * 4;
    int n = n0 + c;
    float4 v4 = n < N ? *(const float4*)(src + (size_t)(k0 + r) * N + n) : make_float4(0.f, 0.f, 0.f, 0.f);
    tile[r * 65 + c] = v4.x; tile[r * 65 + c + 1] = v4.y; tile[r * 65 + c + 2] = v4.z; tile[r * 65 + c + 3] = v4.w;
  }
  __syncthreads();
  int n = tid >> 2, kc = (tid & 3) * 16;
  unsigned pk[8];
#pragma unroll
  for (int i = 0; i < 8; i++) pk[i] = pack2(tile[(kc + 2 * i) * 65 + n], tile[(kc + 2 * i + 1) * 65 + n]);
  int gn = n0 + n;
  int row = mode == 0 ? gn : ((gn >> 4) * 32 + (gn & 15) + (mode == 2 ? 16 : 0));
  uint4* d = (uint4*)(dst + (size_t)row * K + k0 + kc);
  d[0] = make_uint4(pk[0], pk[1], pk[2], pk[3]);
  d[1] = make_uint4(pk[4], pk[5], pk[6], pk[7]);
  __syncthreads();
}

__device__ void phase_wconv(CP p, int L, char* smem, int bid, int nb) {
  float* tile = (float*)smem;
  const int j = L >> 1;
  const bool even = (L & 1) == 0;
  const int ntn_in = even ? 70 : 64;
  const int n_in = 16 * ntn_in;
  const int n_out = even ? 24 * 16 : 16 * 16;
  const int n_g = 16 * 44;
  const int n_lora = even ? 32 : 0;
  const int total = n_in + n_out + 3 * n_g + n_lora;
  for (int u = bid; u < total; u += nb) {
    int li = u;
    if (li < n_in) {
      int kt = li / ntn_in, nt = li % ntn_in;
      if (even)
        wconv_tile(p.w_in_ab + (size_t)j * 1024 * 4368, 1024, 4368, p.wb_in, kt * 64, nt * 64, 0, tile);
      else
        wconv_tile(p.w_in_c + (size_t)j * 1024 * 4096, 1024, 4096, p.wb_in, kt * 64, nt * 64, 0, tile);
      continue;
    }
    li -= n_in;
    if (li < n_out) {
      int kt = li / 16, nt = li % 16;
      if (even)
        wconv_tile(p.w_out_ab + (size_t)j * 1536 * 1024, 1536, 1024, p.wb_out, kt * 64, nt * 64, 0, tile);
      else
        wconv_tile(p.w_out_c + (size_t)j * 1024 * 1024, 1024, 1024, p.wb_out, kt * 64, nt * 64, 0, tile);
      continue;
    }
    li -= n_out;
    if (li < n_g) {
      int kt = li / 44, nt = li % 44;
      wconv_tile(p.w_gate + (size_t)L * 1024 * 2816, 1024, 2816, p.wb_gu, kt * 64, nt * 64, 1, tile);
      continue;
    }
    li -= n_g;
    if (li < n_g) {
      int kt = li / 44, nt = li % 44;
      wconv_tile(p.w_up + (size_t)L * 1024 * 2816, 1024, 2816, p.wb_gu, kt * 64, nt * 64, 2, tile);
      continue;
    }
    li -= n_g;
    if (li < n_g) {
      int kt = li / 16, nt = li % 16;
      wconv_tile(p.w_down + (size_t)L * 2816 * 1024, 2816, 1024, p.wb_dn, kt * 64, nt * 64, 0, tile);
      continue;
    }
    li -= n_g;
    if (li < 8) wconv_tile(p.w2 + (size_t)j * 64 * 512, 64, 512, p.w2t, 0, li * 64, 0, tile);
    else if (li < 16) wconv_tile(p.a2 + (size_t)j * 64 * 512, 64, 512, p.a2t, 0, (li - 8) * 64, 0, tile);
    else wconv_tile(p.g2 + (size_t)j * 128 * 512, 128, 512, p.g2t, ((li - 16) >> 3) * 64, ((li - 16) & 7) * 64, 0, tile);
  }
}

__device__ void phase_norm(CP p, int L, int which, int bid, int nb) {
  const int tid = otid(), lane = tid & 63, wv = tid >> 6;
  const bool first = (L == 0 && which == 0);
  const float* nw = (which ? p.norm_ffn_w : p.norm_mix_w) + L * 1024;
  float* X = p.out;
  for (int row = bid * 4 + wv; row < NT; row += nb * 4) {
    const float* x = first ? (row < 16384 ? p.x_prompt + (size_t)row * 1024 : p.x_sample + (size_t)(row - 16384) * 1024)
                           : X + (size_t)row * 1024;
    float4 v[4];
    float ss = 0.f;
#pragma unroll
    for (int i = 0; i < 4; i++) {
      v[i] = *(const float4*)(x + i * 256 + lane * 4);
      ss += v[i].x * v[i].x + v[i].y * v[i].y + v[i].z * v[i].z + v[i].w * v[i].w;
    }
    ss = wave_sum(ss);
    float rstd = rsqrtf(ss * (1.f / 1024.f) + 1e-6f);
    int s = row_seq(row);
    const float* md = p.mod + ((size_t)L * 10 + s) * 6144 + (which ? 3072 : 0);
#pragma unroll
    for (int i = 0; i < 4; i++) {
      int c = i * 256 + lane * 4;
      float4 w4 = *(const float4*)(nw + c);
      float4 sh = *(const float4*)(md + c);
      float4 sc = *(const float4*)(md + 1024 + c);
      float h0 = v[i].x * rstd * w4.x * (1.f + sc.x) + sh.x;
      float h1 = v[i].y * rstd * w4.y * (1.f + sc.y) + sh.y;
      float h2 = v[i].z * rstd * w4.z * (1.f + sc.z) + sh.z;
      float h3 = v[i].w * rstd * w4.w * (1.f + sc.w) + sh.w;
      *(uint2*)(p.hm + (size_t)row * 1024 + c) = make_uint2(pack2(h0, h1), pack2(h2, h3));
      if (first) *(float4*)(X + (size_t)row * 1024 + c) = v[i];
    }
  }
}

__device__ void phase_final(CP p, int bid, int nb) {
  const int tid = otid(), lane = tid & 63, wv = tid >> 6;
  float* X = p.out;
  for (int row = bid * 4 + wv; row < NT; row += nb * 4) {
    float* x = X + (size_t)row * 1024;
    float4 v[4];
    float ss = 0.f;
#pragma unroll
    for (int i = 0; i < 4; i++) {
      v[i] = *(const float4*)(x + i * 256 + lane * 4);
      ss += v[i].x * v[i].x + v[i].y * v[i].y + v[i].z * v[i].z + v[i].w * v[i].w;
    }
    ss = wave_sum(ss);
    float rstd = rsqrtf(ss * (1.f / 1024.f) + 1e-6f);
#pragma unroll
    for (int i = 0; i < 4; i++) {
      int c = i * 256 + lane * 4;
      float4 w4 = *(const float4*)(p.norm_out_w + c);
      float4 o;
      o.x = v[i].x * rstd * w4.x;
      o.y = v[i].y * rstd * w4.y;
      o.z = v[i].z * rstd * w4.z;
      o.w = v[i].w * rstd * w4.w;
      *(float4*)(x + c) = o;
    }
  }
}

__device__ void gemm_phase(CP p, const u16* __restrict__ A, int lda, const u16* __restrict__ Bt, int K,
                           int ntn, int epi, u16* __restrict__ outb, int ldo, int ncols, const float* __restrict__ gate,
                           char* smem, int bid, int nb) {
  u16* As = (u16*)smem;
  u16* Bs = As + 128 * 64;
  const int tid = otid(), lane = tid & 63, wv = tid >> 6;
  const int wm = wv >> 1, wn = wv & 1;
  const int lr = tid >> 3, lc = tid & 7;
  const int l15 = lane & 15, lq = lane >> 4;
  const int nk = K >> 6;
  const int nitems = (epi == 2) ? 128 * ntn + 8 * ntn : 129 * ntn;
#define G_DECODE(tile_, mt_, nt_, kt0_, kt1_, split_) { \
    kt0_ = 0; kt1_ = nk; split_ = false; \
    if (epi == 2 && (tile_) >= 128 * ntn) { \
      const int r_ = (tile_) - 128 * ntn; \
      mt_ = 128; nt_ = r_ >> 3; split_ = true; \
      kt0_ = ((r_ & 7) * nk) >> 3; kt1_ = (((r_ & 7) + 1) * nk) >> 3; \
    } else if (epi == 2 && nb == 512 && ntn == 4) { \
        \
      const int slot_ = (tile_) >> 3; \
      mt_ = ((tile_) & 7) * 16 + (slot_ >> 2); nt_ = slot_ & 3; \
    } else { mt_ = (tile_) / ntn; nt_ = (tile_) % ntn; } }
  uint4 ra0, ra1, ra2, ra3, rb0, rb1, rb2, rb3, rb4, rb5, rb6, rb7;
  const int voA = lr * lda + lc * 8, voB = lr * K + lc * 8;
  const int sA = 32 * lda, sB = 32 * K;
#define G_BL(rs_, vo_, so_) __builtin_bit_cast(uint4, __builtin_amdgcn_raw_buffer_load_b128(rs_, vo_, so_, 0))
#define G_LOADP(ab_, bb_, kt_) { \
    __amdgpu_buffer_rsrc_t ra_ = __builtin_amdgcn_make_buffer_rsrc((void*)(ab_), 0, 0x7ffffff0, 0x00020000); \
    __amdgpu_buffer_rsrc_t rb_ = __builtin_amdgcn_make_buffer_rsrc((void*)(bb_), 0, 0x7ffffff0, 0x00020000); \
    const int ka_ = (kt_) * 128; \
    ra0 = G_BL(ra_, voA * 2, ka_); ra1 = G_BL(ra_, voA * 2, ka_ + 2 * sA); ra2 = G_BL(ra_, voA * 2, ka_ + 4 * sA); ra3 = G_BL(ra_, voA * 2, ka_ + 6 * sA); \
    rb0 = G_BL(rb_, voB * 2, ka_); rb1 = G_BL(rb_, voB * 2, ka_ + 2 * sB); rb2 = G_BL(rb_, voB * 2, ka_ + 4 * sB); rb3 = G_BL(rb_, voB * 2, ka_ + 6 * sB); \
    rb4 = G_BL(rb_, voB * 2, ka_ + 8 * sB); rb5 = G_BL(rb_, voB * 2, ka_ + 10 * sB); rb6 = G_BL(rb_, voB * 2, ka_ + 12 * sB); rb7 = G_BL(rb_, voB * 2, ka_ + 14 * sB); }
  bool have = false;
  for (int tile = bid; tile < nitems; tile += nb) {
    int mt, nt, kt0, kt1;
    bool split;
    G_DECODE(tile, mt, nt, kt0, kt1, split)
    const int m0 = mt * 128, n0 = nt * 256;
    f32x4 acc0[4][4], acc1[4][4];
#pragma unroll
    for (int a = 0; a < 4; a++)
#pragma unroll
      for (int b = 0; b < 4; b++) { acc0[a][b] = (f32x4){0.f, 0.f, 0.f, 0.f}; acc1[a][b] = (f32x4){0.f, 0.f, 0.f, 0.f}; }
    const u16* Ab = A + (size_t)m0 * lda;
    const u16* Bb = Bt + (size_t)n0 * K;
    u16* Aw = As + lr * 64 + ((lc ^ (lr & 7)) * 8);
    u16* Bw = Bs + lr * 64 + ((lc ^ (lr & 7)) * 8);
    if (!have) G_LOADP(Ab, Bb, kt0)
    for (int kt = kt0; kt < kt1; kt++) {
      __syncthreads();
      *(uint4*)(Aw) = ra0; *(uint4*)(Aw + 32 * 64) = ra1; *(uint4*)(Aw + 64 * 64) = ra2; *(uint4*)(Aw + 96 * 64) = ra3;
      *(uint4*)(Bw) = rb0; *(uint4*)(Bw + 32 * 64) = rb1; *(uint4*)(Bw + 64 * 64) = rb2; *(uint4*)(Bw + 96 * 64) = rb3;
      *(uint4*)(Bw + 128 * 64) = rb4; *(uint4*)(Bw + 160 * 64) = rb5; *(uint4*)(Bw + 192 * 64) = rb6; *(uint4*)(Bw + 224 * 64) = rb7;
      __syncthreads();
      if (kt + 1 < kt1) G_LOADP(Ab, Bb, kt + 1)
      {
        const int sw0 = (lq ^ (l15 & 7)) * 8, sw1 = ((lq + 4) ^ (l15 & 7)) * 8;
        __builtin_amdgcn_s_setprio(1);
        const u16* Ar = As + (wm * 64 + l15) * 64;
        const u16* Br = Bs + (wn * 128 + l15) * 64;
        bf16x8 af0[4];
#pragma unroll
        for (int mi = 0; mi < 4; mi++) af0[mi] = *(const bf16x8*)(Ar + mi * 16 * 64 + sw0);
        bf16x8 bq0 = *(const bf16x8*)(Br + sw0);
        bf16x8 bq1 = *(const bf16x8*)(Br + 16 * 64 + sw0);
        __builtin_amdgcn_sched_barrier(0);
#define G_STEP(ACC, nidx, bcur, nextni, nextsw, donext) { \
          bf16x8 bn_ = bcur; \
          if (donext) bcur = *(const bf16x8*)(Br + (nextni) * 16 * 64 + (nextsw)); \
          _Pragma("unroll") for (int mi = 0; mi < 4; mi++) \
            ACC[mi][nidx] = __builtin_amdgcn_mfma_f32_16x16x32_bf16(af0[mi], bn_, ACC[mi][nidx], 0, 0, 0); \
          __builtin_amdgcn_sched_barrier(0); }
        G_STEP(acc0, 0, bq0, 2, sw0, true)
        G_STEP(acc0, 1, bq1, 3, sw0, true)
        G_STEP(acc0, 2, bq0, 4, sw0, true)
        G_STEP(acc0, 3, bq1, 5, sw0, true)
        G_STEP(acc1, 0, bq0, 6, sw0, true)
        G_STEP(acc1, 1, bq1, 7, sw0, true)
        G_STEP(acc1, 2, bq0, 0, sw1, true)
        G_STEP(acc1, 3, bq1, 1, sw1, true)
#pragma unroll
        for (int mi = 0; mi < 4; mi++) af0[mi] = *(const bf16x8*)(Ar + mi * 16 * 64 + sw1);
        __builtin_amdgcn_sched_barrier(0);
        G_STEP(acc0, 0, bq0, 2, sw1, true)
        G_STEP(acc0, 1, bq1, 3, sw1, true)
        G_STEP(acc0, 2, bq0, 4, sw1, true)
        G_STEP(acc0, 3, bq1, 5, sw1, true)
        G_STEP(acc1, 0, bq0, 6, sw1, true)
        G_STEP(acc1, 1, bq1, 7, sw1, true)
        G_STEP(acc1, 2, bq0, 0, 0, false)
        G_STEP(acc1, 3, bq1, 0, 0, false)
        __builtin_amdgcn_s_setprio(0);
      }
    }
    {
      const int ntile = tile + nb;
      have = ntile < nitems;
      if (have) {
        int mt2, nt2, k0n, k1n; bool sp2;
        G_DECODE(ntile, mt2, nt2, k0n, k1n, sp2)
        (void)k1n; (void)sp2;
        G_LOADP(A + (size_t)(mt2 * 128) * lda, Bt + (size_t)(nt2 * 256) * K, k0n)
      }
    }
    if (epi == 2) {
#pragma unroll
      for (int mi = 0; mi < 4; mi++)
#pragma unroll
        for (int jj = 0; jj < 4; jj++) {
          int row = m0 + wm * 64 + mi * 16 + lq * 4 + jj;
          int s = row_seq(row);
          const float* g = gate + (size_t)s * 6144;
          float* xr = p.out + (size_t)row * 1024;
#pragma unroll
          for (int ni = 0; ni < 4; ni++) {
            int col = n0 + wn * 128 + ni * 16 + l15;
            if (split) { atomicAdd(&xr[col], g[col] * acc0[mi][ni][jj]); atomicAdd(&xr[col + 64], g[col + 64] * acc1[mi][ni][jj]); }
            else { xr[col] += g[col] * acc0[mi][ni][jj]; xr[col + 64] += g[col + 64] * acc1[mi][ni][jj]; }
          }
        }
    } else if (epi == 0) {
      u16* Cs = (u16*)smem;
#define EPI0_HALF(hp, ACC) { \
        __syncthreads(); \
        _Pragma("unroll") for (int mi = 0; mi < 4; mi++) \
          _Pragma("unroll") for (int n4 = 0; n4 < 4; n4++) \
            _Pragma("unroll") for (int jj = 0; jj < 4; jj++) { \
              int r = wm * 64 + mi * 16 + lq * 4 + jj, c = wn * 64 + n4 * 16 + l15; \
              Cs[r * 136 + c] = f2bf(ACC[mi][n4][jj]); } \
        __syncthreads(); \
        _Pragma("unroll") for (int i = 0; i < 8; i++) { \
          int q = tid + 256 * i; \
          int r = q >> 4, ch = q & 15; \
          int gcol = n0 + (ch >> 3) * 128 + (hp) * 64 + (ch & 7) * 8; \
          if (gcol < ncols) *(uint4*)(outb + (size_t)(m0 + r) * ldo + gcol) = *(const uint4*)(Cs + r * 136 + ch * 8); } }
      EPI0_HALF(0, acc0)
      EPI0_HALF(1, acc1)
    } else {
      __syncthreads();
      u16* Cs = (u16*)smem;
#pragma unroll
      for (int mi = 0; mi < 4; mi++)
#pragma unroll
        for (int i2 = 0; i2 < 2; i2++)
#pragma unroll
          for (int jj = 0; jj < 4; jj++) {
            int r = wm * 64 + mi * 16 + lq * 4 + jj, c = wn * 64 + i2 * 16 + l15;
            float g0 = acc0[mi][2 * i2][jj], u0 = acc0[mi][2 * i2 + 1][jj];
            float g1 = acc1[mi][2 * i2][jj], u1 = acc1[mi][2 * i2 + 1][jj];
            Cs[r * 136 + c] = f2bf(silu_(g0) * u0);
            Cs[r * 136 + c + 32] = f2bf(silu_(g1) * u1);
          }
      __syncthreads();
#pragma unroll
      for (int i = 0; i < 8; i++) {
        int q = tid + 256 * i;
        int r = q >> 4, ch = q & 15;
        *(uint4*)(outb + (size_t)(m0 + r) * ldo + nt * 128 + ch * 8) = *(const uint4*)(Cs + r * 136 + ch * 8);
      }
    }
  }
}

__device__ void phase_prep_even(CP p, int j, char* smem, int bid, int nb) {
  const int tid = otid();
  const u16* P = p.pbuf;
  {
    u16* txb = (u16*)smem;
    u16* xab = txb + 16 * 72;
    float* resw = (float*)(xab + 16 * 72);
    float* resa = resw + 8 * 512;
    for (int i = tid; i < 2 * 16 * 72; i += 256) txb[i] = 0;
    const int half = tid >> 7, hk = tid & 127, h = hk >> 4, kq = hk & 15;
    const int c4 = h * 64 + kq * 4;
    const float* mu = p.mu_a + j * 1792;
    for (int u = bid; u < NT / 8; u += nb) {
      const int m0 = u * 8;
      const int s = row_seq(m0);
      const int r0 = seq_row0(s);
      __syncthreads();
#pragma unroll
      for (int i = 0; i < 4; i++) {
        int idx = tid + 256 * i;
        int tok = idx >> 7, cc = idx & 127;
        int m = m0 + tok;
        int col = 1536 + cc;
        float pc = bf2f(P[(size_t)m * PSTR + col]);
        float pp = (m > r0) ? bf2f(P[(size_t)(m - 1) * PSTR + col])
                            : (s >= 2 ? p.st_shift[((size_t)(s - 2) * 2 + j) * 1792 + col] : 0.f);
        float pm = pc + (pp - pc) * mu[col];
        if (cc < 64)
          txb[tok * 72 + cc] = f2bf(tanh_(pm));
        else
          xab[tok * 72 + cc - 64] = f2bf(pm);
      }
      __syncthreads();
      {
        const int lane = tid & 63, wv = tid >> 6, l15 = lane & 15, lq = lane >> 4;
        bf16x8 aw[2], aa[2];
#pragma unroll
        for (int ks = 0; ks < 2; ks++) {
          aw[ks] = *(const bf16x8*)(txb + l15 * 72 + ks * 32 + lq * 8);
          aa[ks] = *(const bf16x8*)(xab + l15 * 72 + ks * 32 + lq * 8);
        }
#pragma unroll
        for (int nt = 0; nt < 8; nt++) {
          const int n = wv * 128 + nt * 16 + l15;
          f32x4 cw = (f32x4){0.f, 0.f, 0.f, 0.f}, ca = (f32x4){0.f, 0.f, 0.f, 0.f};
#pragma unroll
          for (int ks = 0; ks < 2; ks++) {
            bf16x8 bw = *(const bf16x8*)(p.w2t + (size_t)n * 64 + ks * 32 + lq * 8);
            bf16x8 ba = *(const bf16x8*)(p.a2t + (size_t)n * 64 + ks * 32 + lq * 8);
            cw = __builtin_amdgcn_mfma_f32_16x16x32_bf16(aw[ks], bw, cw, 0, 0, 0);
            ca = __builtin_amdgcn_mfma_f32_16x16x32_bf16(aa[ks], ba, ca, 0, 0, 0);
          }
          if (lq < 2) {
#pragma unroll
            for (int jj = 0; jj < 4; jj++) {
              resw[(lq * 4 + jj) * 512 + n] = cw[jj];
              resa[(lq * 4 + jj) * 512 + n] = ca[jj];
            }
          }
        }
      }
      __syncthreads();
      float accw[4][4], acca[4][4];
#pragma unroll
      for (int tk = 0; tk < 4; tk++) {
        float4 rw4 = *(const float4*)(resw + (half * 4 + tk) * 512 + c4);
        float4 ra4 = *(const float4*)(resa + (half * 4 + tk) * 512 + c4);
        accw[tk][0] = rw4.x; accw[tk][1] = rw4.y; accw[tk][2] = rw4.z; accw[tk][3] = rw4.w;
        acca[tk][0] = ra4.x; acca[tk][1] = ra4.y; acca[tk][2] = ra4.z; acca[tk][3] = ra4.w;
      }
      float4 w0v = *(const float4*)(p.w0 + j * 512 + c4);
      float4 a0v = *(const float4*)(p.a0 + j * 512 + c4);
      float4 kkv = *(const float4*)(p.k_k + j * 512 + c4);
      float4 kav = *(const float4*)(p.k_a + j * 512 + c4);
      float4 rkv = *(const float4*)(p.r_k + j * 512 + c4);
      float4 mur = *(const float4*)(mu + c4);
      float4 muk = *(const float4*)(mu + 512 + c4);
      float4 muv = *(const float4*)(mu + 1024 + c4);
      const float w0a[4] = {w0v.x, w0v.y, w0v.z, w0v.w};
      const float a0a[4] = {a0v.x, a0v.y, a0v.z, a0v.w};
      const float kka[4] = {kkv.x, kkv.y, kkv.z, kkv.w};
      const float kaa[4] = {kav.x, kav.y, kav.z, kav.w};
      const float rka[4] = {rkv.x, rkv.y, rkv.z, rkv.w};
      const float mura[4] = {mur.x, mur.y, mur.z, mur.w};
      const float muka[4] = {muk.x, muk.y, muk.z, muk.w};
      const float muva[4] = {muv.x, muv.y, muv.z, muv.w};
#pragma unroll
      for (int tk = 0; tk < 4; tk++) {
        const int m = m0 + half * 4 + tk;
        uint2 pr = *(const uint2*)(P + (size_t)m * PSTR + c4);
        uint2 pk = *(const uint2*)(P + (size_t)m * PSTR + 512 + c4);
        uint2 pv = *(const uint2*)(P + (size_t)m * PSTR + 1024 + c4);
        float rc[4] = {lo16(pr.x), hi16(pr.x), lo16(pr.y), hi16(pr.y)};
        float kc[4] = {lo16(pk.x), hi16(pk.x), lo16(pk.y), hi16(pk.y)};
        float vc[4] = {lo16(pv.x), hi16(pv.x), lo16(pv.y), hi16(pv.y)};
        float rp[4], kp[4], vp[4];
        if (m > r0) {
          uint2 qr = *(const uint2*)(P + (size_t)(m - 1) * PSTR + c4);
          uint2 qk = *(const uint2*)(P + (size_t)(m - 1) * PSTR + 512 + c4);
          uint2 qv = *(const uint2*)(P + (size_t)(m - 1) * PSTR + 1024 + c4);
          rp[0] = lo16(qr.x); rp[1] = hi16(qr.x); rp[2] = lo16(qr.y); rp[3] = hi16(qr.y);
          kp[0] = lo16(qk.x); kp[1] = hi16(qk.x); kp[2] = lo16(qk.y); kp[3] = hi16(qk.y);
          vp[0] = lo16(qv.x); vp[1] = hi16(qv.x); vp[2] = lo16(qv.y); vp[3] = hi16(qv.y);
        } else if (s >= 2) {
          const float* sp = p.st_shift + ((size_t)(s - 2) * 2 + j) * 1792;
#pragma unroll
          for (int e = 0; e < 4; e++) { rp[e] = sp[c4 + e]; kp[e] = sp[512 + c4 + e]; vp[e] = sp[1024 + c4 + e]; }
        } else {
#pragma unroll
          for (int e = 0; e < 4; e++) { rp[e] = 0.f; kp[e] = 0.f; vp[e] = 0.f; }
        }
        float r[4], k[4], v[4], kk[4], kn[4], bb[4], ee[4];
        float ssq = 0.f, bsum = 0.f;
#pragma unroll
        for (int e = 0; e < 4; e++) {
          r[e] = rc[e] + (rp[e] - rc[e]) * mura[e];
          k[e] = kc[e] + (kp[e] - kc[e]) * muka[e];
          v[e] = vc[e] + (vp[e] - vc[e]) * muva[e];
          float wpre = w0a[e] + accw[tk][e];
          float w = -softplus_(-wpre) - 0.5f;
          { const float ew = __expf(w); ee[e] = ew < 1e-3f ? ew * (1.f - 0.5f * ew) : 1.f - __expf(-ew); }
          float a = sigm(a0a[e] + acca[tk][e]);
          kk[e] = k[e] * kka[e];
          ssq += kk[e] * kk[e];
          kn[e] = k[e] * (1.f + (a - 1.f) * kaa[e]);
          bb[e] = a;
          bsum += r[e] * kn[e] * rka[e];
        }
        ssq = red16(ssq);
        bsum = red16(bsum);
        float inv = rsqrtf(fmaxf(ssq, 1e-24f));
#pragma unroll
        for (int e = 0; e < 4; e++) { kk[e] *= inv; bb[e] = kk[e] * bb[e]; }
        if (kq == 0) p.bonus[(size_t)m * 8 + h] = bsum;
        uint4* dst = (uint4*)(p.rw + (((size_t)m * 8 + h) * 16 + kq) * 24);
        dst[0] = make_uint4(pack2(r[0], r[1]), pack2(r[2], r[3]), pack2(kn[0], kn[1]), pack2(kn[2], kn[3]));
        dst[1] = make_uint4(pack2(kk[0], kk[1]), pack2(kk[2], kk[3]), pack2(bb[0], bb[1]), pack2(bb[2], bb[3]));
        dst[2] = make_uint4(pack2(ee[0], ee[1]), pack2(ee[2], ee[3]), pack2(v[0], v[1]), pack2(v[2], v[3]));
      }
    }
  }
  for (int idx = bid * 256 + tid; idx < 10 * 1792; idx += nb * 256) {
    int s = idx / 1792, c = idx % 1792;
    int m = seq_row0(s) + seq_len(s) - 1;
    float* o = out_state(p.out, s, j, O_SHIFT_P, O_SHIFT_S, 1792);
    o[c] = bf2f(P[(size_t)m * PSTR + c]);
  }
  for (int u = bid; u < NT / 16; u += nb) {
    const int mb = u * 16;
    const int s = row_seq(mb);
    const int r0 = seq_row0(s);
    if (tid < 192) {
      const int c0 = tid * 8;
      const int t0 = mb - r0;
      float wgt[4][8], bia[8];
      {
        float4 b0 = *(const float4*)(p.conv_b + j * 1536 + c0), b1 = *(const float4*)(p.conv_b + j * 1536 + c0 + 4);
        bia[0] = b0.x; bia[1] = b0.y; bia[2] = b0.z; bia[3] = b0.w; bia[4] = b1.x; bia[5] = b1.y; bia[6] = b1.z; bia[7] = b1.w;
#pragma unroll
        for (int tap = 0; tap < 4; tap++) {
          const float* cw = p.conv_w + ((size_t)j * 4 + tap) * 1536 + c0;
          float4 w0 = *(const float4*)cw, w1 = *(const float4*)(cw + 4);
          wgt[tap][0] = w0.x; wgt[tap][1] = w0.y; wgt[tap][2] = w0.z; wgt[tap][3] = w0.w;
          wgt[tap][4] = w1.x; wgt[tap][5] = w1.y; wgt[tap][6] = w1.z; wgt[tap][7] = w1.w;
        }
      }
#pragma unroll 1
      for (int hf = 0; hf < 2; hf++) {
      uint4 rows[11];
#pragma unroll
      for (int i = 0; i < 11; i++) {
        const int tt = t0 + hf * 8 - 3 + i;
        if (tt >= 0) {
          rows[i] = *(const uint4*)(P + (size_t)(r0 + tt) * PSTR + 2816 + c0);
        } else if (s >= 2) {
          const float* cs = p.st_conv + (((size_t)(s - 2) * 2 + j) * 3 + (tt + 3)) * 1536 + c0;
          float4 q0 = *(const float4*)cs, q1 = *(const float4*)(cs + 4);
          rows[i] = make_uint4(pack2(q0.x, q0.y), pack2(q0.z, q0.w), pack2(q1.x, q1.y), pack2(q1.z, q1.w));
        } else {
          rows[i] = make_uint4(0, 0, 0, 0);
        }
      }
#pragma unroll
      for (int t = 0; t < 8; t++) {
        float acc[8];
#pragma unroll
        for (int e = 0; e < 8; e++) acc[e] = bia[e];
#pragma unroll
        for (int tap = 0; tap < 4; tap++) {
          const uint4 q = rows[t + tap];
          acc[0] += wgt[tap][0] * lo16(q.x); acc[1] += wgt[tap][1] * hi16(q.x);
          acc[2] += wgt[tap][2] * lo16(q.y); acc[3] += wgt[tap][3] * hi16(q.y);
          acc[4] += wgt[tap][4] * lo16(q.z); acc[5] += wgt[tap][5] * hi16(q.z);
          acc[6] += wgt[tap][6] * lo16(q.w); acc[7] += wgt[tap][7] * hi16(q.w);
        }
        *(uint4*)(p.cv + (size_t)(mb + hf * 8 + t) * 1536 + c0) =
            make_uint4(pack2(silu_(acc[0]), silu_(acc[1])), pack2(silu_(acc[2]), silu_(acc[3])),
                       pack2(silu_(acc[4]), silu_(acc[5])), pack2(silu_(acc[6]), silu_(acc[7])));
      }
      }
    }
    {
      int tok = tid >> 4, hh = tid & 15;
      int m = mb + tok;
      float dtv = softplus_(bf2f(P[(size_t)m * PSTR + 4352 + hh]) + p.dt_bias[j * 16 + hh]);
      float* cs = (float*)smem;
      __syncthreads();
      cs[tid] = -dtv * __expf(p.a_log[j * 16 + hh]);
      __syncthreads();
      float G = 0.f;
      for (int i = 0; i <= tok; i++) G += cs[i * 16 + hh];
      p.dtb[(size_t)m * 32 + hh] = dtv;
      p.dtb[(size_t)m * 32 + 16 + hh] = G;
    }
  }
  for (int idx = bid * 256 + tid; idx < 10 * 3 * 1536; idx += nb * 256) {
    int s = idx / 4608, rem = idx % 4608;
    int r = rem / 1536, c = rem % 1536;
    int m = seq_row0(s) + seq_len(s) - 3 + r;
    float* o = out_state(p.out, s, j, O_CONV_P, O_CONV_S, 4608);
    o[rem] = bf2f(P[(size_t)m * PSTR + 2816 + c]);
  }
}

__device__ __forceinline__ void cvt8_store(float* d, uint4 v) {
  *(float4*)d = make_float4(lo16(v.x), hi16(v.x), lo16(v.y), hi16(v.y));
  *(float4*)(d + 4) = make_float4(lo16(v.z), hi16(v.z), lo16(v.w), hi16(v.w));
}

#define RK_NOC 4
#define RK_BASE(p) ((p).scr + 2100000)
#define RK_LS(p) (RK_BASE(p))
#define RK_PS(p) (RK_BASE(p) + 262144)
#define RK_SI(p) (RK_BASE(p) + 524288)
template <int PART>
__device__ __forceinline__ void rwkv_scan_item(CP p, int j, int s, int h, int rg, int oc, int noc, char* smem) {
  float* Lb = (float*)smem;
  float* ob = Lb + 2 * 16 * 16 * 28;
  const int tid = otid(), lane = tid & 63, wv = tid >> 6;
  const int rl = lane >> 4, kq = lane & 15;
  const int R = rg * 16 + wv * 4 + rl;
  const int T = seq_len(s) / noc, m0 = seq_row0(s) + oc * T;
  float S[4];
  if (PART == 1) {
#pragma unroll
    for (int e = 0; e < 4; e++) S[e] = (R == kq * 4 + e) ? 1.f : 0.f;
  } else if (s >= 2) {
    float4 q = *(const float4*)(p.st_rwkv + ((((size_t)(s - 2) * 2 + j) * 8 + h) * 64 + R) * 64 + kq * 4);
    S[0] = q.x; S[1] = q.y; S[2] = q.z; S[3] = q.w;
  } else {
    S[0] = S[1] = S[2] = S[3] = 0.f;
  }
  const u16* src = p.rw + ((size_t)m0 * 8 + h) * 16 * 24;
  const int q0 = tid, q1 = tid + 256, q2 = tid + 512;
  const int so0 = (q0 / 48) * 3072 + (q0 % 48) * 8, so1 = (q1 / 48) * 3072 + (q1 % 48) * 8,
            so2 = (q2 / 48) * 3072 + (q2 % 48) * 8;
  const int do0 = ((q0 / 48) * 16 + (q0 % 48) / 3) * 28 + ((q0 % 48) % 3) * 8,
            do1 = ((q1 / 48) * 16 + (q1 % 48) / 3) * 28 + ((q1 % 48) % 3) * 8,
            do2 = ((q2 / 48) * 16 + (q2 % 48) / 3) * 28 + ((q2 % 48) % 3) * 8;
  u16* outp = PART ? p.ub + (size_t)(m0 + (tid >> 4)) * 512 + h * 64 + rg * 16 + (tid & 15)
                   : p.hm + (size_t)(m0 + (tid >> 4)) * 1536 + h * 64 + rg * 16 + (tid & 15);
  const int ostr = PART ? 16 * 512 : 16 * 1536;
  const int nbat = T >> 4;
  uint4 a0, a1, a2, c0, c1, c2;
#define RW_ISSUE(r0, r1, r2, bt) { const u16* sp_ = src + (size_t)(bt) * 16 * 3072; \
    r0 = *(const uint4*)(sp_ + so0); r1 = *(const uint4*)(sp_ + so1); r2 = *(const uint4*)(sp_ + so2); }
#define RW_STASH(r0, r1, r2, bi) { float* d_ = Lb + (bi) * (16 * 16 * 28); \
    cvt8_store(d_ + do0, r0); cvt8_store(d_ + do1, r1); cvt8_store(d_ + do2, r2); }
#define RW_COMPUTE(bt) { \
    const float* cur = Lb + ((bt) & 1) * (16 * 16 * 28); \
    float* obc = ob + ((bt) & 1) * 256; \
    float op[16]; \
    f32x2_t Sa = {S[0], S[1]}, Sb = {S[2], S[3]}; \
    _Pragma("unroll") for (int st = 0; st < 16; st++) { \
      const float* sl = cur + (st * 16 + kq) * 28; \
      float4 r4 = *(const float4*)(sl), k4 = *(const float4*)(sl + 4), kk4 = *(const float4*)(sl + 8), \
             b4 = *(const float4*)(sl + 12), e4 = *(const float4*)(sl + 16); \
      float v = PART ? 0.f : cur[(st * 16 + (R >> 2)) * 28 + 20 + (R & 3)]; \
      f32x2_t t_ = Sa * (f32x2_t){kk4.x, kk4.y}; \
      t_ = Sb * (f32x2_t){kk4.z, kk4.w} + t_; \
      const float sa = -red16(t_.x + t_.y); \
      Sa = Sa - Sa * (f32x2_t){e4.x, e4.y}; Sb = Sb - Sb * (f32x2_t){e4.z, e4.w}; \
      if (!PART) { Sa = (f32x2_t){v, v} * (f32x2_t){k4.x, k4.y} + Sa; Sb = (f32x2_t){v, v} * (f32x2_t){k4.z, k4.w} + Sb; } \
      Sa = (f32x2_t){sa, sa} * (f32x2_t){b4.x, b4.y} + Sa; Sb = (f32x2_t){sa, sa} * (f32x2_t){b4.z, b4.w} + Sb; \
      f32x2_t u_ = Sa * (f32x2_t){r4.x, r4.y}; \
      u_ = Sb * (f32x2_t){r4.z, r4.w} + u_; \
      op[st] = u_.x + u_.y; \
      if ((st & 7) == 7) __builtin_amdgcn_sched_barrier(0); \
    } \
    S[0] = Sa.x; S[1] = Sa.y; S[2] = Sb.x; S[3] = Sb.y; \
      \
    { const bool b3_ = (kq & 8) != 0, b2_ = (kq & 4) != 0, b1_ = (kq & 2) != 0, b0_ = (kq & 1) != 0; \
      float s1_[8], s2_[4], s3_[2]; \
      _Pragma("unroll") for (int i = 0; i < 8; i++) s1_[i] = (b3_ ? op[i + 8] : op[i]) + dpp_f<0x140>(b3_ ? op[i] : op[i + 8]); \
      _Pragma("unroll") for (int i = 0; i < 4; i++) s2_[i] = (b2_ ? s1_[i + 4] : s1_[i]) + dpp_f<0x141>(b2_ ? s1_[i] : s1_[i + 4]); \
      _Pragma("unroll") for (int i = 0; i < 2; i++) s3_[i] = (b1_ ? s2_[i + 2] : s2_[i]) + dpp_f<0x1B>(b1_ ? s2_[i] : s2_[i + 2]); \
      const float tot_ = (b0_ ? s3_[1] : s3_[0]) + dpp_f<0xB1>(b0_ ? s3_[0] : s3_[1]); \
      obc[kq * 16 + wv * 4 + rl] = tot_; } }
#define RW_OUT(bt) { outp[(size_t)(bt) * ostr] = f2bf(ob[((bt) & 1) * 256 + tid]); }
  __syncthreads();
  RW_ISSUE(a0, a1, a2, 0)
  RW_STASH(a0, a1, a2, 0)
  if (1 < nbat) RW_ISSUE(a0, a1, a2, 1)
  if (2 < nbat) RW_ISSUE(c0, c1, c2, 2)
  __syncthreads();
  for (int b = 0; b < nbat; b += 2) {
    RW_COMPUTE(b)
    if (b + 1 < nbat) RW_STASH(a0, a1, a2, 1)
    __syncthreads();
    RW_OUT(b)
    if (b + 1 >= nbat) break;
    if (b + 3 < nbat) RW_ISSUE(a0, a1, a2, b + 3)
    RW_COMPUTE(b + 1)
    if (b + 2 < nbat) RW_STASH(c0, c1, c2, 0)
    __syncthreads();
    RW_OUT(b + 1)
    if (b + 4 < nbat) RW_ISSUE(c0, c1, c2, b + 4)
  }
  if (noc == 1) {
    float* o = out_state(p.out, s, j, O_RWKV_P, O_RWKV_S, 32768);
    *(float4*)(o + ((size_t)h * 64 + R) * 64 + kq * 4) = make_float4(S[0], S[1], S[2], S[3]);
  } else {
    float* o = (PART ? RK_PS(p) : RK_LS(p)) + (size_t)((s * 8 + h) * 4 + oc) * 4096;
    *(float4*)(o + (size_t)R * 64 + kq * 4) = make_float4(S[0], S[1], S[2], S[3]);
  }
  __syncthreads();
}

__device__ __forceinline__ void rwkv_combine_item(CP p, int j, int s, int h, char* smem) {
  float* Sl = (float*)smem;
  const int tid = otid();
  const int r = tid >> 2, jq = tid & 3;
  const size_t idx0 = (size_t)(s * 8 + h) * 4;
  float cur[16];
  {
    const float* l0 = RK_LS(p) + idx0 * 4096 + r * 64 + jq * 16;
#pragma unroll
    for (int c = 0; c < 16; c++) cur[c] = l0[c];
  }
  for (int oc = 1; oc < RK_NOC; oc++) {
    float* si = RK_SI(p) + (idx0 + oc) * 4096 + r * 64 + jq * 16;
    __syncthreads();
#pragma unroll
    for (int c = 0; c < 16; c++) { si[c] = cur[c]; Sl[r * 65 + jq * 16 + c] = cur[c]; }
    __syncthreads();
    float nx[16];
    {
      const float* lo = RK_LS(p) + (idx0 + oc) * 4096 + r * 64 + jq * 16;
#pragma unroll
      for (int c = 0; c < 16; c++) nx[c] = lo[c];
    }
    const float* pm = RK_PS(p) + (idx0 + oc) * 4096 + jq * 16;
    for (int i = 0; i < 64; i++) {
      const float sv = Sl[r * 65 + i];
      const float4 p0 = *(const float4*)(pm + i * 64), p1 = *(const float4*)(pm + i * 64 + 4),
                   p2 = *(const float4*)(pm + i * 64 + 8), p3 = *(const float4*)(pm + i * 64 + 12);
      nx[0] += sv * p0.x; nx[1] += sv * p0.y; nx[2] += sv * p0.z; nx[3] += sv * p0.w;
      nx[4] += sv * p1.x; nx[5] += sv * p1.y; nx[6] += sv * p1.z; nx[7] += sv * p1.w;
      nx[8] += sv * p2.x; nx[9] += sv * p2.y; nx[10] += sv * p2.z; nx[11] += sv * p2.w;
      nx[12] += sv * p3.x; nx[13] += sv * p3.y; nx[14] += sv * p3.z; nx[15] += sv * p3.w;
    }
#pragma unroll
    for (int c = 0; c < 16; c++) cur[c] = nx[c];
  }
  float* o = out_state(p.out, s, j, O_RWKV_P, O_RWKV_S, 32768) + ((size_t)h * 64 + r) * 64 + jq * 16;
#pragma unroll
  for (int c = 0; c < 16; c++) o[c] = cur[c];
  __syncthreads();
}

typedef __attribute__((ext_vector_type(4))) short bf16x4;
#define MB_SL(p) ((p).scr)
#define MB_DD(p) ((p).scr + 256 * 8192)
#define MB_NOC 8
template <int MODE>
__device__ __forceinline__ void mamba_scan_item(CP p, int j, int s, int h, int oc, int noc, char* smem) {
  u16* Bs = (u16*)smem;
  u16* Cs = Bs + 2 * 16 * 136;
  u16* BTs = Cs + 2 * 16 * 136;
  u16* XTs = BTs + 2 * 128 * 24;
  u16* XBs = XTs + 2 * 64 * 24;
  u16* SsT = XBs + 2 * 64 * 24;
  float* Gs = (float*)(SsT + 64 * 136);
  const int tid = otid(), lane = tid & 63, wv = tid >> 6;
  const int l15 = lane & 15, lq = lane >> 4;
  const int g = h >> 3;
  const int T = seq_len(s);
  const int nch = (T >> 4) / noc;
  const int m0 = seq_row0(s) + oc * nch * 16;
  f32x4 acc[8];
#pragma unroll
  for (int nt = 0; nt < 8; nt++) acc[nt] = (f32x4){0.f, 0.f, 0.f, 0.f};
  float prodD = 1.f;
  if (MODE == 1) {
    if (s >= 2) {
      const float* sp = p.st_ssm + (((size_t)(s - 2) * 2 + j) * 16 + h) * 8192 + (size_t)(wv * 16 + lq * 4) * 128 + l15;
#pragma unroll
      for (int nt = 0; nt < 8; nt++)
        acc[nt] = (f32x4){sp[nt * 16], sp[128 + nt * 16], sp[256 + nt * 16], sp[384 + nt * 16]};
    } else {
      for (int cp = 0; cp < oc; cp++) {
        const size_t idx = (size_t)((s * 16 + h) * 8 + cp);
        const float dd = MB_DD(p)[idx];
        const float* sp = MB_SL(p) + idx * 8192 + (size_t)(wv * 16 + lq * 4) * 128 + l15;
#pragma unroll
        for (int nt = 0; nt < 8; nt++)
          acc[nt] = (f32x4){acc[nt][0] * dd + sp[nt * 16], acc[nt][1] * dd + sp[128 + nt * 16],
                            acc[nt][2] * dd + sp[256 + nt * 16], acc[nt][3] * dd + sp[384 + nt * 16]};
      }
    }
  }
  const u16* Pb = p.cv + (size_t)(m0 + (tid >> 4)) * 1536 + 1024 + g * 128 + (tid & 15) * 8;
  const u16* Px = p.cv + (size_t)(m0 + ((tid >> 3) & 15)) * 1536 + h * 64 + (tid & 7) * 8;
  const float* Pdt = p.dtb + (size_t)(m0 + ((tid >> 3) & 15)) * 32 + h;
  const float* PgL = p.dtb + (size_t)(m0 + 15) * 32 + 16 + h;
  const float* PG = p.dtb + (size_t)(m0 + (tid & 15)) * 32 + 16 + h;
  uint4 ab, ac, ax, cb, cc, cx;
  float adt = 0.f, ag = 0.f, agl = 0.f, aG = 0.f, cdt = 0.f, cg = 0.f, cgl = 0.f, cG = 0.f;
  ab = make_uint4(0, 0, 0, 0); ac = ab; ax = ab; cb = ab; cc = ab; cx = ab;
#define MM_ISSUE(rb, rc, rx, rdt, rg, rgl, rG, c) { \
    rb = *(const uint4*)(Pb + (size_t)(c) * 16 * 1536); \
    if (MODE == 1) rc = *(const uint4*)(Pb + (size_t)(c) * 16 * 1536 + 256); \
    if (tid < 128) { rx = *(const uint4*)(Px + (size_t)(c) * 16 * 1536); rdt = Pdt[(size_t)(c) * 16 * 32]; \
      rg = Pdt[(size_t)(c) * 16 * 32 + 16]; rgl = PgL[(size_t)(c) * 16 * 32]; } \
    if (tid < 16) rG = PG[(size_t)(c) * 16 * 32]; }
#define MM_T8(dst, rv, sc) { \
      dst[0 * 24] = f2bf(lo16(rv.x) * (sc)); dst[1 * 24] = f2bf(hi16(rv.x) * (sc)); dst[2 * 24] = f2bf(lo16(rv.y) * (sc)); dst[3 * 24] = f2bf(hi16(rv.y) * (sc)); \
      dst[4 * 24] = f2bf(lo16(rv.z) * (sc)); dst[5 * 24] = f2bf(hi16(rv.z) * (sc)); dst[6 * 24] = f2bf(lo16(rv.w) * (sc)); dst[7 * 24] = f2bf(hi16(rv.w) * (sc)); }
#define MM_STASH(rb, rc, rx, rdt, rg, rgl, rG, bi) { \
    if (MODE == 1) { *(uint4*)(Bs + (bi) * (16 * 136) + (tid >> 4) * 136 + (tid & 15) * 8) = rb; \
                     *(uint4*)(Cs + (bi) * (16 * 136) + (tid >> 4) * 136 + (tid & 15) * 8) = rc; } \
    { u16* bd_ = BTs + (bi) * (128 * 24) + ((tid & 15) * 8) * 24 + (tid >> 4); \
      bd_[0 * 24] = (u16)(rb.x & 0xffff); bd_[1 * 24] = (u16)(rb.x >> 16); bd_[2 * 24] = (u16)(rb.y & 0xffff); bd_[3 * 24] = (u16)(rb.y >> 16); \
      bd_[4 * 24] = (u16)(rb.z & 0xffff); bd_[5 * 24] = (u16)(rb.z >> 16); bd_[6 * 24] = (u16)(rb.w & 0xffff); bd_[7 * 24] = (u16)(rb.w >> 16); } \
    if (tid < 128) { const float sb_ = rdt * __expf(rgl - rg); \
      u16* xb_ = XBs + (bi) * (64 * 24) + ((tid & 7) * 8) * 24 + (tid >> 3); MM_T8(xb_, rx, sb_) \
      if (MODE == 1) { u16* xt_ = XTs + (bi) * (64 * 24) + ((tid & 7) * 8) * 24 + (tid >> 3); MM_T8(xt_, rx, rdt) } } \
    if (tid < 16) { Gs[(bi) * 32 + tid] = rG; if (tid == 15) Gs[(bi) * 32 + 16] = __expf(rG); } }
  __syncthreads();
  MM_ISSUE(ab, ac, ax, adt, ag, agl, aG, 0)
  MM_STASH(ab, ac, ax, adt, ag, agl, aG, 0)
  if (1 < nch) MM_ISSUE(ab, ac, ax, adt, ag, agl, aG, 1)
  if (2 < nch) MM_ISSUE(cb, cc, cx, cdt, cg, cgl, cG, 2)
  for (int c = 0; c < nch; c++) {
    const int bi = c & 1;
    if (MODE == 1) {
#pragma unroll
      for (int nt = 0; nt < 8; nt++)
#pragma unroll
        for (int jj = 0; jj < 4; jj++)
          SsT[(wv * 16 + lq * 4 + jj) * 136 + nt * 16 + l15] = f2bf(acc[nt][jj]);
    }
    __syncthreads();
    if (c + 1 < nch) {
      if (bi == 0) { MM_STASH(ab, ac, ax, adt, ag, agl, aG, 1) if (c + 3 < nch) MM_ISSUE(ab, ac, ax, adt, ag, agl, aG, c + 3) }
      else { MM_STASH(cb, cc, cx, cdt, cg, cgl, cG, 0) if (c + 3 < nch) MM_ISSUE(cb, cc, cx, cdt, cg, cgl, cG, c + 3) }
    }
    const u16* Bc = Bs + bi * (16 * 136);
    const u16* Cc = Cs + bi * (16 * 136);
    const u16* BTc = BTs + bi * (128 * 24);
    const u16* XTc = XTs + bi * (64 * 24);
    const u16* XBc = XBs + bi * (64 * 24);
    const float* Gc = Gs + bi * 32;
    if (MODE == 1) {
      f32x4 at = (f32x4){0.f, 0.f, 0.f, 0.f};
      bf16x8 cf[4];
#pragma unroll
      for (int ks = 0; ks < 4; ks++) {
        bf16x8 bfv = *(const bf16x8*)(Bc + l15 * 136 + ks * 32 + lq * 8);
        cf[ks] = *(const bf16x8*)(Cc + l15 * 136 + ks * 32 + lq * 8);
        at = __builtin_amdgcn_mfma_f32_16x16x32_bf16(bfv, cf[ks], at, 0, 0, 0);
      }
      const float Gt = Gc[l15];
      bf16x4 bat;
#pragma unroll
      for (int jj = 0; jj < 4; jj++) {
        const int sidx = lq * 4 + jj;
        bat[jj] = (short)f2bf(sidx <= l15 ? at[jj] * __expf(Gt - Gc[sidx]) : 0.f);
      }
      bf16x4 xt = *(const bf16x4*)(XTc + (wv * 16 + l15) * 24 + lq * 4);
      f32x4 ao1 = (f32x4){0.f, 0.f, 0.f, 0.f};
      ao1 = __builtin_amdgcn_mfma_f32_16x16x16bf16_1k(xt, bat, ao1, 0, 0, 0);
      f32x4 ao2 = (f32x4){0.f, 0.f, 0.f, 0.f};
#pragma unroll
      for (int ks = 0; ks < 4; ks++) {
        bf16x8 sf = *(const bf16x8*)(SsT + (wv * 16 + l15) * 136 + ks * 32 + lq * 8);
        ao2 = __builtin_amdgcn_mfma_f32_16x16x32_bf16(sf, cf[ks], ao2, 0, 0, 0);
      }
      const float eg = __expf(Gt);
      *(uint2*)(p.hm + (size_t)(m0 + c * 16 + l15) * 1536 + 512 + h * 64 + wv * 16 + lq * 4) =
          make_uint2(pack2(ao1[0] + ao2[0] * eg, ao1[1] + ao2[1] * eg), pack2(ao1[2] + ao2[2] * eg, ao1[3] + ao2[3] * eg));
    }
    {
      const float eGL = Gc[16];
      if (MODE == 0) prodD *= eGL;
      bf16x4 xb = *(const bf16x4*)(XBc + (wv * 16 + l15) * 24 + lq * 4);
#pragma unroll
      for (int nt = 0; nt < 8; nt++) {
        bf16x4 bt = *(const bf16x4*)(BTc + (nt * 16 + l15) * 24 + lq * 4);
        f32x4 cin = (f32x4){acc[nt][0] * eGL, acc[nt][1] * eGL, acc[nt][2] * eGL, acc[nt][3] * eGL};
        acc[nt] = __builtin_amdgcn_mfma_f32_16x16x16bf16_1k(xb, bt, cin, 0, 0, 0);
      }
    }
  }
  if (MODE == 0) {
    const size_t idx = (size_t)((s * 16 + h) * 8 + oc);
    float* sp = MB_SL(p) + idx * 8192 + (size_t)(wv * 16 + lq * 4) * 128 + l15;
#pragma unroll
    for (int nt = 0; nt < 8; nt++) {
      sp[nt * 16] = acc[nt][0]; sp[128 + nt * 16] = acc[nt][1]; sp[256 + nt * 16] = acc[nt][2]; sp[384 + nt * 16] = acc[nt][3];
    }
    if (tid == 0) MB_DD(p)[idx] = prodD;
  } else if (oc == noc - 1) {
    float* sp = out_state(p.out, s, j, O_SSM_P, O_SSM_S, 131072) + (size_t)h * 8192 + (size_t)(wv * 16 + lq * 4) * 128 + l15;
#pragma unroll
    for (int nt = 0; nt < 8; nt++) {
      sp[nt * 16] = acc[nt][0]; sp[128 + nt * 16] = acc[nt][1]; sp[256 + nt * 16] = acc[nt][2]; sp[384 + nt * 16] = acc[nt][3];
    }
  }
  __syncthreads();
}

__device__ void phase_scan_even_a(CP p, int j, char* smem, int bid, int nb) {
  const int nA = 32 * (MB_NOC - 1);
  for (int it = bid; it < 448 + nA + 256; it += nb) {
    int kind, q, oc = 0, noc = RK_NOC;
    if (it < 256) { kind = 0; q = it >> 2; oc = it & 3; }
    else if (it < 448) { kind = 1; q = (it - 256) / 3; oc = 1 + (it - 256) % 3; }
    else if (it < 448 + nA) { kind = 2; q = (it - 448) / (MB_NOC - 1); oc = (it - 448) % (MB_NOC - 1); }
    else { kind = 0; q = 64 + (it - 448 - nA); noc = 1; }
    if (kind == 2) mamba_scan_item<0>(p, j, q >> 4, q & 15, oc, MB_NOC, smem);
    else {
      const int s = q < 64 ? (q >> 5) : 2 + ((q - 64) >> 5);
      if (kind == 0) rwkv_scan_item<0>(p, j, s, (q >> 2) & 7, q & 3, oc, noc, smem);
      else rwkv_scan_item<1>(p, j, s, (q >> 2) & 7, q & 3, oc, noc, smem);
    }
  }
}
__device__ void phase_scan_even(CP p, int j, char* smem, int bid, int nb) {
  for (int it = bid; it < 16 + 32 * MB_NOC + 128; it += nb) {
    if (it < 16) { rwkv_combine_item(p, j, it >> 3, it & 7, smem); continue; }
    const int i2 = it - 16;
    int q, s, oc, noc;
    if (i2 < 32 * MB_NOC) { q = i2 / MB_NOC; oc = i2 % MB_NOC; noc = MB_NOC; s = q >> 4; }
    else { q = i2 - 32 * MB_NOC; oc = 0; noc = 1; s = 2 + (q >> 4); }
    mamba_scan_item<1>(p, j, s, q & 15, oc, noc, smem);
  }
}

__device__ void phase_post_even(CP p, int j, char* smem, int bid, int nb) {
  const int tid = otid(), lane = tid & 63, wv = tid >> 6;
  const u16* P = p.pbuf;
  {
    u16* sgb = (u16*)smem;
    float* ul = (float*)(sgb + 16 * 136) ;
    float* resg = ul + 8 * 512;
    for (int i = tid; i < 16 * 136; i += 256) sgb[i] = 0;
    const int half = tid >> 7, hk = tid & 127, h = hk >> 4, kq = hk & 15;
    const int c4 = h * 64 + kq * 4;
    const float* mu = p.mu_a + j * 1792;
    for (int u = bid; u < NT / 8; u += nb) {
      const int m0 = u * 8;
      const int s = row_seq(m0);
      const int r0 = seq_row0(s);
      __syncthreads();
#pragma unroll
      for (int i = 0; i < 4; i++) {
        int idx = tid + 256 * i;
        int tok = idx >> 7, cc = idx & 127;
        int m = m0 + tok;
        int col = 1664 + cc;
        float pc = bf2f(P[(size_t)m * PSTR + col]);
        float pp = (m > r0) ? bf2f(P[(size_t)(m - 1) * PSTR + col])
                            : (s >= 2 ? p.st_shift[((size_t)(s - 2) * 2 + j) * 1792 + col] : 0.f);
        float pm = pc + (pp - pc) * mu[col];
        sgb[tok * 136 + cc] = f2bf(sigm(pm));
      }
      const int ocu = (s < 2) ? ((m0 - r0) >> 11) : 0;
      if (ocu > 0) {
#pragma unroll
        for (int i = 0; i < 2; i++) {
          int idx = tid + 256 * i;
          uint4 uv = *(const uint4*)(p.ub + (size_t)m0 * 512 + idx * 8);
          cvt8_store(ul + idx * 8, uv);
        }
      }
      __syncthreads();
      float corr[4][4];
#pragma unroll
      for (int a = 0; a < 4; a++)
#pragma unroll
        for (int b = 0; b < 4; b++) corr[a][b] = 0.f;
      if (ocu > 0) {
        const float* sip = RK_SI(p) + (size_t)((s * 8 + h) * 4 + ocu) * 4096 + (size_t)(kq * 4) * 64;
#pragma unroll 2
        for (int i = 0; i < 64; i += 4) {
          float4 u4[4];
#pragma unroll
          for (int tk = 0; tk < 4; tk++) u4[tk] = *(const float4*)(ul + (half * 4 + tk) * 512 + h * 64 + i);
#pragma unroll
          for (int rr = 0; rr < 4; rr++) {
            float4 s4 = *(const float4*)(sip + rr * 64 + i);
#pragma unroll
            for (int tk = 0; tk < 4; tk++)
              corr[tk][rr] += s4.x * u4[tk].x + s4.y * u4[tk].y + s4.z * u4[tk].z + s4.w * u4[tk].w;
          }
        }
      }
      {
        const int lane = tid & 63, wv = tid >> 6, l15 = lane & 15, lq = lane >> 4;
        bf16x8 ag[4];
#pragma unroll
        for (int ks = 0; ks < 4; ks++) ag[ks] = *(const bf16x8*)(sgb + l15 * 136 + ks * 32 + lq * 8);
#pragma unroll
        for (int nt = 0; nt < 8; nt++) {
          const int n = wv * 128 + nt * 16 + l15;
          f32x4 cgv = (f32x4){0.f, 0.f, 0.f, 0.f};
#pragma unroll
          for (int ks = 0; ks < 4; ks++) {
            bf16x8 bg = *(const bf16x8*)(p.g2t + (size_t)n * 128 + ks * 32 + lq * 8);
            cgv = __builtin_amdgcn_mfma_f32_16x16x32_bf16(ag[ks], bg, cgv, 0, 0, 0);
          }
          if (lq < 2) {
#pragma unroll
            for (int jj = 0; jj < 4; jj++) resg[(lq * 4 + jj) * 512 + n] = cgv[jj];
          }
        }
      }
      __syncthreads();
      float accg[4][4];
#pragma unroll
      for (int tk = 0; tk < 4; tk++) {
        float4 rg4 = *(const float4*)(resg + (half * 4 + tk) * 512 + c4);
        accg[tk][0] = rg4.x; accg[tk][1] = rg4.y; accg[tk][2] = rg4.z; accg[tk][3] = rg4.w;
      }
      float4 lw = *(const float4*)(p.lnx_w + j * 512 + c4);
      float4 lb = *(const float4*)(p.lnx_b + j * 512 + c4);
      const float lwa[4] = {lw.x, lw.y, lw.z, lw.w};
      const float lba[4] = {lb.x, lb.y, lb.z, lb.w};
#pragma unroll
      for (int tk = 0; tk < 4; tk++) {
        const int m = m0 + half * 4 + tk;
        u16* op = p.hm + (size_t)m * 1536 + c4;
        uint2 oraw = *(const uint2*)op;
        float o[4] = {lo16(oraw.x) + corr[tk][0], hi16(oraw.x) + corr[tk][1], lo16(oraw.y) + corr[tk][2], hi16(oraw.y) + corr[tk][3]};
        float sm = red16(o[0] + o[1] + o[2] + o[3]);
        float mean = sm * (1.f / 64.f);
        float d0 = o[0] - mean, d1 = o[1] - mean, d2 = o[2] - mean, d3 = o[3] - mean;
        float var = red16(d0 * d0 + d1 * d1 + d2 * d2 + d3 * d3) * (1.f / 64.f);
        float rs = rsqrtf(var + 64e-5f);
        float bon = p.bonus[(size_t)m * 8 + h];
        uint4 sl2 = *(const uint4*)(p.rw + (((size_t)m * 8 + h) * 16 + kq) * 24 + 16);
        float v[4] = {lo16(sl2.z), hi16(sl2.z), lo16(sl2.w), hi16(sl2.w)};
        float dd[4] = {d0, d1, d2, d3};
        float res[4];
#pragma unroll
        for (int e = 0; e < 4; e++) res[e] = (dd[e] * rs * lwa[e] + lba[e] + bon * v[e]) * accg[tk][e];
        *(uint2*)op = make_uint2(pack2(res[0], res[1]), pack2(res[2], res[3]));
      }
    }
  }
  for (int w = bid * 4 + wv; w < NT * 2; w += nb * 4) {
    int m = w >> 1, g = w & 1;
    u16* yp = p.hm + (size_t)m * 1536 + 512 + g * 512 + lane * 8;
    uint4 yr = *(const uint4*)yp;
    uint4 zr = *(const uint4*)(P + (size_t)m * PSTR + 1792 + g * 512 + lane * 8);
    float y[8] = {lo16(yr.x), hi16(yr.x), lo16(yr.y), hi16(yr.y), lo16(yr.z), hi16(yr.z), lo16(yr.w), hi16(yr.w)};
    float z[8] = {lo16(zr.x), hi16(zr.x), lo16(zr.y), hi16(zr.y), lo16(zr.z), hi16(zr.z), lo16(zr.w), hi16(zr.w)};
    uint4 xr = *(const uint4*)(p.cv + (size_t)m * 1536 + g * 512 + lane * 8);
    float x[8] = {lo16(xr.x), hi16(xr.x), lo16(xr.y), hi16(xr.y), lo16(xr.z), hi16(xr.z), lo16(xr.w), hi16(xr.w)};
    const float dsk = p.d_skip[j * 16 + g * 8 + (lane >> 3)];
    float ss = 0.f;
#pragma unroll
    for (int e = 0; e < 8; e++) { y[e] = (y[e] + dsk * x[e]) * silu_(z[e]); ss += y[e] * y[e]; }
    ss = wave_sum(ss);
    float rs = rsqrtf(ss * (1.f / 512.f) + 1e-5f);
    const float* nw = p.norm_b_w + j * 1024 + g * 512 + lane * 8;
    float4 n0 = *(const float4*)nw, n1 = *(const float4*)(nw + 4);
    *(uint4*)yp = make_uint4(pack2(y[0] * rs * n0.x, y[1] * rs * n0.y), pack2(y[2] * rs * n0.z, y[3] * rs * n0.w),
                             pack2(y[4] * rs * n1.x, y[5] * rs * n1.y), pack2(y[6] * rs * n1.z, y[7] * rs * n1.w));
  }
}

#define QK_OFF ((size_t)1032 * 1024 * 16)
__device__ void phase_prep_odd(CP p, int j, int bid, int nb) {
  const int tid = otid();
  const u16* P = p.pbuf;
  u16* KT = p.rw;
  u16* QK = p.rw + QK_OFF;
  float* DL = (float*)p.cv;
  for (int u = bid; u < (NT / 16) * 2; u += nb) {
    const int ci = u >> 1, k = ((u & 1) * 256 + tid) * 2;
    float lb0 = 0.f, lb1 = 0.f;
    if (j == 1) { lb0 = sigm(p.lb_param[1024 + k] - p.lb_param[k]); lb1 = sigm(p.lb_param[1025 + k] - p.lb_param[k + 1]); }
    const u16* base = P + (size_t)ci * 16 * PSTR + k;
    unsigned qr[16], fr[16];
#pragma unroll
    for (int t = 0; t < 16; t++) { qr[t] = *(const unsigned*)(base + (size_t)t * PSTR); fr[t] = *(const unsigned*)(base + (size_t)t * PSTR + 1024); }
    float G0 = 0.f, G1 = 0.f;
    unsigned kt0[8], kt1[8];
#pragma unroll
    for (int t = 0; t < 16; t++) {
      float q0 = lo16(qr[t]), q1 = hi16(qr[t]), f0 = lo16(fr[t]), f1 = hi16(fr[t]);
      float s0 = sigm(f0), s1 = sigm(f1);
      float ff0 = lb0 + (1.f - lb0) * s0, ff1 = lb1 + (1.f - lb1) * s1;
      float kk0 = (1.f - lb0) * (1.f - s0), kk1 = (1.f - lb1) * (1.f - s1);
      G0 += __logf(fmaxf(ff0, 1e-30f)); G1 += __logf(fmaxf(ff1, 1e-30f));
      float Q0 = silu_(q0) * __expf(G0), Q1 = silu_(q1) * __expf(G1);
      float K0 = kk0 * __expf(fminf(-G0, 80.f)), K1 = kk1 * __expf(fminf(-G1, 80.f));
      unsigned kb0 = f2bf(K0), kb1 = f2bf(K1);
      u16* qd = QK + (size_t)(ci * 16 + t) * 2048 + k;
      *(unsigned*)qd = pack2(Q0, Q1);
      *(unsigned*)(qd + 1024) = kb0 | (kb1 << 16);
      if (t & 1) { kt0[t >> 1] |= kb0 << 16; kt1[t >> 1] |= kb1 << 16; } else { kt0[t >> 1] = kb0; kt1[t >> 1] = kb1; }
    }
    *(float2*)(DL + (size_t)ci * 1024 + k) = make_float2(__expf(G0), __expf(G1));
    uint4* kd = (uint4*)(KT + ((size_t)ci * 1024 + k) * 16);
    kd[0] = make_uint4(kt0[0], kt0[1], kt0[2], kt0[3]);
    kd[1] = make_uint4(kt0[4], kt0[5], kt0[6], kt0[7]);
    kd[2] = make_uint4(kt1[0], kt1[1], kt1[2], kt1[3]);
    kd[3] = make_uint4(kt1[4], kt1[5], kt1[6], kt1[7]);
  }
}

#define HG_SL(p) ((float*)(p).cv + 2 * 1024 * 1024)
#define HG_DD(p) (HG_SL(p) + 2 * 8 * 8 * 16384)
template <int MODE>
__device__ __forceinline__ void hgrn_scan_item(CP p, int j, int s, int h, int vq, int oc, int noc, char* smem) {
  u16* Qs = (u16*)smem;
  u16* Ks = Qs + 2 * 16 * 136;
  u16* KTs = Ks + 2 * 16 * 136;
  u16* VTs = KTs + 2 * 128 * 24;
  u16* SsT = VTs + 2 * 32 * 24;
  float* dLs = (float*)(SsT + 2 * 32 * 136);
  const int tid = otid(), lane = tid & 63, wv = tid >> 6;
  const int l15 = lane & 15, lq = lane >> 4;
  const int T = seq_len(s);
  const int nch = (T >> 4) / noc;
  const int m0 = seq_row0(s) + oc * nch * 16;
  const int ci0 = m0 >> 4;
  f32x4 acc[2][2];
#pragma unroll
  for (int vt = 0; vt < 2; vt++)
#pragma unroll
    for (int kl = 0; kl < 2; kl++) acc[vt][kl] = (f32x4){0.f, 0.f, 0.f, 0.f};
  float prodD[2] = {1.f, 1.f};
  if (MODE == 1) {
    if (s >= 2) {
      const float* sp = p.st_hgrn + (((size_t)(s - 2) * 2 + j) * 8 + h) * 16384;
#pragma unroll
      for (int vt = 0; vt < 2; vt++)
#pragma unroll
        for (int kl = 0; kl < 2; kl++) {
          float4 q = *(const float4*)(sp + (size_t)((2 * wv + kl) * 16 + l15) * 128 + vq * 32 + vt * 16 + lq * 4);
          acc[vt][kl] = (f32x4){q.x, q.y, q.z, q.w};
        }
    } else {
      for (int cp = 0; cp < oc; cp++) {
        const size_t idx = (size_t)((s * 8 + h) * 8 + cp);
#pragma unroll
        for (int kl = 0; kl < 2; kl++) {
          const int k = (2 * wv + kl) * 16 + l15;
          const float dd = HG_DD(p)[idx * 128 + k];
#pragma unroll
          for (int vt = 0; vt < 2; vt++) {
            float4 L4 = *(const float4*)(HG_SL(p) + idx * 16384 + (size_t)k * 128 + vq * 32 + vt * 16 + lq * 4);
            acc[vt][kl] = (f32x4){acc[vt][kl][0] * dd + L4.x, acc[vt][kl][1] * dd + L4.y, acc[vt][kl][2] * dd + L4.z,
                                  acc[vt][kl][3] * dd + L4.w};
          }
        }
      }
    }
  }
  const u16* Pq = p.rw + QK_OFF + (size_t)(m0 + (tid >> 4)) * 2048 + h * 128 + (tid & 15) * 8;
  const u16* Pv = p.pbuf + (size_t)(m0 + ((tid >> 2) & 15)) * PSTR + 2048 + h * 128 + vq * 32 + (tid & 3) * 8;
  const u16* Pkt = p.rw + ((size_t)ci0 * 1024 + h * 128 + (tid >> 1)) * 16 + (tid & 1) * 8;
  const float* Pdl = (const float*)p.cv + (size_t)ci0 * 1024 + h * 128 + (tid & 31) * 4;
  uint4 aq, ak, akt, av, cq, ck, ckt, cvv;
  float4 ad, cd;
  aq = make_uint4(0, 0, 0, 0); ak = aq; cq = aq; ck = aq;
  av = make_uint4(0, 0, 0, 0); cvv = av; ad = make_float4(0, 0, 0, 0); cd = ad;
#define HM_ISSUE(rq, rk, rkt, rv, rd, c) { \
    if (MODE == 1) { rq = *(const uint4*)(Pq + (size_t)(c) * 16 * 2048); rk = *(const uint4*)(Pq + (size_t)(c) * 16 * 2048 + 1024); } \
    rkt = *(const uint4*)(Pkt + (size_t)(c) * 1024 * 16); \
    if (tid < 64) rv = *(const uint4*)(Pv + (size_t)(c) * 16 * PSTR); \
    if (tid < 32) rd = *(const float4*)(Pdl + (size_t)(c) * 1024); }
#define HM_STASH(rq, rk, rkt, rv, rd, bi) { \
    if (MODE == 1) { *(uint4*)(Qs + (bi) * (16 * 136) + (tid >> 4) * 136 + (tid & 15) * 8) = rq; \
    *(uint4*)(Ks + (bi) * (16 * 136) + (tid >> 4) * 136 + (tid & 15) * 8) = rk; } \
    *(uint4*)(KTs + (bi) * (128 * 24) + (tid >> 1) * 24 + (tid & 1) * 8) = rkt; \
    if (tid < 64) { u16* vd_ = VTs + (bi) * (32 * 24) + ((tid & 3) * 8) * 24 + (tid >> 2); \
      vd_[0 * 24] = (u16)(rv.x & 0xffff); vd_[1 * 24] = (u16)(rv.x >> 16); vd_[2 * 24] = (u16)(rv.y & 0xffff); vd_[3 * 24] = (u16)(rv.y >> 16); \
      vd_[4 * 24] = (u16)(rv.z & 0xffff); vd_[5 * 24] = (u16)(rv.z >> 16); vd_[6 * 24] = (u16)(rv.w & 0xffff); vd_[7 * 24] = (u16)(rv.w >> 16); } \
    if (tid < 32) *(float4*)(dLs + (bi) * 128 + tid * 4) = rd; }
  __syncthreads();
  HM_ISSUE(aq, ak, akt, av, ad, 0)
  HM_STASH(aq, ak, akt, av, ad, 0)
  if (1 < nch) HM_ISSUE(aq, ak, akt, av, ad, 1)
  if (2 < nch) HM_ISSUE(cq, ck, ckt, cvv, cd, 2)
  for (int c = 0; c < nch; c++) {
    const int bi = c & 1;
    if (MODE == 1) {
      u16* sd = SsT + bi * (32 * 136);
#pragma unroll
      for (int vt = 0; vt < 2; vt++)
#pragma unroll
        for (int kl = 0; kl < 2; kl++)
#pragma unroll
          for (int jj = 0; jj < 4; jj++)
            sd[(vt * 16 + lq * 4 + jj) * 136 + (2 * wv + kl) * 16 + l15] = f2bf(acc[vt][kl][jj]);
    }
    __syncthreads();
    if (c + 1 < nch) {
      if (bi == 0) { HM_STASH(aq, ak, akt, av, ad, 1) if (c + 3 < nch) HM_ISSUE(aq, ak, akt, av, ad, c + 3) }
      else { HM_STASH(cq, ck, ckt, cvv, cd, 0) if (c + 3 < nch) HM_ISSUE(cq, ck, ckt, cvv, cd, c + 3) }
    }
    const u16* Qc = Qs + bi * (16 * 136);
    const u16* Kc = Ks + bi * (16 * 136);
    const u16* KTc = KTs + bi * (128 * 24);
    const u16* VTc = VTs + bi * (32 * 24);
    const u16* Sc = SsT + bi * (32 * 136);
    if (MODE == 1 && wv < 2) {
      const int vt = wv;
      f32x4 at = (f32x4){0.f, 0.f, 0.f, 0.f};
      bf16x8 qf[4];
#pragma unroll
      for (int ks = 0; ks < 4; ks++) {
        bf16x8 kf = *(const bf16x8*)(Kc + l15 * 136 + ks * 32 + lq * 8);
        qf[ks] = *(const bf16x8*)(Qc + l15 * 136 + ks * 32 + lq * 8);
        at = __builtin_amdgcn_mfma_f32_16x16x32_bf16(kf, qf[ks], at, 0, 0, 0);
      }
      bf16x4 bat;
#pragma unroll
      for (int jj = 0; jj < 4; jj++) bat[jj] = (short)f2bf((lq * 4 + jj) <= l15 ? at[jj] : 0.f);
      bf16x4 vf = *(const bf16x4*)(VTc + (vt * 16 + l15) * 24 + lq * 4);
      f32x4 ao1 = (f32x4){0.f, 0.f, 0.f, 0.f};
      ao1 = __builtin_amdgcn_mfma_f32_16x16x16bf16_1k(vf, bat, ao1, 0, 0, 0);
      f32x4 ao2 = (f32x4){0.f, 0.f, 0.f, 0.f};
#pragma unroll
      for (int ks = 0; ks < 4; ks++) {
        bf16x8 sf = *(const bf16x8*)(Sc + (vt * 16 + l15) * 136 + ks * 32 + lq * 8);
        ao2 = __builtin_amdgcn_mfma_f32_16x16x32_bf16(sf, qf[ks], ao2, 0, 0, 0);
      }
      f32x4 ao = (f32x4){ao1[0] + ao2[0], ao1[1] + ao2[1], ao1[2] + ao2[2], ao1[3] + ao2[3]};
      *(uint2*)(p.hm + (size_t)(m0 + c * 16 + l15) * 1024 + h * 128 + vq * 32 + vt * 16 + lq * 4) =
          make_uint2(pack2(ao[0], ao[1]), pack2(ao[2], ao[3]));
    }
#pragma unroll
    for (int kl = 0; kl < 2; kl++) {
      const int kt = 2 * wv + kl;
      bf16x4 kb = *(const bf16x4*)(KTc + (kt * 16 + l15) * 24 + lq * 4);
      float dl = dLs[bi * 128 + kt * 16 + l15];
      if (MODE == 0) prodD[kl] *= dl;
#pragma unroll
      for (int vt = 0; vt < 2; vt++) {
        bf16x4 vf = *(const bf16x4*)(VTc + (vt * 16 + l15) * 24 + lq * 4);
        f32x4 a = __builtin_amdgcn_mfma_f32_16x16x16bf16_1k(vf, kb, acc[vt][kl], 0, 0, 0);
        acc[vt][kl] = (f32x4){a[0] * dl, a[1] * dl, a[2] * dl, a[3] * dl};
      }
    }
  }
  if (MODE == 0) {
    const size_t idx = (size_t)((s * 8 + h) * 8 + oc);
#pragma unroll
    for (int kl = 0; kl < 2; kl++) {
      const int k = (2 * wv + kl) * 16 + l15;
      if (vq == 0 && lq == 0) HG_DD(p)[idx * 128 + k] = prodD[kl];
#pragma unroll
      for (int vt = 0; vt < 2; vt++)
        *(float4*)(HG_SL(p) + idx * 16384 + (size_t)k * 128 + vq * 32 + vt * 16 + lq * 4) =
            make_float4(acc[vt][kl][0], acc[vt][kl][1], acc[vt][kl][2], acc[vt][kl][3]);
    }
  } else if (oc == noc - 1) {
    float* o = out_state(p.out, s, j, O_HGRN_P, O_HGRN_S, 131072) + (size_t)h * 16384;
#pragma unroll
    for (int vt = 0; vt < 2; vt++)
#pragma unroll
      for (int kl = 0; kl < 2; kl++)
        *(float4*)(o + (size_t)((2 * wv + kl) * 16 + l15) * 128 + vq * 32 + vt * 16 + lq * 4) =
            make_float4(acc[vt][kl][0], acc[vt][kl][1], acc[vt][kl][2], acc[vt][kl][3]);
  }
  __syncthreads();
}

#define HG_NOC 8
__device__ void phase_scan_odd_a(CP p, int j, char* smem, int bid, int nb) {
  for (int it = bid; it < 64 * (HG_NOC - 1); it += nb) {
    int q = it / (HG_NOC - 1), oc = it % (HG_NOC - 1);
    hgrn_scan_item<0>(p, j, q >> 5, (q >> 2) & 7, q & 3, oc, HG_NOC, smem);
  }
}
__device__ void phase_scan_odd(CP p, int j, char* smem, int bid, int nb) {
  for (int it = bid; it < 64 * HG_NOC + 256; it += nb) {
    int q, s, oc, noc;
    if (it < 64 * HG_NOC) { q = it / HG_NOC; oc = it % HG_NOC; noc = HG_NOC; s = q >> 5; }
    else { q = it - 64 * HG_NOC; oc = 0; noc = 1; s = 2 + (q >> 5); }
    hgrn_scan_item<1>(p, j, s, (q >> 2) & 7, q & 3, oc, noc, smem);
  }
}

__device__ void phase_post_odd(CP p, int j, int bid, int nb) {
  const int tid = otid(), lane = tid & 63, wv = tid >> 6;
  const u16* P = p.pbuf;
  for (int m = bid * 4 + wv; m < NT; m += nb * 4) {
    u16* op = p.hm + (size_t)m * 1024 + lane * 16;
    uint4 a = *(const uint4*)op, b = *(const uint4*)(op + 8);
    const u16* gp = P + (size_t)m * PSTR + 3072 + lane * 16;
    uint4 ga = *(const uint4*)gp, gb = *(const uint4*)(gp + 8);
    float o[16] = {lo16(a.x), hi16(a.x), lo16(a.y), hi16(a.y), lo16(a.z), hi16(a.z), lo16(a.w), hi16(a.w),
                   lo16(b.x), hi16(b.x), lo16(b.y), hi16(b.y), lo16(b.z), hi16(b.z), lo16(b.w), hi16(b.w)};
    float g[16] = {lo16(ga.x), hi16(ga.x), lo16(ga.y), hi16(ga.y), lo16(ga.z), hi16(ga.z), lo16(ga.w), hi16(ga.w),
                   lo16(gb.x), hi16(gb.x), lo16(gb.y), hi16(gb.y), lo16(gb.z), hi16(gb.z), lo16(gb.w), hi16(gb.w)};
    float ss = 0.f;
#pragma unroll
    for (int e = 0; e < 16; e++) ss += o[e] * o[e];
    ss += dpp_f<0xB1>(ss);
    ss += dpp_f<0x4E>(ss);
    ss += dpp_f<0x141>(ss);
    float rs = rsqrtf(ss * (1.f / 128.f) + 1e-5f);
    const float* nw = p.norm_c_w + j * 1024 + lane * 16;
    float r[16];
#pragma unroll
    for (int e = 0; e < 16; e++) r[e] = o[e] * rs * nw[e] * silu_(g[e]);
    *(uint4*)op = make_uint4(pack2(r[0], r[1]), pack2(r[2], r[3]), pack2(r[4], r[5]), pack2(r[6], r[7]));
    *(uint4*)(op + 8) = make_uint4(pack2(r[8], r[9]), pack2(r[10], r[11]), pack2(r[12], r[13]), pack2(r[14], r[15]));
  }
}


#define XB_TMO      128
#define XB_XCNT(j)  (256  + 64 * (j))
#define XB_XSUB(j)  (1280 + 64 * (j))
#define XB_XGEN(j)  (2304 + 64 * (j))
#define XB_TOP      3328
#define XB_TOPGEN   3392
#define XCD_BAR_WORDS 3456
#define XB_SPIN_CAP (1u << 22)
#define LAS __attribute__((address_space(3)))
__device__ __forceinline__ unsigned xb_ld(unsigned* p) { return __hip_atomic_load(p, __ATOMIC_RELAXED, __HIP_MEMORY_SCOPE_AGENT); }
__device__ __forceinline__ unsigned xb_add(unsigned* p, unsigned v) { return __hip_atomic_fetch_add(p, v, __ATOMIC_RELAXED, __HIP_MEMORY_SCOPE_AGENT); }
__device__ __forceinline__ unsigned xb_xcc_id() { return (unsigned)__builtin_amdgcn_s_getreg((3 << 11) | 20) & 0xFu; }
#define XB_SPIN(cond, bar) do { unsigned _sp = 0; while (cond) { __builtin_amdgcn_s_sleep(1); \
    if ((++_sp & 255u) == 0u) { if (xb_ld(&(bar)[XB_TMO])) break; if (_sp > XB_SPIN_CAP) { atomicAdd(&(bar)[XB_TMO], 1u); break; } } } } while (0)
struct XcdBarrier { unsigned* bar; unsigned x; volatile LAS unsigned* st; };
__device__ __forceinline__ XcdBarrier xcd_barrier_post(unsigned* bar, volatile LAS unsigned* st) {
  XcdBarrier b; b.bar = bar; b.x = xb_xcc_id(); b.st = st;
  if (threadIdx.x == 0) (void)xb_add(&bar[XB_XCNT(b.x)], 1u);
  return b;
}
__device__ __forceinline__ void xcd_barrier_complete(unsigned* bar, unsigned x, unsigned& nloc, unsigned& nx) {
  const unsigned G = gridDim.x * gridDim.y * gridDim.z;
  unsigned sum, cnt, mine, sp = 0u;
  for (;;) {
    sum = 0u; cnt = 0u; mine = 0u;
#pragma unroll
    for (unsigned j = 0; j < 16; ++j) { const unsigned c = xb_ld(&bar[XB_XCNT(j)]); sum += c; cnt += (c > 0u) ? 1u : 0u; mine = (j == x) ? c : mine; }
    if (sum == G) break;
    __builtin_amdgcn_s_sleep(1);
    if ((++sp & 255u) == 0u) { if (xb_ld(&bar[XB_TMO])) break; if (sp > XB_SPIN_CAP) { atomicAdd(&bar[XB_TMO], 1u); break; } }
  }
  nloc = mine > 0u ? mine : 1u; nx = cnt > 0u ? cnt : 1u;
}
__device__ __forceinline__ void xcd_barrier(const XcdBarrier& b) {
  asm volatile("s_waitcnt vmcnt(0)" ::: "memory");
  __syncthreads();
  if (threadIdx.x == 0) {
    unsigned* bar = b.bar;
    __builtin_amdgcn_s_waitcnt(0);
    unsigned nloc = b.st[0], nx = b.st[1];
    if (nloc == 0u) { xcd_barrier_complete(bar, b.x, nloc, nx); b.st[0] = nloc; b.st[1] = nx; }
    const unsigned old = xb_add(&bar[XB_XSUB(b.x)], 1u);
    const unsigned gen = old / nloc;
    if (old + 1u == (gen + 1u) * nloc) {
      __builtin_amdgcn_fence(__ATOMIC_RELEASE, "agent");
      asm volatile("s_waitcnt vmcnt(0)" ::: "memory");
      const unsigned og = xb_add(&bar[XB_TOP], 1u);
      const unsigned tg = og / nx;
      if (og + 1u == (tg + 1u) * nx) xb_add(&bar[XB_TOPGEN], 1u);
      else XB_SPIN(xb_ld(&bar[XB_TOPGEN]) == tg, bar);
      __builtin_amdgcn_fence(__ATOMIC_ACQUIRE, "agent");
      xb_add(&bar[XB_XGEN(b.x)], 1u);
      asm volatile("s_waitcnt vmcnt(0)" ::: "memory");
    } else {
      XB_SPIN(xb_ld(&bar[XB_XGEN(b.x)]) == gen, bar);
      __builtin_amdgcn_fence(__ATOMIC_ACQUIRE, "agent");
      asm volatile("s_waitcnt vmcnt(0)" ::: "memory");
    }
  }
  __syncthreads();
}

#define NPHASE 42
__global__ void __launch_bounds__(256, 2) mega(Params kp) {
  __shared__ __attribute__((aligned(16))) char smem[65536];
  cg::grid_group grid = cg::this_grid();
  const int ph0 = kp.p0, ph1 = kp.p1;
  volatile LAS unsigned* xst = (volatile LAS unsigned*)(smem + 65520);
  if (threadIdx.x == 0) { xst[0] = 0u; xst[1] = 0u; }
  __syncthreads();
  XcdBarrier xb = xcd_barrier_post(kp.bar, xst);
  if (ph1 > 1000) grid.sync();
  const bool multi = (ph1 - ph0) > 1;
  for (int ph = ph0; ph < ph1; ph++) {
    CP p = *getp();
    int bid = blockIdx.x, nb = gridDim.x;
    asm volatile("" : "+s"(bid), "+s"(nb));
    if (ph == 0) {
      phase_mod(p, smem, bid, nb);
    } else if (ph == NPHASE - 1) {
      phase_final(p, bid, nb);
    } else {
      const int L = (ph - 1) / 10, sp = (ph - 1) % 10;
      const int j = L >> 1;
      const bool even = (L & 1) == 0;
      int reps = 1;
#ifdef PROBE_SCAN
      if (sp == 4 && !even) reps = 2;
#endif
#ifdef PROBE_GEMM
      if (sp == 1 || sp == 8) reps = 2;
#endif
#ifdef PROBE_MISC
      if (sp == 0 || sp == 7 || sp == 2) reps = 2;
#endif
      for (int rep = 0; rep < reps; rep++) {
      bool do_gemm = false;
      const u16 *A = nullptr, *Bt = nullptr;
      u16* outb = nullptr;
      const float* gate = nullptr;
      int lda = 0, K = 0, ntn = 0, epi = 0, ldo = 0, ncols = 0;
      switch (sp) {
        case 0:
          phase_wconv(p, L, smem, bid, nb);
          phase_norm(p, L, 0, bid, nb);
          break;
        case 1:
          do_gemm = true; A = p.hm; lda = 1024; Bt = p.wb_in; K = 1024; ntn = even ? 18 : 16; epi = 0;
          outb = p.pbuf; ldo = PSTR; ncols = even ? PSTR : 4096;
          break;
        case 2:
          if (even) phase_prep_even(p, j, smem, bid, nb); else phase_prep_odd(p, j, bid, nb);
          break;
        case 3:
          if (even) phase_scan_even_a(p, j, smem, bid, nb); else phase_scan_odd_a(p, j, smem, bid, nb);
          break;
        case 4:
          if (even) phase_scan_even(p, j, smem, bid, nb); else phase_scan_odd(p, j, smem, bid, nb);
          break;
        case 5:
          if (even) phase_post_even(p, j, smem, bid, nb); else phase_post_odd(p, j, bid, nb);
          break;
        case 6:
          do_gemm = true; A = p.hm; lda = even ? 1536 : 1024; Bt = p.wb_out; K = lda; ntn = 4; epi = 2;
          gate = p.mod + (size_t)L * 10 * 6144 + 2048;
          break;
        case 7:
          phase_norm(p, L, 1, bid, nb);
          break;
        case 8:
          do_gemm = true; A = p.hm; lda = 1024; Bt = p.wb_gu; K = 1024; ntn = 22; epi = 1;
          outb = p.pbuf; ldo = 2816; ncols = 2816;
          break;
        default:
          do_gemm = true; A = p.pbuf; lda = 2816; Bt = p.wb_dn; K = 2816; ntn = 4; epi = 2;
          gate = p.mod + (size_t)L * 10 * 6144 + 5120;
          break;
      }
      if (do_gemm) gemm_phase(p, A, lda, Bt, K, ntn, epi, outb, ldo, ncols, gate, smem, bid, nb);
      }
    }
    if (multi && ph + 1 < ph1) xcd_barrier(xb);
  }
}

extern "C" void kernel_launch(void* const* d_in, const int* in_sizes, int n_in, void* d_out, int out_size, void* d_ws,
                              size_t ws_size, hipStream_t stream) {
  static int grid_blocks = 0;
  if (!grid_blocks) {
    int dev = 0, cus = 0, per_cu = 0;
    hipGetDevice(&dev);
    hipDeviceGetAttribute(&cus, hipDeviceAttributeMultiprocessorCount, dev);
    hipOccupancyMaxActiveBlocksPerMultiprocessor(&per_cu, mega, 256, 0);
    if (per_cu > 2) per_cu = 2;
    if (per_cu < 1) per_cu = 1;
    grid_blocks = cus * per_cu;
  }
  Params p{};
  const float* const* in = (const float* const*)d_in;
  p.x_prompt = in[0]; p.x_sample = in[1]; p.st_rwkv = in[2]; p.st_shift = in[3]; p.st_ssm = in[4]; p.st_conv = in[5];
  p.st_hgrn = in[6]; p.c_prompt = in[7]; p.c_sample = in[8]; p.norm_mix_w = in[9]; p.norm_ffn_w = in[10];
  p.norm_out_w = in[11]; p.ada_w = in[12]; p.ada_b = in[13]; p.w_in_ab = in[14]; p.w_out_ab = in[15]; p.mu_a = in[16];
  p.w0 = in[17]; p.w2 = in[18]; p.a0 = in[19]; p.a2 = in[20]; p.g2 = in[21]; p.k_k = in[22]; p.k_a = in[23];
  p.r_k = in[24]; p.lnx_w = in[25]; p.lnx_b = in[26]; p.conv_w = in[27]; p.conv_b = in[28]; p.dt_bias = in[29];
  p.a_log = in[30]; p.d_skip = in[31]; p.norm_b_w = in[32]; p.w_in_c = in[33]; p.w_out_c = in[34]; p.lb_param = in[35];
  p.norm_c_w = in[36]; p.w_gate = in[37]; p.w_up = in[38]; p.w_down = in[39];
  p.out = (float*)d_out;
  char* ws = (char*)d_ws;
  size_t off = 0;
  auto take = [&](size_t bytes) { char* r = ws + off; off += (bytes + 255) & ~(size_t)255; return r; };
  p.bar = (unsigned*)take(16384);
  p.mod = (float*)take((size_t)4 * 10 * 6144 * 4);
  p.bonus = (float*)take((size_t)NT * 8 * 4);
  p.dtb = (float*)take((size_t)NT * 32 * 4);
  p.wb_in = (u16*)take((size_t)4480 * 1024 * 2);
  p.wb_out = (u16*)take((size_t)1024 * 1536 * 2);
  p.wb_gu = (u16*)take((size_t)5632 * 1024 * 2);
  p.wb_dn = (u16*)take((size_t)1024 * 2816 * 2);
  p.hm = (u16*)take((size_t)NT * 1536 * 2);
  p.pbuf = (u16*)take((size_t)NT * PSTR * 2);
  p.rw = (u16*)take((size_t)NT * 8 * 16 * 24 * 2);
  p.cv = (u16*)take((size_t)NT * 1536 * 2);
  p.scr = (float*)take((size_t)12 * 1024 * 1024);
  p.ub = (u16*)take((size_t)NT * 512 * 2);
  p.w2t = (u16*)take((size_t)512 * 64 * 2);
  p.a2t = (u16*)take((size_t)512 * 64 * 2);
  p.g2t = (u16*)take((size_t)512 * 128 * 2);
#if 1
  p.p0 = 0; p.p1 = NPHASE;
  hipMemsetAsync(p.bar, 0, 16384, stream);
  void* args[] = {&p};
  hipError_t e = hipLaunchCooperativeKernel((void*)mega, dim3(grid_blocks), dim3(256), args, 0, stream);
  if (e != hipSuccess) fprintf(stderr, "cooperative launch failed: %s (grid %d)\n", hipGetErrorString(e), grid_blocks);
#else
  for (int ph = 0; ph < NPHASE; ph++) {
    p.p0 = ph; p.p1 = ph + 1;
    mega<<<dim3(grid_blocks), dim3(256), 0, stream>>>(p);
  }
#endif
}
```
